# Optimizing an MI355X kernel written in HIP

```python
import math
import jax, jax.numpy as jnp
from jax import lax
import numpy as np

D_MODEL = 1024
BATCH = 32
SEQ = 2048
DEPTH = 1

HEAD_DIM = 64
N_HEADS = 8
N_KV_HEADS = 2
GQA_GROUP = N_HEADS // N_KV_HEADS
WINDOW = 128
BLOCK = 128
ROT_DIM = HEAD_DIM // 4
ROPE_THETA = 500000.0
ATTN_WIDTH = N_HEADS * HEAD_DIM
KV_WIDTH = N_KV_HEADS * HEAD_DIM
CHUNK = 128
G_GROUPS = 8
G_GROUP_DIM = 64
G_WIDTH = G_GROUPS * G_GROUP_DIM
Q_END = ATTN_WIDTH
K_END = Q_END + KV_WIDTH
V_END = K_END + KV_WIDTH
Z_END = V_END + 2 * G_WIDTH
GA_END = Z_END + D_MODEL
IN_COLS = GA_END + D_MODEL
N_GROUPS = 4
EXPERTS_PER_GROUP = 8
N_EXPERTS = N_GROUPS * EXPERTS_PER_GROUP
TOP_K = 2
D_EXPERT = 512
EPS = 1e-5
NEG_INF = -1e30

kernel_name = "hybrid_swa_sink_chunked_gmlp_hier_moe"


def rms_norm(x, g):
    xf = x.astype(jnp.float32)
    y = xf * lax.rsqrt(jnp.mean(xf * xf, axis=-1, keepdims=True) + EPS)
    return (y * g.astype(jnp.float32)).astype(x.dtype)


def layer_norm(x, g, b):
    xf = x.astype(jnp.float32)
    mu = jnp.mean(xf, axis=-1, keepdims=True)
    var = jnp.mean(jnp.square(xf - mu), axis=-1, keepdims=True)
    y = (xf - mu) * lax.rsqrt(var + EPS)
    return (y * g.astype(jnp.float32) + b.astype(jnp.float32)).astype(x.dtype)


def rope_tables(seq):
    inv_freq = ROPE_THETA ** (-jnp.arange(0, ROT_DIM, 2, dtype=jnp.float32) / ROT_DIM)
    pos = jnp.arange(seq, dtype=jnp.float32)
    ang = pos[:, None] * inv_freq[None, :]
    return jnp.cos(ang), jnp.sin(ang)


def partial_rope(t, cos, sin):
    tr, tp = t[..., :ROT_DIM], t[..., ROT_DIM:]
    t1 = tr[..., :ROT_DIM // 2].astype(jnp.float32)
    t2 = tr[..., ROT_DIM // 2:].astype(jnp.float32)
    c = cos[None, :, None, :]
    s = sin[None, :, None, :]
    rot = jnp.concatenate([t1 * c - t2 * s, t2 * c + t1 * s], axis=-1)
    return jnp.concatenate([rot.astype(t.dtype), tp], axis=-1)


def sliding_window_sink_attention(q, k, v, sinks):
    b, s = q.shape[0], q.shape[1]
    nb = s // BLOCK
    q = q.reshape(b, nb, BLOCK, N_KV_HEADS, GQA_GROUP, HEAD_DIM)
    k = k.reshape(b, nb, BLOCK, N_KV_HEADS, HEAD_DIM)
    v = v.reshape(b, nb, BLOCK, N_KV_HEADS, HEAD_DIM)
    prev = lambda t: jnp.concatenate([jnp.zeros_like(t[:, :1]), t[:, :-1]], axis=1)
    kk = jnp.concatenate([prev(k), k], axis=2)
    vv = jnp.concatenate([prev(v), v], axis=2)
    scores = jnp.einsum("bnqhgd,bnkhd->bnhgqk", q, kk,
                        preferred_element_type=jnp.float32) * (1.0 / math.sqrt(HEAD_DIM))
    qi = jnp.arange(BLOCK)[:, None]
    kj = jnp.arange(2 * BLOCK)[None, :]
    rel = qi + BLOCK - kj
    band = (rel >= 0) & (rel < WINDOW)
    has_prev = (jnp.arange(nb) > 0)[:, None, None] | (kj >= BLOCK)[None]
    valid = band[None] & has_prev
    scores = jnp.where(valid[None, :, None, None], scores, NEG_INF)
    sink = jnp.broadcast_to(
        sinks.astype(jnp.float32).reshape(N_KV_HEADS, GQA_GROUP)[None, None, :, :, None, None],
        scores.shape[:-1] + (1,))
    probs = jax.nn.softmax(jnp.concatenate([scores, sink], axis=-1), axis=-1)[..., :-1]
    out = jnp.einsum("bnhgqk,bnkhd->bnqhgd", probs.astype(vv.dtype), vv)
    return out.reshape(b, s, ATTN_WIDTH)


def chunked_spatial_gating(z, ln_g, ln_b, w_s, b_s):
    b, s = z.shape[0], z.shape[1]
    nc = s // CHUNK
    u, v = z[..., :G_WIDTH], z[..., G_WIDTH:]
    v = layer_norm(v, ln_g, ln_b).reshape(b, nc, CHUNK, G_GROUPS, G_GROUP_DIM)
    causal = jnp.tril(jnp.ones((CHUNK, CHUNK), dtype=w_s.dtype))
    w = w_s * causal[None]
    mixed = jnp.einsum("gqp,bcpgd->bcqgd", w, v) + b_s.T[None, None, :, :, None]
    return u * mixed.reshape(b, s, G_WIDTH)


def hierarchical_moe(h, wg, bg, we, be, w_gate, w_up, w_down):
    b, s, d = h.shape
    t = h.reshape(b * s, d)
    g_logits = (t @ wg).astype(jnp.float32) + bg.astype(jnp.float32)
    g_prob = jax.nn.softmax(g_logits, axis=-1)
    g_sel = jnp.argmax(g_prob, axis=-1)
    g_w = jnp.take_along_axis(g_prob, g_sel[:, None], axis=-1)
    e_logits = ((t @ we).astype(jnp.float32) + be.astype(jnp.float32)).reshape(-1, N_GROUPS, EXPERTS_PER_GROUP)
    e_in_group = jnp.take_along_axis(e_logits, g_sel[:, None, None], axis=1)[:, 0]
    top_logit, top_idx = lax.top_k(e_in_group, TOP_K)
    weights = g_w * jax.nn.softmax(top_logit, axis=-1)
    expert_id = (g_sel[:, None] * EXPERTS_PER_GROUP + top_idx).reshape(-1)
    order = jnp.argsort(expert_id)
    tok = order // TOP_K
    xs = t[tok]
    ws = weights.reshape(-1)[order]
    sizes = jnp.bincount(expert_id, length=N_EXPERTS).astype(jnp.int32)
    hid = jax.nn.silu(lax.ragged_dot(xs, w_gate, sizes)) * lax.ragged_dot(xs, w_up, sizes)
    ys = lax.ragged_dot(hid, w_down, sizes) * ws[:, None].astype(hid.dtype)
    out = jnp.zeros_like(t).at[tok].add(ys.astype(t.dtype))
    return out.reshape(b, s, d)


def setup_inputs(seed: int = 0) -> dict:
    key = jax.random.key(seed)
    ks = jax.random.split(key, 24)
    n = lambda k, shape, scale: jax.random.normal(k, shape, jnp.float32) * scale
    return {
        "x": n(ks[0], (BATCH, SEQ, D_MODEL), 1.0),
        "norm1_g": 1.0 + n(ks[1], (DEPTH, D_MODEL), 0.05),
        "w_in": n(ks[2], (DEPTH, D_MODEL, IN_COLS), D_MODEL ** -0.5),
        "attn_sinks": n(ks[3], (DEPTH, N_HEADS), 1.0),
        "gmlp_ln_g": 1.0 + n(ks[4], (DEPTH, G_WIDTH), 0.05),
        "gmlp_ln_b": n(ks[5], (DEPTH, G_WIDTH), 0.05),
        "gmlp_ws": n(ks[6], (DEPTH, G_GROUPS, CHUNK, CHUNK), CHUNK ** -0.5),
        "gmlp_bs": 1.0 + n(ks[7], (DEPTH, G_GROUPS, CHUNK), 0.1),
        "w_attn_branch": n(ks[8], (DEPTH, ATTN_WIDTH, D_MODEL), ATTN_WIDTH ** -0.5),
        "w_gmlp_branch": n(ks[9], (DEPTH, G_WIDTH, D_MODEL), G_WIDTH ** -0.5),
        "w_out": n(ks[10], (DEPTH, D_MODEL, D_MODEL), D_MODEL ** -0.5),
        "norm2_g": 1.0 + n(ks[11], (DEPTH, D_MODEL), 0.05),
        "router_group_w": n(ks[12], (DEPTH, D_MODEL, N_GROUPS), D_MODEL ** -0.5),
        "router_group_b": n(ks[13], (DEPTH, N_GROUPS), 0.01),
        "router_expert_w": n(ks[14], (DEPTH, D_MODEL, N_EXPERTS), D_MODEL ** -0.5),
        "router_expert_b": n(ks[15], (DEPTH, N_EXPERTS), 0.01),
        "expert_w_gate": n(ks[16], (DEPTH, N_EXPERTS, D_MODEL, D_EXPERT), D_MODEL ** -0.5),
        "expert_w_up": n(ks[17], (DEPTH, N_EXPERTS, D_MODEL, D_EXPERT), D_MODEL ** -0.5),
        "expert_w_down": n(ks[18], (DEPTH, N_EXPERTS, D_EXPERT, D_MODEL), D_EXPERT ** -0.5),
        "final_norm_g": 1.0 + n(ks[19], (D_MODEL,), 0.05),
    }


def reference(x, norm1_g, w_in, attn_sinks, gmlp_ln_g, gmlp_ln_b, gmlp_ws, gmlp_bs,
              w_attn_branch, w_gmlp_branch, w_out, norm2_g, router_group_w, router_group_b,
              router_expert_w, router_expert_b, expert_w_gate, expert_w_up, expert_w_down,
              final_norm_g):
    b, s, _ = x.shape
    cos, sin = rope_tables(s)
    for l in range(DEPTH):
        h = rms_norm(x, norm1_g[l])
        proj = h @ w_in[l]
        q, k, v, z, ga, gg = jnp.split(proj, [Q_END, K_END, V_END, Z_END, GA_END], axis=-1)
        q = partial_rope(q.reshape(b, s, N_HEADS, HEAD_DIM), cos, sin)
        k = partial_rope(k.reshape(b, s, N_KV_HEADS, HEAD_DIM), cos, sin)
        v = v.reshape(b, s, N_KV_HEADS, HEAD_DIM)
        a = sliding_window_sink_attention(q, k, v, attn_sinks[l]) @ w_attn_branch[l]
        g = chunked_spatial_gating(jax.nn.gelu(z), gmlp_ln_g[l], gmlp_ln_b[l],
                                   gmlp_ws[l], gmlp_bs[l]) @ w_gmlp_branch[l]
        mixed = jax.nn.sigmoid(ga) * a + jax.nn.sigmoid(gg) * g
        x = x + mixed @ w_out[l]
        x = x + hierarchical_moe(rms_norm(x, norm2_g[l]), router_group_w[l], router_group_b[l],
                                 router_expert_w[l], router_expert_b[l], expert_w_gate[l],
                                 expert_w_up[l], expert_w_down[l])
    return rms_norm(x, final_norm_g)
```

```cpp
#include <hip/hip_runtime.h>
#include <cstdio>
#include <cstdint>

#ifndef MK_N_LAUNCHES
#define MK_N_LAUNCHES 1
#endif

#define GAS __attribute__((address_space(1)))
#define LAS __attribute__((address_space(3)))
typedef unsigned short bf16;
typedef unsigned v4u __attribute__((ext_vector_type(4)));
typedef unsigned v2u __attribute__((ext_vector_type(2)));
typedef float f32x4 __attribute__((ext_vector_type(4)));
typedef float f32x2 __attribute__((ext_vector_type(2)));
typedef short bf16x8 __attribute__((ext_vector_type(8)));
typedef short s16x4 __attribute__((ext_vector_type(4)));
typedef int v8i __attribute__((ext_vector_type(8)));
typedef int v4i __attribute__((ext_vector_type(4)));

constexpr int T_ = 65536, D_ = 1024, SEQ_ = 2048, INC_ = 3840;
constexpr int NEXP = 32, DEXP = 512;
constexpr float EPS_ = 1e-5f;
constexpr float LOG2E = 1.4426950408889634f;
constexpr float QSCALE = 0.125f * LOG2E;

constexpr size_t MiB = 1u << 20;
constexpr size_t WS_CTL = 0, CTL_ZERO_BYTES = 1 * MiB;
constexpr size_t WS_WIN = 2 * MiB;
constexpr size_t WS_WIN8Q = 6 * MiB;
constexpr size_t WS_WIN8 = 6 * MiB + 768 * 1024;
constexpr size_t WS_WA = 10 * MiB, WS_WG = 11 * MiB, WS_WOUT = 12 * MiB;
constexpr size_t WS_WR = 14 * MiB;
constexpr size_t WS_WM = 14 * MiB + 256 * 1024;
constexpr size_t WS_ROPE = 14 * MiB + 512 * 1024;
constexpr size_t WS_WGU = 16 * MiB;
constexpr size_t WS_WD = 80 * MiB;
constexpr size_t WS_LIST = 112 * MiB;
constexpr size_t WS_TOKE = 120 * MiB, WS_TOKW = 121 * MiB, WS_TOKP = 122 * MiB;
constexpr size_t WS_XN = 128 * MiB;
constexpr size_t WS_Q = 256 * MiB, WS_K = 320 * MiB, WS_V = 336 * MiB, WS_AO = 352 * MiB, WS_GO = 416 * MiB;
constexpr size_t WS_Z = 480 * MiB, WS_SGA = 608 * MiB, WS_SGG = 736 * MiB, WS_MIX = 864 * MiB;
constexpr size_t WS_XN8 = 352 * MiB;
constexpr size_t WS_X1 = 128 * MiB;
constexpr size_t WS_H2 = 352 * MiB;
constexpr size_t WS_HID = 480 * MiB;
constexpr size_t WS_Y = 616 * MiB;
constexpr size_t WS_END = 992 * MiB;
constexpr int CW_BAR = 4096;
constexpr int CW_CNT = 16384;
constexpr int CW_QUAD = 32768;
constexpr int CW_XLOC = 40960;

constexpr int RING_OFF = 0, RING_BYTES = 131072;
constexpr int LDSCTL_OFF = RING_BYTES, MISC_OFF = LDSCTL_OFF + 320;
constexpr int TAB_OFF = RING_BYTES + 512;
constexpr int TAB_CNT = TAB_OFF, TAB_TPRE = TAB_OFF + 128, TAB_ULIST = TAB_OFF + 384, TAB_GATHER = TAB_OFF + 512;
constexpr int MAX_UNITS = 12;
constexpr int LDS_BYTES = 163840;
static_assert(TAB_GATHER + MAX_UNITS * 1024 <= LDS_BYTES, "LDS map");

#define RLX_AGENT __ATOMIC_RELAXED, __HIP_MEMORY_SCOPE_AGENT
#define LDS_WAIT() asm volatile("s_waitcnt lgkmcnt(0)" ::: "memory")
#define VM_WAIT() asm volatile("s_waitcnt vmcnt(0)" ::: "memory")
__device__ __forceinline__ unsigned cvt_pk_bf16(float lo, float hi) { unsigned r; asm volatile("v_cvt_pk_bf16_f32 %0, %1, %2" : "=v"(r) : "v"(lo), "v"(hi)); return r; }
__device__ __forceinline__ float bf_lo(unsigned w) { return __uint_as_float(w << 16); }
__device__ __forceinline__ float bf_hi(unsigned w) { return __uint_as_float(w & 0xffff0000u); }
__device__ __forceinline__ float fast_exp2(float x) { return __builtin_amdgcn_exp2f(x); }
__device__ __forceinline__ float fast_rcp(float x) { return __builtin_amdgcn_rcpf(x); }
__device__ __forceinline__ float gelu_tanh(float x) { const float u = x + 0.044715f * x * x * x; return x * fast_rcp(1.0f + fast_exp2(-2.302208198f * u)); }
__device__ __forceinline__ float sigmoidf_(float x) { return fast_rcp(1.0f + fast_exp2(-LOG2E * x)); }
__device__ __forceinline__ float sat448(float v) { return __builtin_amdgcn_fmed3f(v, -448.0f, 448.0f); }
__device__ __forceinline__ unsigned pk4_fp8(float a, float b, float c, float d) { int w = 0; w = __builtin_amdgcn_cvt_pk_fp8_f32(a, b, w, false); w = __builtin_amdgcn_cvt_pk_fp8_f32(c, d, w, true); return (unsigned)w; }
__device__ __forceinline__ void unpack8_fp8(const v2u w, f32x4& v0, f32x4& v1) {
    const f32x2 a = __builtin_amdgcn_cvt_pk_f32_fp8((int)w.x, false), b = __builtin_amdgcn_cvt_pk_f32_fp8((int)w.x, true), c = __builtin_amdgcn_cvt_pk_f32_fp8((int)w.y, false), d = __builtin_amdgcn_cvt_pk_f32_fp8((int)w.y, true);
    v0 = (f32x4){a.x, a.y, b.x, b.y}; v1 = (f32x4){c.x, c.y, d.x, d.y};
}
template <int CTRL> __device__ __forceinline__ float dpp_f(float v) { return __builtin_bit_cast(float, __builtin_amdgcn_update_dpp(0, __builtin_bit_cast(int, v), CTRL, 0xF, 0xF, true)); }
__device__ __forceinline__ float wave_sum(float v) {
    v += dpp_f<0xB1>(v); v += dpp_f<0x4E>(v); v += dpp_f<0x141>(v); v += dpp_f<0x140>(v);
    { const auto rr = __builtin_amdgcn_permlane16_swap(__float_as_uint(v), __float_as_uint(v), false, false); v = __uint_as_float(rr[0]) + __uint_as_float(rr[1]); }
    { const auto rr = __builtin_amdgcn_permlane32_swap(__float_as_uint(v), __float_as_uint(v), false, false); v = __uint_as_float(rr[0]) + __uint_as_float(rr[1]); }
    return v;
}
__device__ __forceinline__ f32x4 mfma16(bf16x8 a, bf16x8 b, f32x4 c) { return __builtin_amdgcn_mfma_f32_16x16x32_bf16(a, b, c, 0, 0, 0); }
typedef short v4i16_t __attribute__((ext_vector_type(4)));
__device__ __forceinline__ s16x4 vtr(LAS const unsigned char* p) { return __builtin_bit_cast(s16x4, __builtin_amdgcn_ds_read_tr16_b64_v4i16((LAS v4i16_t*)p)); }

namespace pg8 {
#define PG8_LAS __attribute__((address_space(3)))
typedef unsigned short bf16_t;
typedef unsigned u32x4 __attribute__((ext_vector_type(4)));
constexpr int BM = 256, BK = 64, HALF = 128, HTB = HALF * BK * 2, STAGE_BYTES = 8 * HTB, NXCD = 8, WGM = 8;
__host__ __device__ __forceinline__ int lds_byte(int r, int c) { const int st = (r >> 4) * 2 + (c >> 5), rr = r & 15, cc = c & 31, ob = rr * 64 + cc * 2; return st * 1024 + (ob ^ (((ob >> 9) & 1) << 5)); }
__host__ __device__ __forceinline__ void stage_rc(int b, int& R, int& C) { const int st = b / 1024, sb = b % 1024, swz = sb ^ (((sb >> 9) & 1) << 5); R = (st >> 1) * 16 + swz / 64; C = (st & 1) * 32 + (swz % 64) / 2; }
__host__ __device__ __forceinline__ int perm32(int rho) { const int n = rho >> 4, i = rho & 15; return 8 * (i >> 2) + 4 * n + (i & 3); }

template <int OFF> __device__ __forceinline__ void glds16s(const char* sbase, unsigned voff, unsigned lds_base) {
    unsigned keep;
    asm volatile("s_mov_b32 %0, m0\n\ts_add_u32 m0, %3, %4\n\ts_nop 2\n\tglobal_load_lds_dwordx4 %2, %1\n\ts_mov_b32 m0, %0" : "=&s"(keep) : "s"(sbase), "v"(voff), "s"(lds_base), "n"(OFF) : "memory", "scc");
}
struct Unit { int pm, pn; const char* a; const char* b; int aux; };

struct DenseOrder {
    const char* A; const char* Bt; int K, nM, nN, nwg, G, c; bool idg, panel;
    __device__ void init(const void* A_, const void* Bt_, int M, int N, int K_, int G_, int c_, bool idg_ = false, bool panel_ = false) { A = (const char*)A_; Bt = (const char*)Bt_; K = K_; nM = M / BM; nN = N / BM; nwg = nM * nN; G = G_; c = c_; idg = idg_; panel = panel_; }
    __device__ bool next(int i, Unit& u) const {
        if (panel) { u.pn = c & 3; u.pm = (c & ~3) + (i & 3) + (i >> 2) * G; if (u.pm >= nM) return false; }
        else {
        const long L = (long)i * G + c; if (L >= nwg) return false;
        int wgid = (int)L; { const int q = nwg / NXCD, r = nwg % NXCD, xcd = wgid % NXCD, off = wgid / NXCD; wgid = (xcd < r ? xcd * (q + 1) : r * (q + 1) + (xcd - r) * q) + off; }
        const int nig = WGM * nN, gid = wgid / nig, fm = gid * WGM, gsz = (nM - fm) < WGM ? (nM - fm) : WGM;
        u.pm = fm + ((wgid % nig) % gsz); u.pn = (wgid % nig) / gsz; }
        u.a = idg ? A : A + (size_t)u.pm * BM * K * 2; u.b = Bt + (size_t)u.pn * BM * K * 2; u.aux = idg ? i : 0; return true;
    }
};
struct DualOrder {
    const char* A[2]; const char* Bt[2]; int K, nM, nN, nwg, G, c;
    __device__ void init(const void* A0, const void* B0, const void* A1, const void* B1, int M, int N, int K_, int G_, int c_) { A[0] = (const char*)A0; Bt[0] = (const char*)B0; A[1] = (const char*)A1; Bt[1] = (const char*)B1; K = K_; nM = M / BM; nN = N / BM; nwg = nM * nN; G = G_; c = c_; }
    __device__ bool next(int i, Unit& u) const {
        const int seg = i & 1, t = i >> 1; u.pn = c & 3; u.pm = (c & ~3) + (t & 3) + (t >> 2) * G; if (u.pm >= nM) return false;
        u.a = (seg ? A[1] : A[0]) + (size_t)u.pm * BM * K * 2; u.b = (seg ? Bt[1] : Bt[0]) + (size_t)u.pn * BM * K * 2; u.aux = seg; return true;
    }
};
struct MoeOrder {
    const PG8_LAS int* ulist; int nu; const char* Abase; size_t a_tile; const char* Bbase; size_t b_exp, b_pn; int aux0;
    __device__ bool next(int i, Unit& u) const {
        if (i >= nu) return false;
        const int w = __builtin_amdgcn_readfirstlane(ulist[i]); const int e = w >> 16, ti = (w >> 2) & 0x3fff, pn = w & 3;
        u.pm = ti; u.pn = pn; u.a = Abase + (size_t)ti * a_tile; u.b = Bbase + (size_t)e * b_exp + (size_t)pn * b_pn; u.aux = i + aux0; return true;
    }
};

template <class Epi, class Sched, bool ALIGN_EPI, bool GATHER, int SA8 = 0, int SB8 = 0>
__device__ __forceinline__ void gemm_phase(PG8_LAS unsigned char* lds, const int K, const Sched& S, const Epi& E, const PG8_LAS unsigned char* gtab) {
    const int tid = threadIdx.x, wid = __builtin_amdgcn_readfirstlane(tid >> 6), lane = tid & 63, wr = wid >> 2, wc = wid & 3, fr = lane & 15, fq = lane >> 4;
    const int nt = K / BK;
    unsigned voffA[2], voffB[2]; int gRow[2]; unsigned gCol[2];
#pragma unroll
    for (int i = 0; i < 2; ++i) { int R, C; stage_rc(tid * 16 + i * 8192, R, C); const int Rb = (R & ~31) + perm32(R & 31);
        voffA[i] = (unsigned)(R * K + C) * 2u; voffB[i] = (unsigned)(Rb * K + C) * 2u; gRow[i] = R; gCol[i] = (unsigned)C * 2u; }
    const size_t kstep = (size_t)(BK * 2);
    const size_t hstep = (size_t)HALF * K * 2;
    const unsigned ldsw = (unsigned)wid * 1024u;
    const unsigned ldsb = (unsigned)(size_t)lds + ldsw;
    const int aoff = lds_byte(wr * 64 + fr, fq * 8), boff = lds_byte(wc * 32 + fr, fq * 8);
    unsigned gC[2][2], gN[2][2];
#define PG8_SA(b, h) (((b) * 2 + (h)) * HTB)
#define PG8_SB(b, h) ((4 + (b) * 2 + (h)) * HTB)
#define PG8_STAGE(bufoff, gbase, voff) do { glds16s<(bufoff)>((const char*)(gbase), (voff)[0], ldsb); glds16s<(bufoff) + 8192>((const char*)(gbase), (voff)[1], ldsb); } while (0)
#define PG8_STAGE_A(bufoff, kptr, h) PG8_STAGE(bufoff, kptr, gC[h])
#define PG8_GLOAD(dst, unit) do { _Pragma("unroll") for (int _h = 0; _h < 2; ++_h) _Pragma("unroll") for (int _i = 0; _i < 2; ++_i) \
        dst[_h][_i] = *(const PG8_LAS unsigned*)(gtab + (unit) * 1024 + (gRow[_i] + _h * HALF) * 4) + gCol[_i]; } while (0)
#define PG8_LDA(dst, b, h) do { _Pragma("unroll") for (int m = 0; m < 4; ++m) _Pragma("unroll") for (int k = 0; k < 2; ++k) dst[m][k] = *(const PG8_LAS bf16x8*)(lds + PG8_SA(b, h) + aoff + m * 2048 + k * 1024); } while (0)
#define PG8_LDB(dst, b, h) do { _Pragma("unroll") for (int n = 0; n < 2; ++n) _Pragma("unroll") for (int k = 0; k < 2; ++k) dst[n][k] = *(const PG8_LAS bf16x8*)(lds + PG8_SB(b, h) + boff + n * 2048 + k * 1024); } while (0)
#define PG8_CAT8(x0, x1) __builtin_shufflevector(__builtin_bit_cast(v4i, x0), __builtin_bit_cast(v4i, x1), 0, 1, 2, 3, 4, 5, 6, 7)
#define PG8_MMA(ai, bj, At, Bt) do { __builtin_amdgcn_s_setprio(1); _Pragma("unroll") for (int m = 0; m < 4; ++m) _Pragma("unroll") for (int n = 0; n < 2; ++n) { \
        if constexpr (SA8 != 0) { acc[ai][bj][m][n] = __builtin_amdgcn_mfma_scale_f32_16x16x128_f8f6f4(PG8_CAT8(Bt[n][0], Bt[n][1]), PG8_CAT8(At[m][0], At[m][1]), acc[ai][bj][m][n], 0, 0, 0, SA8 * 0x01010101, 0, SB8 * 0x01010101); } \
        else { _Pragma("unroll") for (int k = 0; k < 2; ++k) acc[ai][bj][m][n] = __builtin_amdgcn_mfma_f32_16x16x32_bf16(Bt[n][k], At[m][k], acc[ai][bj][m][n], 0, 0, 0); } } \
        __builtin_amdgcn_s_setprio(0); } while (0)
#define PG8_WAIT_V(n) asm volatile("s_waitcnt vmcnt(" #n ")" ::: "memory")
#define PG8_WAIT_L(n) asm volatile("s_waitcnt lgkmcnt(" #n ")" ::: "memory")
#define PG8_BAR __builtin_amdgcn_s_barrier()
#define PG8_SCHED __builtin_amdgcn_sched_barrier(0)
    Unit cur, nxt; int ui = 0;
    if (!S.next(0, cur)) return;
    f32x4 acc[2][2][4][2];
    if constexpr (Epi::ACC_INIT) E.init(acc, cur, wr, wc, fr, fq);
    else {
#pragma unroll
    for (int a = 0; a < 2; ++a)
#pragma unroll
        for (int b = 0; b < 2; ++b)
#pragma unroll
            for (int m = 0; m < 4; ++m)
#pragma unroll
                for (int n = 0; n < 2; ++n) acc[a][b][m][n] = (f32x4){0.f, 0.f, 0.f, 0.f}; }
    bf16x8 At[4][2], B0[2][2], B1[2][2];
    const char* cA = cur.a; const char* cB = cur.b;
    if constexpr (GATHER) { PG8_GLOAD(gC, cur.aux); PG8_WAIT_L(0); }
    else {
#pragma unroll
        for (int h = 0; h < 2; ++h)
#pragma unroll
            for (int i = 0; i < 2; ++i) gC[h][i] = voffA[i] + (unsigned)h * (unsigned)hstep; }
    PG8_STAGE(PG8_SB(0, 0), cB, voffB); PG8_STAGE(PG8_SB(0, 1), cB + hstep, voffB); PG8_STAGE_A(PG8_SA(0, 0), cA, 0); PG8_STAGE_A(PG8_SA(0, 1), cA, 1);
    if (wr == 1) PG8_BAR;
    PG8_WAIT_V(2); PG8_BAR;
    PG8_STAGE(PG8_SB(1, 0), cB + kstep, voffB); PG8_STAGE_A(PG8_SA(1, 0), cA + kstep, 0); PG8_STAGE(PG8_SB(1, 1), cB + hstep + kstep, voffB);
    PG8_WAIT_V(6); PG8_BAR;
    for (;;) {
        const bool has_next = S.next(ui + 1, nxt);
        const char* nA = has_next ? nxt.a : cA; const char* nB = has_next ? nxt.b : cB;
        if constexpr (GATHER) { if (has_next) { PG8_GLOAD(gN, nxt.aux); } else {
#pragma unroll
            for (int h = 0; h < 2; ++h)
#pragma unroll
                for (int i = 0; i < 2; ++i) gN[h][i] = gC[h][i]; } }
        if constexpr (Epi::ACC_INIT) {
#pragma unroll
            for (int a = 0; a < 2; ++a)
#pragma unroll
                for (int b = 0; b < 2; ++b) asm volatile("" : "+v"(acc[a][b][0][0]), "+v"(acc[a][b][0][1]), "+v"(acc[a][b][1][0]), "+v"(acc[a][b][1][1]), "+v"(acc[a][b][2][0]), "+v"(acc[a][b][2][1]), "+v"(acc[a][b][3][0]), "+v"(acc[a][b][3][1])); }
#pragma unroll 1
        for (int t = 0; t < nt; t += 2) {
            const bool last = (t == nt - 2);
            const char* a1 = cA + (size_t)(t + 1) * kstep;
            const char* a2 = last ? nA : cA + (size_t)(t + 2) * kstep; const char* b2 = last ? nB : cB + (size_t)(t + 2) * kstep;
            const char* a3 = a2 + kstep; const char* b3 = b2 + kstep;
            PG8_LDB(B0, 0, 0); PG8_LDB(B1, 0, 1); PG8_SCHED; PG8_LDA(At, 0, 0); PG8_STAGE_A(PG8_SA(1, 1), a1, 1);
            if constexpr (GATHER) { if (last) {
#pragma unroll
                for (int h = 0; h < 2; ++h)
#pragma unroll
                    for (int i = 0; i < 2; ++i) gC[h][i] = gN[h][i]; } }
            PG8_WAIT_V(8); PG8_WAIT_L(0); PG8_BAR; PG8_MMA(0, 0, At, B0); PG8_MMA(0, 1, At, B1); PG8_BAR; PG8_SCHED;
            PG8_LDA(At, 0, 1); PG8_STAGE(PG8_SB(0, 0), b2, voffB); PG8_STAGE(PG8_SB(0, 1), b2 + hstep, voffB); PG8_STAGE_A(PG8_SA(0, 0), a2, 0);
            PG8_WAIT_V(8); PG8_WAIT_L(0); PG8_BAR; PG8_MMA(1, 0, At, B0); PG8_MMA(1, 1, At, B1); PG8_BAR; PG8_SCHED;
            PG8_LDB(B0, 1, 0); PG8_LDB(B1, 1, 1); PG8_SCHED; PG8_LDA(At, 1, 0); PG8_STAGE_A(PG8_SA(0, 1), a2, 1);
            PG8_WAIT_V(8); PG8_WAIT_L(0); PG8_BAR; PG8_MMA(0, 0, At, B0); PG8_MMA(0, 1, At, B1); PG8_BAR; PG8_SCHED;
            PG8_LDA(At, 1, 1); PG8_STAGE(PG8_SB(1, 0), b3, voffB); PG8_STAGE(PG8_SB(1, 1), b3 + hstep, voffB); PG8_STAGE_A(PG8_SA(1, 0), a3, 0);
            PG8_WAIT_V(8); PG8_WAIT_L(0); PG8_BAR; PG8_MMA(1, 0, At, B0); PG8_MMA(1, 1, At, B1); PG8_BAR; PG8_SCHED;
        }
        if constexpr (ALIGN_EPI) { if (wr == 0) PG8_BAR; }
        E(acc, cur, wr, wc, fr, fq);
        if (!has_next) break;
        if constexpr (Epi::ACC_INIT) E.init(acc, nxt, wr, wc, fr, fq);
        else
        if (!(Epi::SEG && cur.aux == 0))
#pragma unroll
        for (int a = 0; a < 2; ++a)
#pragma unroll
            for (int b = 0; b < 2; ++b)
#pragma unroll
                for (int m = 0; m < 4; ++m)
#pragma unroll
                    for (int n = 0; n < 2; ++n) acc[a][b][m][n] = (f32x4){0.f, 0.f, 0.f, 0.f};
        cur = nxt; cA = nA; cB = nB; ++ui;
        if constexpr (ALIGN_EPI) { if (wr == 1) PG8_BAR; }
    }
    PG8_WAIT_V(0);
    if constexpr (!ALIGN_EPI) { if (wr == 0) PG8_BAR; }
    PG8_BAR;
#undef PG8_SA
#undef PG8_SB
#undef PG8_STAGE
#undef PG8_STAGE_A
#undef PG8_GLOAD
#undef PG8_LDA
#undef PG8_LDB
#undef PG8_MMA
#undef PG8_CAT8
#undef PG8_WAIT_V
#undef PG8_WAIT_L
#undef PG8_BAR
#undef PG8_SCHED
}

__device__ __forceinline__ u32x4 pack8(const f32x4 v0, const f32x4 v1) { u32x4 w; w.x = cvt_pk_bf16(v0[0], v0[1]); w.y = cvt_pk_bf16(v0[2], v0[3]); w.z = cvt_pk_bf16(v1[0], v1[1]); w.w = cvt_pk_bf16(v1[2], v1[3]); return w; }
__device__ __forceinline__ void unpack8(const u32x4 w, f32x4& v0, f32x4& v1) { v0 = (f32x4){bf_lo(w.x), bf_hi(w.x), bf_lo(w.y), bf_hi(w.y)}; v1 = (f32x4){bf_lo(w.z), bf_hi(w.z), bf_lo(w.w), bf_hi(w.w)}; }

struct EpiInProj {
    static constexpr bool SEG = false; static constexpr bool ACC_INIT = false;
    bf16_t *Q, *Kb, *Vb, *Z; const float* rope; int pn0;
    __device__ __forceinline__ void operator()(const f32x4 (&acc)[2][2][4][2], const Unit& u, int wr, int wc, int fr, int fq) const {
        const int row0 = u.pm * BM + wr * 64 + fr, c8 = wc * 32 + 8 * fq, pn = u.pn + pn0;
        if (pn <= 2) {
            const bool rot_lane = ((wc & 1) == 0) && (fq < 2);
            const float sgn = (fq == 0) ? -1.f : 1.f;
#pragma unroll
            for (int ai = 0; ai < 2; ++ai)
#pragma unroll
                for (int m = 0; m < 4; ++m) {
                    const int row = row0 + ai * HALF + m * 16, pos = row & (SEQ_ - 1);
                    const f32x4 cs0 = *(const f32x4*)(rope + pos * 16), cs1 = *(const f32x4*)(rope + pos * 16 + 4), sn0 = *(const f32x4*)(rope + pos * 16 + 8), sn1 = *(const f32x4*)(rope + pos * 16 + 12);
#pragma unroll
                    for (int bj = 0; bj < 2; ++bj) {
                        f32x4 v0 = acc[ai][bj][m][0], v1 = acc[ai][bj][m][1];
                        const bool isv = (pn == 2) && (bj == 1);
                        if (!isv) {
                            f32x4 o0, o1;
#pragma unroll
                            for (int j = 0; j < 4; ++j) { o0[j] = __shfl_xor(v0[j], 16); o1[j] = __shfl_xor(v1[j], 16); }
                            if (rot_lane) { v0 = v0 * cs0 + sgn * (o0 * sn0); v1 = v1 * cs1 + sgn * (o1 * sn1); }
                        }
                        bf16_t* dst;
                        if (pn < 2) { v0 = v0 * QSCALE; v1 = v1 * QSCALE; dst = Q + (size_t)row * 512 + pn * 256 + bj * HALF + c8; }
                        else dst = (bj == 0 ? Kb : Vb) + (size_t)row * 128 + c8;
                        *(u32x4*)dst = pack8(v0, v1);
                    }
                }
        } else if (pn <= 6) {
#pragma unroll
            for (int ai = 0; ai < 2; ++ai)
#pragma unroll
                for (int m = 0; m < 4; ++m) {
                    bf16_t* rowp = Z + (size_t)(row0 + ai * HALF + m * 16) * 1024 + (pn - 3) * 256 + c8;
#pragma unroll
                    for (int bj = 0; bj < 2; ++bj) { f32x4 v0 = acc[ai][bj][m][0], v1 = acc[ai][bj][m][1];
#pragma unroll
                        for (int j = 0; j < 4; ++j) { v0[j] = gelu_tanh(v0[j]); v1[j] = gelu_tanh(v1[j]); }
                        *(u32x4*)(rowp + bj * HALF) = pack8(v0, v1); }
                }
        }
    }
};
struct EpiGates {
    static constexpr bool SEG = false; static constexpr bool ACC_INIT = false;
    bf16_t *R, *S;
    __device__ __forceinline__ void operator()(const f32x4 (&acc)[2][2][4][2], const Unit& u, int wr, int wc, int fr, int fq) const {
        const int row0 = u.pm * BM + wr * 64 + fr, col0 = u.pn * HALF + wc * 32 + 8 * fq;
#pragma unroll
        for (int ai = 0; ai < 2; ++ai)
#pragma unroll
            for (int m = 0; m < 4; ++m) { f32x4 r0, r1, s0, s1;
#pragma unroll
                for (int j = 0; j < 4; ++j) { const float ea0 = fast_exp2(-LOG2E * acc[ai][0][m][0][j]), ea1 = fast_exp2(-LOG2E * acc[ai][0][m][1][j]), eg0 = fast_exp2(-LOG2E * acc[ai][1][m][0][j]), eg1 = fast_exp2(-LOG2E * acc[ai][1][m][1][j]);
                    r0[j] = (1.0f + eg0) * fast_rcp(1.0f + ea0); r1[j] = (1.0f + eg1) * fast_rcp(1.0f + ea1); s0[j] = fast_rcp(1.0f + eg0); s1[j] = fast_rcp(1.0f + eg1); }
                const size_t off = (size_t)(row0 + ai * HALF + m * 16) * 1024 + col0;
                *(u32x4*)(R + off) = pack8(r0, r1); *(u32x4*)(S + off) = pack8(s0, s1); }
    }
};
struct EpiInProj8 {
    static constexpr bool SEG = false; static constexpr bool ACC_INIT = false;
    EpiInProj qkv; EpiGates gates;
    __device__ __forceinline__ void operator()(const f32x4 (&acc)[2][2][4][2], const Unit& u, int wr, int wc, int fr, int fq) const {
        if (u.pn < 3) qkv(acc, u, wr, wc, fr, fq); else { Unit v = u; v.pn = u.pn - 3; gates(acc, v, wr, wc, fr, fq); }
    }
};
struct EpiMixFused {
    static constexpr bool SEG = true; static constexpr bool ACC_INIT = false;
    bf16_t* MIX; const bf16_t *SGA, *SGG;
    __device__ __forceinline__ void operator()(f32x4 (&acc)[2][2][4][2], const Unit& u, int wr, int wc, int fr, int fq) const {
        const int row0 = u.pm * BM + wr * 64 + fr, col0 = u.pn * BM + wc * 32 + 8 * fq;
        if (u.aux == 0) {
#pragma unroll
            for (int ai = 0; ai < 2; ++ai)
#pragma unroll
                for (int m = 0; m < 4; ++m) { const size_t off = (size_t)(row0 + ai * HALF + m * 16) * 1024 + col0;
#pragma unroll
                    for (int bj = 0; bj < 2; ++bj) { f32x4 a0, a1; unpack8(*(const u32x4*)(SGA + off + bj * HALF), a0, a1);
                        acc[ai][bj][m][0] = acc[ai][bj][m][0] * a0; acc[ai][bj][m][1] = acc[ai][bj][m][1] * a1; } }
        } else {
#pragma unroll
            for (int ai = 0; ai < 2; ++ai)
#pragma unroll
                for (int m = 0; m < 4; ++m) { const size_t off = (size_t)(row0 + ai * HALF + m * 16) * 1024 + col0;
#pragma unroll
                    for (int bj = 0; bj < 2; ++bj) { f32x4 g0, g1; unpack8(*(const u32x4*)(SGG + off + bj * HALF), g0, g1);
                        *(u32x4*)(MIX + off + bj * HALF) = pack8(acc[ai][bj][m][0] * g0, acc[ai][bj][m][1] * g1); } }
        }
    }
};
struct EpiResid {
    static constexpr bool SEG = false; static constexpr bool ACC_INIT = true;
    const float* X; bf16_t* X1;
    __device__ __forceinline__ void init(f32x4 (&acc)[2][2][4][2], const Unit& u, int wr, int wc, int fr, int fq) const {
        const int row0 = u.pm * BM + wr * 64 + fr, col0 = u.pn * BM + wc * 32 + 8 * fq;
#pragma unroll
        for (int ai = 0; ai < 2; ++ai)
#pragma unroll
            for (int m = 0; m < 4; ++m) { const size_t off = (size_t)(row0 + ai * HALF + m * 16) * 1024 + col0;
#pragma unroll
                for (int bj = 0; bj < 2; ++bj) { acc[ai][bj][m][0] = *(const f32x4*)(X + off + bj * HALF); acc[ai][bj][m][1] = *(const f32x4*)(X + off + bj * HALF + 4); } }
    }
    __device__ __forceinline__ void operator()(const f32x4 (&acc)[2][2][4][2], const Unit& u, int wr, int wc, int fr, int fq) const {
        const int row0 = u.pm * BM + wr * 64 + fr, col0 = u.pn * BM + wc * 32 + 8 * fq;
#pragma unroll
        for (int ai = 0; ai < 2; ++ai)
#pragma unroll
            for (int m = 0; m < 4; ++m) { const size_t off = (size_t)(row0 + ai * HALF + m * 16) * 1024 + col0;
#pragma unroll
                for (int bj = 0; bj < 2; ++bj) *(u32x4*)(X1 + off + bj * HALF) = pack8(acc[ai][bj][m][0], acc[ai][bj][m][1]); }
    }
};
struct EpiGateUp {
    static constexpr bool SEG = false; static constexpr bool ACC_INIT = false;
    unsigned char* HID;
    __device__ __forceinline__ void operator()(const f32x4 (&acc)[2][2][4][2], const Unit& u, int wr, int wc, int fr, int fq) const {
        const int row0 = u.pm * BM + wr * 64 + fr, col0 = u.pn * HALF + wc * 32 + 8 * fq;
#pragma unroll
        for (int ai = 0; ai < 2; ++ai)
#pragma unroll
            for (int m = 0; m < 4; ++m) { f32x4 v0, v1;
#pragma unroll
                for (int j = 0; j < 4; ++j) { const float g0 = acc[ai][0][m][0][j], g1 = acc[ai][0][m][1][j];
                    v0[j] = 8.0f * g0 * sigmoidf_(g0) * acc[ai][1][m][0][j]; v1[j] = 8.0f * g1 * sigmoidf_(g1) * acc[ai][1][m][1][j]; }
                v2u o; o.x = pk4_fp8(sat448(v0[0]), sat448(v0[1]), sat448(v0[2]), sat448(v0[3])); o.y = pk4_fp8(sat448(v1[0]), sat448(v1[1]), sat448(v1[2]), sat448(v1[3]));
                *(v2u*)(HID + (size_t)(row0 + ai * HALF + m * 16) * DEXP + col0) = o; }
    }
};
struct EpiDown {
    static constexpr bool SEG = false; static constexpr bool ACC_INIT = false;
    unsigned char* Y;
    __device__ __forceinline__ void operator()(const f32x4 (&acc)[2][2][4][2], const Unit& u, int wr, int wc, int fr, int fq) const {
        const int row0 = u.pm * BM + wr * 64 + fr, col0 = u.pn * BM + wc * 32 + 8 * fq;
#pragma unroll
        for (int ai = 0; ai < 2; ++ai)
#pragma unroll
            for (int m = 0; m < 4; ++m) { unsigned char* rowp = Y + (size_t)(row0 + ai * HALF + m * 16) * 1024 + col0;
#pragma unroll
                for (int bj = 0; bj < 2; ++bj) { const f32x4 v0 = acc[ai][bj][m][0] * 16.0f, v1 = acc[ai][bj][m][1] * 16.0f;
                    v2u o; o.x = pk4_fp8(sat448(v0[0]), sat448(v0[1]), sat448(v0[2]), sat448(v0[3])); o.y = pk4_fp8(sat448(v1[0]), sat448(v1[1]), sat448(v1[2]), sat448(v1[3])); *(v2u*)(rowp + bj * HALF) = o; } }
    }
};
}

#define XB_TMO      128
#define XB_XCNT(j)  (256  + 64 * (j))
#define XB_XSUB(j)  (1280 + 64 * (j))
#define XB_XGEN(j)  (2304 + 64 * (j))
#define XB_TOP      3328
#define XB_TOPGEN   3392
#define XCD_BAR_WORDS 3456
#define XB_SPIN_CAP (1u << 18)
__device__ __forceinline__ unsigned xb_ld(unsigned* p)              { return __hip_atomic_load(p, __ATOMIC_RELAXED, __HIP_MEMORY_SCOPE_AGENT); }
__device__ __forceinline__ unsigned xb_add(unsigned* p, unsigned v) { return __hip_atomic_fetch_add(p, v, __ATOMIC_RELAXED, __HIP_MEMORY_SCOPE_AGENT); }
__device__ __forceinline__ unsigned xb_xcc_id() { return (unsigned)__builtin_amdgcn_s_getreg((3 << 11) | 20) & 0xFu; }
#define XB_SPIN(cond, bar) do { unsigned _sp = 0; while (cond) { __builtin_amdgcn_s_sleep(1); \
    if ((++_sp & 255u) == 0u) { if (xb_ld(&(bar)[XB_TMO])) break; if (_sp > XB_SPIN_CAP) { atomicAdd(&(bar)[XB_TMO], 1u); break; } } } } while (0)
struct XcdBarrier { unsigned* bar; unsigned x; volatile LAS unsigned* st; };
__device__ __forceinline__ XcdBarrier xcd_barrier_post(unsigned* bar, volatile LAS unsigned* st) {
    XcdBarrier b; b.bar = bar; b.x = xb_xcc_id(); b.st = st;
    if (threadIdx.x == 0) (void)xb_add(&bar[XB_XCNT(b.x)], 1u);
    return b;
}
__device__ __forceinline__ void xcd_barrier_complete(unsigned* bar, unsigned x, unsigned& nloc, unsigned& nx) {
    const unsigned G = gridDim.x * gridDim.y * gridDim.z;
    unsigned sum, cnt, mine, sp = 0u;
    for (;;) {
        sum = 0u; cnt = 0u; mine = 0u;
#pragma unroll
        for (unsigned j = 0; j < 16; ++j) { const unsigned c = xb_ld(&bar[XB_XCNT(j)]); sum += c; cnt += (c > 0u) ? 1u : 0u; mine = (j == x) ? c : mine; }
        if (sum == G) break;
        __builtin_amdgcn_s_sleep(1);
        if ((++sp & 255u) == 0u) { if (xb_ld(&bar[XB_TMO])) break; if (sp > XB_SPIN_CAP) { atomicAdd(&bar[XB_TMO], 1u); break; } }
    }
    nloc = mine > 0u ? mine : 1u; nx = cnt > 0u ? cnt : 1u;
}
__device__ __forceinline__ void xcd_barrier(const XcdBarrier& b) {
    asm volatile("s_waitcnt vmcnt(0)" ::: "memory");
    __syncthreads();
    if (threadIdx.x == 0) {
        unsigned* bar = b.bar;
        __builtin_amdgcn_s_waitcnt(0);
        unsigned nloc = b.st[0], nx = b.st[1];
        if (nloc == 0u) { xcd_barrier_complete(bar, b.x, nloc, nx); b.st[0] = nloc; b.st[1] = nx; }
        const unsigned old = xb_add(&bar[XB_XSUB(b.x)], 1u);
        const unsigned gen = old / nloc;
        if (old + 1u == (gen + 1u) * nloc) {
            __builtin_amdgcn_fence(__ATOMIC_RELEASE, "agent");
            asm volatile("s_waitcnt vmcnt(0)" ::: "memory");
            const unsigned og = xb_add(&bar[XB_TOP], 1u);
            const unsigned tg = og / nx;
            if (og + 1u == (tg + 1u) * nx) xb_add(&bar[XB_TOPGEN], 1u);
            else XB_SPIN(xb_ld(&bar[XB_TOPGEN]) == tg, bar);
            __builtin_amdgcn_fence(__ATOMIC_ACQUIRE, "agent");
            xb_add(&bar[XB_XGEN(b.x)], 1u);
            asm volatile("s_waitcnt vmcnt(0)" ::: "memory");
        } else {
            XB_SPIN(xb_ld(&bar[XB_XGEN(b.x)]) == gen, bar);
            __builtin_amdgcn_fence(__ATOMIC_ACQUIRE, "agent");
            asm volatile("s_waitcnt vmcnt(0)" ::: "memory");
        }
    }
    __syncthreads();
}

__device__ __forceinline__ void quad_barrier(unsigned* cnt, unsigned target, bool same_xcd, unsigned* bar) {
    asm volatile("s_waitcnt vmcnt(0)" ::: "memory");
    __syncthreads();
    if (threadIdx.x == 0) {
        if (!same_xcd) { __builtin_amdgcn_fence(__ATOMIC_RELEASE, "agent"); asm volatile("s_waitcnt vmcnt(0)" ::: "memory"); }
        (void)xb_add(cnt, 1u);
        XB_SPIN(xb_ld(cnt) < target, bar);
        __builtin_amdgcn_fence(__ATOMIC_ACQUIRE, "agent");
        asm volatile("s_waitcnt vmcnt(0)" ::: "memory");
    }
    __syncthreads();
}

struct Frame {
    LAS unsigned char* lds;
    unsigned* ctl;
    int tid, lane, wave, vcu, G;
    unsigned char* wsp; const float* const* in; float* out;
};
#define FIN(k) (F.in[k])
#define FWS(T, off) ((T*)(F.wsp + (off)))

__device__ __forceinline__ void p0_transpose_item(const float* W, int K, int N, int ldw, bf16* WT, int mode, LAS float* scr, int item, int lane) {
    const int nblk = N / 32, kb = item / nblk, nb = item % nblk, k0 = 64 * kb, n0 = 32 * nb;
    float tv[32];
#pragma unroll
    for (int i = 0; i < 32; ++i) { const int kk = 2 * i + (lane >> 5); tv[i] = __builtin_nontemporal_load(W + (size_t)(k0 + kk) * ldw + n0 + (lane & 31)); }
#pragma unroll
    for (int i = 0; i < 32; ++i) { const int kk = 2 * i + (lane >> 5); scr[kk * 33 + (lane & 31)] = tv[i]; }
    LDS_WAIT(); asm volatile("" ::: "memory");
    const int c = lane & 7;
    const int rowbase = (mode == 0) ? n0 : ((n0 >> 7) * 256 + (n0 & 127) + (mode == 2 ? 128 : 0));
#pragma unroll
    for (int j = 0; j < 4; ++j) { const int n = (lane >> 3) + 8 * j; const LAS float* s = scr + (8 * c) * 33 + n;
        v4u o; o.x = cvt_pk_bf16(s[0 * 33], s[1 * 33]); o.y = cvt_pk_bf16(s[2 * 33], s[3 * 33]); o.z = cvt_pk_bf16(s[4 * 33], s[5 * 33]); o.w = cvt_pk_bf16(s[6 * 33], s[7 * 33]);
        *(GAS v4u*)(WT + (size_t)(rowbase + n) * K + k0 + 8 * c) = o; }
    LDS_WAIT(); asm volatile("" ::: "memory");
}
__device__ __forceinline__ void p0_transpose_item8(const float* W, int K, int N, int ldw, unsigned char* WT, int mode, float scale, LAS float* scr, int item, int lane) {
    const int nblk = N / 32, kb = item / nblk, nb = item % nblk, k0 = 64 * kb, n0 = 32 * nb;
    float tv[32];
#pragma unroll
    for (int i = 0; i < 32; ++i) { const int kk = 2 * i + (lane >> 5); tv[i] = __builtin_nontemporal_load(W + (size_t)(k0 + kk) * ldw + n0 + (lane & 31)); }
#pragma unroll
    for (int i = 0; i < 32; ++i) { const int kk = 2 * i + (lane >> 5); scr[kk * 33 + (lane & 31)] = tv[i] * scale; }
    LDS_WAIT(); asm volatile("" ::: "memory");
    const int c = lane & 3;
    const int rowbase = (mode == 0) ? n0 : ((n0 >> 7) * 256 + (n0 & 127) + (mode == 2 ? 128 : 0));
#pragma unroll
    for (int j = 0; j < 2; ++j) { const int n = (lane >> 2) + 16 * j; const LAS float* sp = scr + (16 * c) * 33 + n;
        v4u o; o.x = pk4_fp8(sp[0 * 33], sp[1 * 33], sp[2 * 33], sp[3 * 33]); o.y = pk4_fp8(sp[4 * 33], sp[5 * 33], sp[6 * 33], sp[7 * 33]);
        o.z = pk4_fp8(sp[8 * 33], sp[9 * 33], sp[10 * 33], sp[11 * 33]); o.w = pk4_fp8(sp[12 * 33], sp[13 * 33], sp[14 * 33], sp[15 * 33]);
        *(GAS v4u*)(WT + (size_t)(rowbase + n) * K + k0 + 16 * c) = o; }
    LDS_WAIT(); asm volatile("" ::: "memory");
}
template <int NR> __device__ __forceinline__ void rms_rows_to_bf16(int lane, const float* xrow0, size_t rstride, const float* gain, bf16* orow0, unsigned char* o8row0) {
    f32x4 v[NR][4]; float rstd[NR];
#pragma unroll
    for (int r = 0; r < NR; ++r) { const GAS f32x4* xr = (const GAS f32x4*)(xrow0 + r * rstride) + lane;
#pragma unroll
        for (int j = 0; j < 4; ++j) v[r][j] = __builtin_nontemporal_load(xr + 64 * j); }
    const GAS f32x4* gr = (const GAS f32x4*)gain + lane; f32x4 g[4];
#pragma unroll
    for (int j = 0; j < 4; ++j) g[j] = gr[64 * j];
#pragma unroll
    for (int r = 0; r < NR; ++r) { float s = 0.f;
#pragma unroll
        for (int j = 0; j < 4; ++j) s += (v[r][j].x * v[r][j].x + v[r][j].y * v[r][j].y) + (v[r][j].z * v[r][j].z + v[r][j].w * v[r][j].w);
        rstd[r] = rsqrtf(wave_sum(s) * (1.f / D_) + EPS_); }
#pragma unroll
    for (int r = 0; r < NR; ++r) { GAS v2u* o8 = (GAS v2u*)(orow0 + r * rstride) + lane;
#pragma unroll
        for (int j = 0; j < 4; ++j) { const f32x4 h = v[r][j] * rstd[r] * g[j]; v2u o; o.x = cvt_pk_bf16(h.x, h.y); o.y = cvt_pk_bf16(h.z, h.w); o8[64 * j] = o;
            ((GAS unsigned*)(o8row0 + r * rstride))[lane + 64 * j] = pk4_fp8(h.x, h.y, h.z, h.w); } }
}
__device__ __forceinline__ void p0_prologue(Frame& F) {
    LAS float* scr = (LAS float*)(F.lds + RING_OFF + F.wave * 16384);
    const int gw = F.vcu * 8 + F.wave, NGW = F.G * 8;
    constexpr int I_IN = 16 * 32, I_QKV = 16 * 24, I_GA = 16 * 32, I_A = 8 * 32, I_O = 16 * 32, I_DENSE = I_IN + I_QKV + 2 * I_GA + 2 * I_A + I_O;
    for (int it = gw; it < I_DENSE; it += NGW) {
        int r = it;
        if (r < I_IN) { p0_transpose_item(FIN(2) + 768, D_, 1024, INC_, FWS(bf16, WS_WIN), 0, scr, r, F.lane); continue; } r -= I_IN;
        if (r < I_QKV) { p0_transpose_item8(FIN(2), D_, 768, INC_, FWS(unsigned char, WS_WIN8Q), 0, 32.0f, scr, r, F.lane); continue; } r -= I_QKV;
        if (r < I_GA) { p0_transpose_item8(FIN(2) + 1792, D_, 1024, INC_, FWS(unsigned char, WS_WIN8), 1, 32.0f, scr, r, F.lane); continue; } r -= I_GA;
        if (r < I_GA) { p0_transpose_item8(FIN(2) + 2816, D_, 1024, INC_, FWS(unsigned char, WS_WIN8), 2, 32.0f, scr, r, F.lane); continue; } r -= I_GA;
        if (r < I_A) { p0_transpose_item(FIN(8), 512, D_, D_, FWS(bf16, WS_WA), 0, scr, r, F.lane); continue; } r -= I_A;
        if (r < I_A) { p0_transpose_item(FIN(9), 512, D_, D_, FWS(bf16, WS_WG), 0, scr, r, F.lane); continue; } r -= I_A;
        p0_transpose_item(FIN(10), D_, D_, D_, FWS(bf16, WS_WOUT), 0, scr, r, F.lane);
    }
    const int gt = F.vcu * 512 + F.tid, NGT = F.G * 512;
    for (int i = gt; i < 48 * 1024; i += NGT) { const int o = i >> 10, k = i & 1023; float v = 0.f; if (o < 4) v = FIN(12)[k * 4 + o]; else if (o < 36) v = FIN(14)[k * 32 + (o - 4)];
        FWS(bf16, WS_WR)[i] = (bf16)(cvt_pk_bf16(v, 0.f) & 0xffffu); }
    for (int i = gt; i < 8 * 128 * 128; i += NGT) { const int p = i & 127, q = (i >> 7) & 127; const float v = (p <= q) ? FIN(6)[i] : 0.f; FWS(bf16, WS_WM)[i] = (bf16)(cvt_pk_bf16(v, 0.f) & 0xffffu); }
    for (int i = gt; i < SEQ_ * 8; i += NGT) { const int pos = i >> 3, j = i & 7; const float inv = powf(500000.0f, -(float)(2 * j) / 16.0f); const float ang = (float)pos * inv;
        FWS(float, WS_ROPE)[pos * 16 + j] = cosf(ang); FWS(float, WS_ROPE)[pos * 16 + 8 + j] = sinf(ang); }
    for (int m = 4 * gw; m < T_; m += 4 * NGW) rms_rows_to_bf16<4>(F.lane, FIN(0) + (size_t)m * D_, (size_t)D_, FIN(1), FWS(bf16, WS_XN) + (size_t)m * D_, FWS(unsigned char, WS_XN8) + (size_t)m * D_);
}

__device__ __forceinline__ void attn_load(Frame& F, int au, v4u (&kv)[4], v4u (&vv)[4], bf16x8 (&qf)[2][2][2]) {
    const int tid = F.tid, lane = F.lane, w = F.wave;
    const int hk = au & 1, n = (au >> 1) & 15, b = au >> 5;
#pragma unroll
    for (int it = 0; it < 4; ++it) { const int q = it * 512 + tid, kr = q >> 3, c16 = q & 7;
        int rel = 128 * (n - 1) + kr; if (rel < 0) rel = 0;
        const size_t trow = (size_t)(b * SEQ_ + rel);
        kv[it] = *(const GAS v4u*)(FWS(bf16, WS_K) + trow * 128 + hk * 64 + c16 * 8);
        vv[it] = *(const GAS v4u*)(FWS(bf16, WS_V) + trow * 128 + hk * 64 + c16 * 8); }
    const int hq = 4 * hk + (w >> 1), qh = w & 1, c = lane & 15, g = lane >> 4, tok0 = b * SEQ_ + 128 * n;
#pragma unroll
    for (int gi = 0; gi < 2; ++gi)
#pragma unroll
        for (int qt = 0; qt < 2; ++qt)
#pragma unroll
            for (int sx = 0; sx < 2; ++sx) qf[gi][qt][sx] = *(const GAS bf16x8*)(FWS(bf16, WS_Q) + (size_t)(tok0 + 64 * qh + 32 * gi + 16 * qt + c) * 512 + hq * 64 + 32 * sx + 8 * g);
}
template <bool FIRST>
__device__ __forceinline__ void attn_unit(Frame& F, int au, const bf16x8 (&qc)[2][2][2]) {
    const int lane = F.lane, w = F.wave;
    const int hk = au & 1, n = (au >> 1) & 15, b = au >> 5;
    const int tok0 = b * SEQ_ + 128 * n;
    LAS unsigned char* Kl = F.lds;
    LAS unsigned char* Vl = F.lds + 36864;
    const int hq = 4 * hk + (w >> 1), qh = w & 1, c = lane & 15, g = lane >> 4, qq = c >> 2, pp = c & 3;
    const float sink2 = FIN(3)[hq] * LOG2E;
#pragma unroll 1
    for (int gi = 0; gi < 2; ++gi) {
        const int q0 = 64 * qh + 32 * gi;
        bf16x8 qf[2][2];
#pragma unroll
        for (int qt = 0; qt < 2; ++qt)
#pragma unroll
            for (int s = 0; s < 2; ++s) qf[qt][s] = gi ? qc[1][qt][s] : qc[0][qt][s];
        f32x4 S[10][2];
#pragma unroll
        for (int kt = 0; kt < 10; ++kt) { S[kt][0] = (f32x4){0.f, 0.f, 0.f, 0.f}; S[kt][1] = (f32x4){0.f, 0.f, 0.f, 0.f}; }
#pragma unroll
        for (int kt = 0; kt < 10; ++kt)
#pragma unroll
            for (int s = 0; s < 2; ++s) { const bf16x8 kf = *(const LAS bf16x8*)(Kl + (q0 + 16 * kt + c) * 144 + 64 * s + 16 * g);
                S[kt][0] = mfma16(kf, qf[0][s], S[kt][0]); S[kt][1] = mfma16(kf, qf[1][s], S[kt][1]); }
        float inv[2];
#pragma unroll
        for (int qt = 0; qt < 2; ++qt) {
            float m = sink2;
#pragma unroll
            for (int kt = 0; kt < 10; ++kt) {
                const int d = kt - qt;
                if (d < 0 || d > 8) continue;
#pragma unroll
                for (int i = 0; i < 4; ++i) { bool valid = true;
                    if (d == 0 || d == 8) { const int relp = 16 * d + 4 * g + i - c; valid = (relp >= 1) && (relp <= 128); }
                    if (FIRST) valid = valid && (q0 + 16 * kt + 4 * g + i >= 128);
                    const float s = valid ? S[kt][qt][i] : -1e30f; S[kt][qt][i] = s; m = fmaxf(m, s); } }
            m = fmaxf(m, __shfl_xor(m, 16)); m = fmaxf(m, __shfl_xor(m, 32));
            float sum = 0.f;
#pragma unroll
            for (int kt = 0; kt < 10; ++kt) { const int d = kt - qt;
#pragma unroll
                for (int i = 0; i < 4; ++i) { const float p = (d < 0 || d > 8) ? 0.f : fast_exp2(S[kt][qt][i] - m); S[kt][qt][i] = p; sum += p; } }
            sum += __shfl_xor(sum, 16); sum += __shfl_xor(sum, 32);
            inv[qt] = 1.0f / (sum + fast_exp2(sink2 - m));
        }
        f32x4 O[4][2];
#pragma unroll
        for (int dt = 0; dt < 4; ++dt) { O[dt][0] = (f32x4){0.f, 0.f, 0.f, 0.f}; O[dt][1] = (f32x4){0.f, 0.f, 0.f, 0.f}; }
#pragma unroll
        for (int ks = 0; ks < 5; ++ks) {
            bf16x8 pf[2];
#pragma unroll
            for (int qt = 0; qt < 2; ++qt) { const v4u pw = {cvt_pk_bf16(S[2 * ks][qt][0], S[2 * ks][qt][1]), cvt_pk_bf16(S[2 * ks][qt][2], S[2 * ks][qt][3]),
                                                              cvt_pk_bf16(S[2 * ks + 1][qt][0], S[2 * ks + 1][qt][1]), cvt_pk_bf16(S[2 * ks + 1][qt][2], S[2 * ks + 1][qt][3])};
                pf[qt] = __builtin_bit_cast(bf16x8, pw); }
            const int r1 = q0 + 32 * ks + 4 * g + qq, r2 = r1 + 16;
#pragma unroll
            for (int dt = 0; dt < 4; ++dt) {
                const s16x4 lo = vtr(Vl + r1 * 128 + ((dt ^ ((r1 >> 1) & 3)) * 32) + pp * 8);
                const s16x4 hi = vtr(Vl + r2 * 128 + ((dt ^ ((r2 >> 1) & 3)) * 32) + pp * 8);
                const bf16x8 af = (bf16x8){lo[0], lo[1], lo[2], lo[3], hi[0], hi[1], hi[2], hi[3]};
                O[dt][0] = mfma16(af, pf[0], O[dt][0]); O[dt][1] = mfma16(af, pf[1], O[dt][1]); }
        }
#pragma unroll
        for (int qt = 0; qt < 2; ++qt) { bf16* orow = FWS(bf16, WS_AO) + (size_t)(tok0 + q0 + 16 * qt + c) * 512 + hq * 64 + 4 * g;
#pragma unroll
            for (int dt = 0; dt < 4; ++dt) { const f32x4 o = O[dt][qt] * inv[qt]; v2u wv; wv.x = cvt_pk_bf16(o[0], o[1]); wv.y = cvt_pk_bf16(o[2], o[3]); *(GAS v2u*)(orow + 16 * dt) = wv; } }
    }
}
__device__ __forceinline__ int attn_unit_id(const Frame& F, int q) {
    const int pm = F.vcu + (q >> 2) * F.G, j = q & 3; if (pm >= T_ / 256) return -1;
    return ((pm >> 3) << 5) | ((2 * (pm & 7) + (j >> 1)) << 1) | (j & 1);
}
__device__ __forceinline__ void attn_phase(Frame& F) {
    int q = 0, a = attn_unit_id(F, 0); if (a < 0) return;
    LAS unsigned char* Kl = F.lds; LAS unsigned char* Vl = F.lds + 36864;
    v4u kv[4], vv[4]; bf16x8 qf[2][2][2];
    attn_load(F, a, kv, vv, qf);
    for (;;) {
#pragma unroll
        for (int it = 0; it < 4; ++it) { const int qi = it * 512 + F.tid, kr = qi >> 3, c16 = qi & 7;
            *(LAS v4u*)(Kl + kr * 144 + c16 * 16) = kv[it];
            *(LAS v4u*)(Vl + kr * 128 + (((c16 >> 1) ^ ((kr >> 1) & 3)) * 32) + (c16 & 1) * 16) = vv[it]; }
        bf16x8 qc[2][2][2];
#pragma unroll
        for (int gi = 0; gi < 2; ++gi)
#pragma unroll
            for (int qt = 0; qt < 2; ++qt)
#pragma unroll
                for (int sx = 0; sx < 2; ++sx) qc[gi][qt][sx] = qf[gi][qt][sx];
        __syncthreads();
        const int an = attn_unit_id(F, q + 1); const bool has_next = an >= 0;
        if (has_next) attn_load(F, an, kv, vv, qf);
        if (((a >> 1) & 15) == 0) attn_unit<true>(F, a, qc); else attn_unit<false>(F, a, qc);
        __syncthreads();
        if (!has_next) break;
        a = an; ++q;
    }
}
template <int H> __device__ __forceinline__ void gmlp_half(Frame& F, LAS unsigned char* tile, int tb, int w, int lane) {
    const int c = lane & 15, g = lane >> 4, qq = c >> 2, pp = c & 3;
    f32x4 acc[4][4];
#pragma unroll
    for (int dt = 0; dt < 4; ++dt)
#pragma unroll
        for (int q4 = 0; q4 < 4; ++q4) acc[dt][q4] = (f32x4){0.f, 0.f, 0.f, 0.f};
    const bf16* Wg = FWS(bf16, WS_WM) + (size_t)w * 128 * 128;
    v2u uw[4][4];
#pragma unroll
    for (int q4 = 0; q4 < 4; ++q4)
#pragma unroll
        for (int dt = 0; dt < 4; ++dt) uw[q4][dt] = *(const GAS v2u*)(FWS(bf16, WS_Z) + (size_t)(tb + 16 * (4 * H + q4) + c) * 1024 + 64 * w + 4 * g + 16 * dt);
#pragma unroll
    for (int ks = 0; ks < 2 + 2 * H; ++ks) {
        bf16x8 af[4];
        const int r1 = 32 * ks + 4 * g + qq, r2 = r1 + 16;
#pragma unroll
        for (int dt = 0; dt < 4; ++dt) { const s16x4 lo = vtr(tile + r1 * 128 + ((dt ^ ((r1 >> 1) & 3)) * 32) + pp * 8), hi = vtr(tile + r2 * 128 + ((dt ^ ((r2 >> 1) & 3)) * 32) + pp * 8);
            af[dt] = (bf16x8){lo[0], lo[1], lo[2], lo[3], hi[0], hi[1], hi[2], hi[3]}; }
#pragma unroll
        for (int q4 = 0; q4 < 4; ++q4) { const int qt = 4 * H + q4;
            if (2 * ks <= qt) {
                const v2u b0 = *(const GAS v2u*)(Wg + (size_t)(16 * qt + c) * 128 + 32 * ks + 4 * g), b1 = *(const GAS v2u*)(Wg + (size_t)(16 * qt + c) * 128 + 32 * ks + 16 + 4 * g);
                const v4u bw = {b0.x, b0.y, b1.x, b1.y}; const bf16x8 bf = __builtin_bit_cast(bf16x8, bw);
#pragma unroll
                for (int dt = 0; dt < 4; ++dt) acc[dt][q4] = mfma16(af[dt], bf, acc[dt][q4]);
            } }
    }
#pragma unroll
    for (int q4 = 0; q4 < 4; ++q4) { const int q = 16 * (4 * H + q4) + c; const float bias = FIN(7)[w * 128 + q];
        const size_t off = (size_t)(tb + q) * 1024 + 64 * w + 4 * g; bf16* go = FWS(bf16, WS_GO) + (size_t)(tb + q) * 512 + 64 * w + 4 * g;
#pragma unroll
        for (int dt = 0; dt < 4; ++dt) { const v2u uq = uw[q4][dt];
            const f32x4 mx = acc[dt][q4] + bias; v2u o; o.x = cvt_pk_bf16(bf_lo(uq.x) * mx[0], bf_hi(uq.x) * mx[1]); o.y = cvt_pk_bf16(bf_lo(uq.y) * mx[2], bf_hi(uq.y) * mx[3]);
            *(GAS v2u*)(go + 16 * dt) = o; } }
}
__device__ __forceinline__ void gmlp_load(Frame& F, int cu, v4u (&sl)[16]) {
    const int lane = F.lane, w = F.wave, c16 = lane & 7, ch0 = 64 * w + 8 * c16, p0 = lane >> 3;
    const GAS char* zb = (const GAS char*)(FWS(bf16, WS_Z) + (size_t)cu * 128 * 1024 + 512);
    const unsigned lo_s = (unsigned)(p0 * 2048 + ch0 * 2);
#pragma unroll
    for (int it = 0; it < 16; ++it) sl[it] = *(const GAS v4u*)(zb + it * 16384 + (size_t)lo_s);
}
__device__ __forceinline__ void gmlp_front(Frame& F, v4u (&sl)[16]) {
    const int lane = F.lane, w = F.wave, c16 = lane & 7, ch0 = 64 * w + 8 * c16, p0 = lane >> 3;
    LAS f32x2* stats = (LAS f32x2*)(F.lds + TAB_GATHER);
    LAS f32x2* part = stats + 128;
    LAS unsigned char* tile = F.lds + w * 16384;
    LAS f32x2* pw = part + w * 128 + p0;
#pragma unroll
    for (int it = 0; it < 16; ++it) { f32x4 a, bq; pg8::unpack8(sl[it], a, bq);
        float sm = ((a[0] + a[1]) + (a[2] + a[3])) + ((bq[0] + bq[1]) + (bq[2] + bq[3]));
        float sq = ((a[0] * a[0] + a[1] * a[1]) + (a[2] * a[2] + a[3] * a[3])) + ((bq[0] * bq[0] + bq[1] * bq[1]) + (bq[2] * bq[2] + bq[3] * bq[3]));
        sm += dpp_f<0xB1>(sm); sq += dpp_f<0xB1>(sq); sm += dpp_f<0x4E>(sm); sq += dpp_f<0x4E>(sq); sm += dpp_f<0x141>(sm); sq += dpp_f<0x141>(sq);
        if (c16 == 0) pw[8 * it] = (f32x2){sm, sq}; }
#pragma unroll
    for (int it = 0; it < 16; ++it) asm volatile("" : "+v"(sl[it]));
    __syncthreads();
    {   const int r = 16 * w + (lane >> 2), j = lane & 3;
        const f32x2 pa = part[j * 128 + r], pb = part[(j + 4) * 128 + r];
        float sm = pa.x + pb.x, sq = pa.y + pb.y;
        sm += dpp_f<0xB1>(sm); sq += dpp_f<0xB1>(sq); sm += dpp_f<0x4E>(sm); sq += dpp_f<0x4E>(sq);
        const float mean = sm * (1.f / 512.f), var = fmaxf(sq * (1.f / 512.f) - mean * mean, 0.f);
        if (j == 0) stats[r] = (f32x2){mean, rsqrtf(var + EPS_)}; }
    __syncthreads();
    const f32x4 lg0 = *(const f32x4*)(FIN(4) + ch0), lg1 = *(const f32x4*)(FIN(4) + ch0 + 4), lb0 = *(const f32x4*)(FIN(5) + ch0), lb1 = *(const f32x4*)(FIN(5) + ch0 + 4);
    const LAS f32x2* sp = stats + p0;
    LAS unsigned char* tp = tile + p0 * 128 + (((c16 >> 1) ^ ((p0 >> 1) & 3)) * 32) + (c16 & 1) * 16;
#pragma unroll
    for (int it = 0; it < 16; ++it) {
        f32x4 a, bq; pg8::unpack8(sl[it], a, bq); const f32x2 st = sp[8 * it];
        a = (a - st.x) * st.y * lg0 + lb0; bq = (bq - st.x) * st.y * lg1 + lb1;
        *(LAS v4u*)(tp + 1024 * it) = pg8::pack8(a, bq); }
    LDS_WAIT(); asm volatile("" ::: "memory");
}
__device__ __forceinline__ void gmlp_back(Frame& F, int cu) {
    LAS unsigned char* tile = F.lds + F.wave * 16384;
    gmlp_half<0>(F, tile, cu * 128, F.wave, F.lane);
    gmlp_half<1>(F, tile, cu * 128, F.wave, F.lane);
}
__device__ __forceinline__ void gmlp_pair(Frame& F, int cu) {
    v4u sa[16], sb[16];
    gmlp_load(F, cu, sa);
    gmlp_front(F, sa);
    gmlp_back(F, cu);
    __syncthreads();
    gmlp_load(F, cu + 1, sb);
    gmlp_front(F, sb);
    gmlp_back(F, cu + 1);
    __syncthreads();
}

__device__ __forceinline__ void router_phase(Frame& F) {
    const int tid = F.tid, lane = F.lane, w = F.wave;
    LAS unsigned char* wrl = F.lds;
    LAS float* g2l = (LAS float*)(F.lds + 99328);
    LAS float* lgw = (LAS float*)(F.lds + 103424) + w * 800;
    LAS unsigned* lcnt = (LAS unsigned*)(F.lds + 129024);
    LAS unsigned* lbase = (LAS unsigned*)(F.lds + 129024 + 128);
    for (int i = tid; i < 48 * 128; i += 512) { const int row = i >> 7, ch = i & 127;
        *(LAS v4u*)(wrl + row * 2064 + ch * 16) = *(const GAS v4u*)(FWS(bf16, WS_WR) + (size_t)row * 1024 + ch * 8); }
    for (int i = tid; i < 1024; i += 512) g2l[i] = FIN(11)[i];
    if (tid < 32) lcnt[tid] = 0u;
    __syncthreads();
    const int c = lane & 15, g = lane >> 4;
    for (int bq = w; bq < 16 * ((T_ / 256 - F.vcu + F.G - 1) / F.G); bq += 8) { const int bi = 16 * (F.vcu + (bq >> 4) * F.G) + (bq & 15);
        const int t0 = bi * 16;
        const GAS v4u* xrow = (const GAS v4u*)(FWS(bf16, WS_X1) + (size_t)(t0 + c) * 1024) + g;
        GAS v2u* hrow = (GAS v2u*)(FWS(unsigned char, WS_H2) + (size_t)(t0 + c) * 1024) + g;
        v4u xr[32]; float ss = 0.f;
#pragma unroll
        for (int s = 0; s < 32; ++s) xr[s] = xrow[4 * s];
#pragma unroll
        for (int s = 0; s < 32; ++s) { f32x4 a, bq; pg8::unpack8(xr[s], a, bq); ss += (a[0] * a[0] + a[1] * a[1]) + (a[2] * a[2] + a[3] * a[3]) + (bq[0] * bq[0] + bq[1] * bq[1]) + (bq[2] * bq[2] + bq[3] * bq[3]); }
#pragma unroll
        for (int s = 0; s < 32; ++s) asm volatile("" : "+v"(xr[s]));
        ss += __shfl_xor(ss, 16); ss += __shfl_xor(ss, 32);
        const float rstd = rsqrtf(ss * (1.f / D_) + EPS_);
        f32x4 acc[3] = {(f32x4){0.f, 0.f, 0.f, 0.f}, (f32x4){0.f, 0.f, 0.f, 0.f}, (f32x4){0.f, 0.f, 0.f, 0.f}};
        const LAS unsigned char* wl = wrl + c * 2064 + g * 16; const LAS unsigned char* wl2 = wl + 2 * 16 * 2064;
#pragma unroll
        for (int s = 0; s < 32; ++s) {
            f32x4 a, bq; pg8::unpack8(xr[s], a, bq);
            const f32x4 ga = *(const LAS f32x4*)(g2l + 32 * s + 8 * g), gb = *(const LAS f32x4*)(g2l + 32 * s + 8 * g + 4);
            const f32x4 ha = a * rstd * ga, hb = bq * rstd * gb;
            const v4u hw = pg8::pack8(ha, hb);
            { v2u h8; h8.x = pk4_fp8(ha[0], ha[1], ha[2], ha[3]); h8.y = pk4_fp8(hb[0], hb[1], hb[2], hb[3]); hrow[4 * s] = h8; }
            const bf16x8 af = __builtin_bit_cast(bf16x8, hw);
#pragma unroll
            for (int ot = 0; ot < 3; ++ot) { const bf16x8 bfr = *(const LAS bf16x8*)((ot == 2 ? wl2 : wl + ot * 16 * 2064) + 64 * s); acc[ot] = mfma16(af, bfr, acc[ot]); }
            if ((s & 1) == 1) asm volatile("" ::: "memory");
        }
#pragma unroll
        for (int ot = 0; ot < 3; ++ot)
#pragma unroll
            for (int i = 0; i < 4; ++i) lgw[(4 * g + i) * 49 + 16 * ot + c] = acc[ot][i];
        LDS_WAIT(); asm volatile("" ::: "memory");
        {
            const LAS float* lg = lgw + c * 49;
            float gl[4]; int gsel = 0; float gmax;
#pragma unroll
            for (int j = 0; j < 4; ++j) gl[j] = lg[j] + FIN(13)[j];
            gmax = gl[0];
#pragma unroll
            for (int j = 1; j < 4; ++j) if (gl[j] > gmax) { gmax = gl[j]; gsel = j; }
            float den = 0.f;
#pragma unroll
            for (int j = 0; j < 4; ++j) den += expf(gl[j] - gmax);
            const float gwt = 1.0f / den;
            float el[8];
#pragma unroll
            for (int j = 0; j < 8; ++j) el[j] = lg[4 + 8 * gsel + j] + FIN(15)[8 * gsel + j];
            int i1 = 0; float l1 = el[0];
#pragma unroll
            for (int j = 1; j < 8; ++j) if (el[j] > l1) { l1 = el[j]; i1 = j; }
            int i2 = -1; float l2 = -3.0e38f;
#pragma unroll
            for (int j = 0; j < 8; ++j) if (j != i1 && el[j] > l2) { l2 = el[j]; i2 = j; }
            const float e21 = expf(l2 - l1); const float w0 = gwt / (1.0f + e21), w1 = gwt * e21 / (1.0f + e21);
            if (lane < 16) {
                const int t = t0 + lane, e0 = 8 * gsel + i1, e1 = 8 * gsel + i2;
                const unsigned p0 = __hip_atomic_fetch_add(lcnt + e0, 1u, __ATOMIC_RELAXED, __HIP_MEMORY_SCOPE_WORKGROUP);
                const unsigned p1 = __hip_atomic_fetch_add(lcnt + e1, 1u, __ATOMIC_RELAXED, __HIP_MEMORY_SCOPE_WORKGROUP);
                FWS(int, WS_TOKE)[2 * t] = e0; FWS(int, WS_TOKE)[2 * t + 1] = e1; FWS(float, WS_TOKW)[2 * t] = w0; FWS(float, WS_TOKW)[2 * t + 1] = w1; FWS(int, WS_TOKP)[2 * t] = (int)p0; FWS(int, WS_TOKP)[2 * t + 1] = (int)p1;
            }
        }
        LDS_WAIT(); asm volatile("" ::: "memory");
    }
    __syncthreads();
    if (tid < 32) lbase[tid] = __hip_atomic_fetch_add(F.ctl + CW_CNT + tid, lcnt[tid], RLX_AGENT);
    __syncthreads();
    for (int bq = w; bq < 16 * ((T_ / 256 - F.vcu + F.G - 1) / F.G); bq += 8) { const int bi = 16 * (F.vcu + (bq >> 4) * F.G) + (bq & 15);
        if (lane < 16) { const int t = bi * 16 + lane;
#pragma unroll
            for (int k = 0; k < 2; ++k) { const int e = FWS(int, WS_TOKE)[2 * t + k]; const int pos = (int)lbase[e] + FWS(int, WS_TOKP)[2 * t + k]; FWS(int, WS_TOKP)[2 * t + k] = pos; FWS(int, WS_LIST)[(size_t)e * T_ + pos] = t; } }
    }
}

__device__ __forceinline__ int moe_tables(Frame& F, int gather, bool reuse = false) {
    LAS int* s_cnt = (LAS int*)(F.lds + TAB_CNT); LAS int* s_tpre = (LAS int*)(F.lds + TAB_TPRE); LAS int* s_ul = (LAS int*)(F.lds + TAB_ULIST); LAS unsigned* s_tab = (LAS unsigned*)(F.lds + TAB_GATHER);
    __syncthreads();
    if (!reuse) {
        if (F.tid < 32) s_cnt[F.tid] = (int)__hip_atomic_load(F.ctl + CW_CNT + F.tid, RLX_AGENT);
        __syncthreads();
        if (F.tid == 0) { int a = 0; for (int e = 0; e < 32; ++e) { s_tpre[e] = a; a += (s_cnt[e] + 255) >> 8; } s_tpre[32] = a; }
        __syncthreads();
    }
    const int NT = s_tpre[32];
    const int tot = 4 * NT, R = tot / F.G, rem = tot - R * F.G;
    int ex = -1, prodq = F.vcu >> 2;
    if (F.G == 256) { const int x = F.vcu >> 5, a = (F.vcu >> 2) & 7, as = (gather == 2) ? ((a + 4) & 7) : a, e4 = 4 * (8 * as + x) + (F.vcu & 3); if (e4 < rem) { ex = e4; prodq = 8 * x + as; } }
    else if (F.vcu < rem) ex = F.vcu;
    const int n_main = R < MAX_UNITS - 1 ? R : MAX_UNITS - 1, nu = n_main + (ex >= 0 ? 1 : 0);
    if (F.tid < nu) { const int L = (F.tid < n_main) ? ((gather == 2) ? n_main - 1 - F.tid : F.tid) * F.G + F.vcu : R * F.G + ex, ti = L >> 2, pn = L & 3;       int e = 0; for (int j = 1; j < 32; ++j) if (s_tpre[j] <= ti) e = j; s_ul[F.tid] = (e << 16) | (ti << 2) | pn; }
    __syncthreads();
    if (gather == 2) {
        for (int idx = F.tid; idx < nu * 256; idx += 512) { const int wd = s_ul[idx >> 8]; s_tab[idx] = (unsigned)(256 * ((wd >> 2) & 0x3fff) + (idx & 255)) * 512u; }
        __syncthreads();
    } else if (gather == 1) {
        for (int idx = F.tid; idx < nu * 256; idx += 512) { const int i = idx >> 8, r = idx & 255; const int wd = s_ul[i]; const int e = wd >> 16, ti = (wd >> 2) & 0x3fff;
            int rr = 256 * (ti - s_tpre[e]) + r; if (rr >= s_cnt[e]) rr = s_cnt[e] - 1;
            s_tab[idx] = (unsigned)FWS(int, WS_LIST)[(size_t)e * T_ + rr] * 1024u; }
        __syncthreads();
    }
    return nu | (n_main << 8) | (prodq << 16);
}

__device__ __forceinline__ void final_phase(Frame& F, bool fresh) {
    LAS int* s_tpre = (LAS int*)(F.lds + TAB_TPRE);
    if (fresh) (void)moe_tables(F, 0);
    const int gw = F.vcu * 8 + F.wave, NGW = F.G * 8, lane = F.lane;
    const GAS f32x4* gp = (const GAS f32x4*)FIN(19) + 2 * lane;
    f32x4 gfv[2][2];
#pragma unroll
    for (int j = 0; j < 2; ++j)
#pragma unroll
        for (int k = 0; k < 2; ++k) gfv[j][k] = gp[128 * j + k];
    constexpr int NR = 4;
    for (int tb = NR * gw; tb < T_; tb += NR * NGW) {
        v2u ev[NR], pv[NR]; f32x2 wv[NR];
#pragma unroll
        for (int r = 0; r < NR; ++r) { ev[r] = *(const GAS v2u*)(FWS(int, WS_TOKE) + 2 * (tb + r)); pv[r] = *(const GAS v2u*)(FWS(int, WS_TOKP) + 2 * (tb + r)); wv[r] = *(const GAS f32x2*)(FWS(float, WS_TOKW) + 2 * (tb + r)); }
        v4u xr[NR][2]; v2u ya[NR][2], yb[NR][2];
#pragma unroll
        for (int r = 0; r < NR; ++r) {
            const size_t r0 = (size_t)(256 * s_tpre[ev[r].x] + (int)pv[r].x), r1 = (size_t)(256 * s_tpre[ev[r].y] + (int)pv[r].y);
            const GAS v4u* xp = (const GAS v4u*)(FWS(bf16, WS_X1) + (size_t)(tb + r) * 1024) + lane; const GAS v2u* y0 = (const GAS v2u*)(FWS(unsigned char, WS_Y) + r0 * 1024) + lane; const GAS v2u* y1 = (const GAS v2u*)(FWS(unsigned char, WS_Y) + r1 * 1024) + lane;
#pragma unroll
            for (int j = 0; j < 2; ++j) { xr[r][j] = __builtin_nontemporal_load(xp + 64 * j); ya[r][j] = __builtin_nontemporal_load(y0 + 64 * j); yb[r][j] = __builtin_nontemporal_load(y1 + 64 * j); } }
#pragma unroll
        for (int r = 0; r < NR; ++r) {
            f32x4 v[2][2]; float ss = 0.f; const float w0 = wv[r].x * (1.0f / 16.0f), w1 = wv[r].y * (1.0f / 16.0f);
#pragma unroll
            for (int j = 0; j < 2; ++j) { f32x4 xa, xb, a0, b0, a1, b1; pg8::unpack8(xr[r][j], xa, xb); unpack8_fp8(ya[r][j], a0, b0); unpack8_fp8(yb[r][j], a1, b1);
                v[j][0] = xa + w0 * a0 + w1 * a1; v[j][1] = xb + w0 * b0 + w1 * b1;
#pragma unroll
                for (int k = 0; k < 2; ++k) ss += (v[j][k][0] * v[j][k][0] + v[j][k][1] * v[j][k][1]) + (v[j][k][2] * v[j][k][2] + v[j][k][3] * v[j][k][3]); }
            const float rstd = rsqrtf(wave_sum(ss) * (1.f / D_) + EPS_);
            GAS f32x4* op = (GAS f32x4*)(F.out + (size_t)(tb + r) * 1024) + 2 * lane;
#pragma unroll
            for (int j = 0; j < 2; ++j)
#pragma unroll
                for (int k = 0; k < 2; ++k) __builtin_nontemporal_store(v[j][k] * rstd * gfv[j][k], op + 128 * j + k);
        }
    }
}

struct ExpItem { const float* W; unsigned char* WT; int K, N, mode, item; float scale; };
__device__ __forceinline__ ExpItem exp_item(Frame& F, int it) {
    const int e = it / 768, q = it % 768;
    if (q < 256) return ExpItem{FIN(16) + (size_t)e * D_ * DEXP, FWS(unsigned char, WS_WGU) + (size_t)e * D_ * D_, D_, DEXP, 1, q, 32.0f};
    if (q < 512) return ExpItem{FIN(17) + (size_t)e * D_ * DEXP, FWS(unsigned char, WS_WGU) + (size_t)e * D_ * D_, D_, DEXP, 2, q - 256, 32.0f};
    return ExpItem{FIN(18) + (size_t)e * DEXP * D_, FWS(unsigned char, WS_WD) + (size_t)e * D_ * DEXP, DEXP, D_, 0, q - 512, 16.0f};
}
__device__ __forceinline__ void exp_item_load(const ExpItem& d, int lane, float (&tv)[32]) {
    const int nblk = d.N / 32, kb = d.item / nblk, nb = d.item % nblk;
    const float* wp = d.W + (size_t)(64 * kb) * d.N + 32 * nb + (size_t)(lane >> 5) * d.N + (lane & 31);
#pragma unroll
    for (int i = 0; i < 32; ++i) tv[i] = __builtin_nontemporal_load(wp + (size_t)(2 * i) * d.N);
}
__device__ __forceinline__ void exp_item_finish(const ExpItem& d, int lane, LAS float* scr, const float (&tv)[32]) {
    const int nblk = d.N / 32, kb = d.item / nblk, nb = d.item % nblk, k0 = 64 * kb, n0 = 32 * nb;
#pragma unroll
    for (int i = 0; i < 32; ++i) { const int kk = 2 * i + (lane >> 5); scr[kk * 33 + (lane & 31)] = tv[i] * d.scale; }
    LDS_WAIT(); asm volatile("" ::: "memory");
    const int c = lane & 3, rowbase = (d.mode == 0) ? n0 : ((n0 >> 7) * 256 + (n0 & 127) + (d.mode == 2 ? 128 : 0));
#pragma unroll
    for (int j = 0; j < 2; ++j) { const int n = (lane >> 2) + 16 * j; const LAS float* sp = scr + (16 * c) * 33 + n;
        v4u o; o.x = pk4_fp8(sp[0 * 33], sp[1 * 33], sp[2 * 33], sp[3 * 33]); o.y = pk4_fp8(sp[4 * 33], sp[5 * 33], sp[6 * 33], sp[7 * 33]);
        o.z = pk4_fp8(sp[8 * 33], sp[9 * 33], sp[10 * 33], sp[11 * 33]); o.w = pk4_fp8(sp[12 * 33], sp[13 * 33], sp[14 * 33], sp[15 * 33]);
        *(GAS v4u*)(d.WT + (size_t)(rowbase + n) * d.K + k0 + 16 * c) = o; }
    LDS_WAIT(); asm volatile("" ::: "memory");
}
__device__ __forceinline__ void conv_expert_items(Frame& F, int j0, int cnt) {
    LAS float* scr = (LAS float*)(F.lds + RING_OFF + F.wave * 16384);
    const int gw = F.vcu * 8 + F.wave, NGW = F.G * 8, NIT = NEXP * 768;
    __syncthreads();
    int j = j0; const int jend = j0 + cnt;
    if (j < jend && gw + j * NGW < NIT) {
        ExpItem cur = exp_item(F, gw + j * NGW); float tv[32]; exp_item_load(cur, F.lane, tv);
        for (;;) {
            const int jn = j + 1; const bool hn = (jn < jend) && (gw + jn * NGW < NIT); ExpItem nd = cur; float tn[32];
            if (hn) { nd = exp_item(F, gw + jn * NGW); exp_item_load(nd, F.lane, tn); }
            exp_item_finish(cur, F.lane, scr, tv);
            if (!hn) break;
            cur = nd; j = jn;
#pragma unroll
            for (int i = 0; i < 32; ++i) tv[i] = tn[i];
        }
    }
    __syncthreads();
}
constexpr int N_PHASES = 9;

struct Args { const float* in[20]; float* out; unsigned char* ws; int ph_lo, ph_hi, li, pad; };
__global__ void __launch_bounds__(512, 2) mk_fwd(Args args) {
    extern __shared__ __attribute__((aligned(16))) unsigned char lds[];
    Frame F;
    F.lds = (LAS unsigned char*)lds;
    F.tid = threadIdx.x; F.lane = F.tid & 63; F.wave = __builtin_amdgcn_readfirstlane(F.tid >> 6);
    F.G = gridDim.x; { const int bx = blockIdx.x; F.vcu = (F.G % 8 == 0) ? (bx % 8) * (F.G / 8) + bx / 8 : bx; }
    unsigned char* ws = args.ws;
    F.ctl = (unsigned*)(ws + WS_CTL);
    F.wsp = ws; F.in = args.in; F.out = args.out;
    for (int u = F.tid; u < 128; u += 512) ((LAS unsigned*)(F.lds + LDSCTL_OFF))[u] = 0u;
    __syncthreads();
    volatile LAS unsigned* MISC = (volatile LAS unsigned*)(F.lds + MISC_OFF);
    XcdBarrier bar; bar.bar = F.ctl + CW_BAR; bar.x = 0; bar.st = nullptr;
    if (MK_N_LAUNCHES == 1) bar = xcd_barrier_post(F.ctl + CW_BAR, MISC + 8);
    unsigned* const qw = F.ctl + CW_QUAD + 32 * (F.vcu >> 2);
    if (MK_N_LAUNCHES == 1 && F.tid == 0) (void)__hip_atomic_fetch_or(qw + 16, 1u << xb_xcc_id(), __ATOMIC_RELAXED, __HIP_MEMORY_SCOPE_AGENT);
    bool q_same = false, x_same = false;
    unsigned* const xw = F.ctl + CW_XLOC + 32 * (F.vcu >> 5);
    const bool xloc = (MK_N_LAUNCHES == 1) && (F.G == 256);
    if (xloc && F.tid == 0) (void)__hip_atomic_fetch_or(xw + 16, 1u << xb_xcc_id(), __ATOMIC_RELAXED, __HIP_MEMORY_SCOPE_AGENT);
#define QUAD_BAR(n) do { if (MK_N_LAUNCHES == 1) quad_barrier(qw, 4u * (n), q_same, F.ctl + CW_BAR); } while (0)
#define GRID_BAR() do { if (MK_N_LAUNCHES == 1) xcd_barrier(bar); } while (0)
    const int lo = args.ph_lo, hi = args.ph_hi;
#ifndef PH_MASK
#define PH_MASK 0x1ff
#endif
#define IN(k) (((PH_MASK >> (k)) & 1) && lo <= (k) && (k) < hi)
#define BOTH(k) (IN(k) && IN((k) + 1))
#define LOCAL_SEAM() do { asm volatile("s_waitcnt vmcnt(0)" ::: "memory"); __syncthreads(); } while (0)
    LAS unsigned char* ring = F.lds + RING_OFF; const LAS unsigned char* gtab = F.lds + TAB_GATHER;

    if (IN(0)) { p0_prologue(F); if (BOTH(0)) GRID_BAR(); }

    if (IN(1)) {
        { pg8::DenseOrder S; S.init(FWS(bf16, WS_XN), FWS(bf16, WS_WIN), T_, 1024, D_, F.G, (int)blockIdx.x);
          pg8::EpiInProj E{FWS(bf16, WS_Q), FWS(bf16, WS_K), FWS(bf16, WS_V), FWS(bf16, WS_Z), FWS(float, WS_ROPE), 3};
          pg8::gemm_phase<pg8::EpiInProj, pg8::DenseOrder, true, false>(ring, D_, S, E, gtab); }
        { pg8::DenseOrder S; S.init(FWS(unsigned char, WS_XN8), FWS(unsigned char, WS_WIN8Q), T_, 768 + 2048, D_ / 2, F.G, (int)blockIdx.x, true);
          { LAS unsigned* tab = (LAS unsigned*)(F.lds + TAB_GATHER);
            for (int idx = F.tid; idx < MAX_UNITS * 256; idx += 512) { pg8::Unit u; if (S.next(idx >> 8, u)) tab[idx] = (unsigned)(u.pm * 256 + (idx & 255)) * 1024u; }
            __syncthreads(); }
          pg8::EpiInProj8 E{pg8::EpiInProj{FWS(bf16, WS_Q), FWS(bf16, WS_K), FWS(bf16, WS_V), FWS(bf16, WS_Z), FWS(float, WS_ROPE), 0}, pg8::EpiGates{FWS(bf16, WS_SGA), FWS(bf16, WS_SGG)}};
          pg8::gemm_phase<pg8::EpiInProj8, pg8::DenseOrder, true, true, 122, 127>(ring, D_ / 2, S, E, gtab); }
        if (BOTH(1)) {
            if (xloc) { if (F.tid == 0) MISC[13] = (__builtin_popcount(xb_ld(xw + 16)) == 1) ? 1u : 0u; __syncthreads(); x_same = MISC[13] != 0u; quad_barrier(xw, 32u, x_same, F.ctl + CW_BAR); }
            else GRID_BAR();
        }
    }
    if (IN(2)) {
        if (MK_N_LAUNCHES == 1) { if (F.tid == 0) MISC[12] = (__builtin_popcount(xb_ld(qw + 16)) == 1) ? 1u : 0u; __syncthreads(); q_same = MISC[12] != 0u; }
#ifndef P2_SKIP_ATTN
        attn_phase(F);
#endif
#ifndef P2_SKIP_GMLP
        for (int pm = F.vcu; pm < T_ / 256; pm += F.G) gmlp_pair(F, 2 * pm);
#endif
        if (BOTH(2)) QUAD_BAR(1);
    }
    if (IN(3)) {
        pg8::DualOrder S; S.init(FWS(bf16, WS_AO), FWS(bf16, WS_WA), FWS(bf16, WS_GO), FWS(bf16, WS_WG), T_, D_, 512, F.G, F.vcu);
        pg8::EpiMixFused E{FWS(bf16, WS_MIX), FWS(bf16, WS_SGA), FWS(bf16, WS_SGG)};
        pg8::gemm_phase<pg8::EpiMixFused, pg8::DualOrder, true, false>(ring, 512, S, E, gtab);
        if (BOTH(3)) QUAD_BAR(2);
    }
    if (IN(4)) {
        pg8::DenseOrder S; S.init(FWS(bf16, WS_MIX), FWS(bf16, WS_WOUT), T_, D_, D_, F.G, F.vcu, false, true); pg8::EpiResid E{FIN(0), FWS(bf16, WS_X1)};
        pg8::gemm_phase<pg8::EpiResid, pg8::DenseOrder, true, false>(ring, D_, S, E, gtab);
        if (BOTH(4)) QUAD_BAR(3);
    }
    if (IN(5)) { router_phase(F); conv_expert_items(F, 0, (NEXP * 768 + F.G * 8 - 1) / (F.G * 8));       if (BOTH(5)) GRID_BAR(); }
    if (IN(6)) {
        const int nu = moe_tables(F, 1) & 255;
        pg8::MoeOrder S{(const LAS int*)(F.lds + TAB_ULIST), nu, (const char*)FWS(unsigned char, WS_H2), 0, (const char*)FWS(unsigned char, WS_WGU), (size_t)D_ * D_, (size_t)256 * D_, 0};
        pg8::EpiGateUp E{FWS(unsigned char, WS_HID)};
        pg8::gemm_phase<pg8::EpiGateUp, pg8::MoeOrder, true, true, 122, 127>(ring, D_ / 2, S, E, gtab);
        if (BOTH(6)) { if (MK_N_LAUNCHES == 1) quad_barrier(qw, 16u, x_same, F.ctl + CW_BAR); }
    }
    if (IN(7)) {
        const int pk = moe_tables(F, 2, MK_N_LAUNCHES == 1 && lo <= 6), nu = pk & 255, n_main = (pk >> 8) & 255, prodq = pk >> 16;
        pg8::EpiDown E{FWS(unsigned char, WS_Y)};
#pragma unroll 1
        for (int pass = 0; pass < 2; ++pass) {
            const int u0 = pass ? n_main : 0, n = pass ? nu - n_main : n_main;
            if (pass && n > 0 && MK_N_LAUNCHES == 1) {
                if (F.tid == 0) { unsigned* pc = F.ctl + CW_QUAD + 32 * prodq; XB_SPIN(xb_ld(pc) < 16u, F.ctl + CW_BAR); __builtin_amdgcn_fence(__ATOMIC_ACQUIRE, "agent"); asm volatile("s_waitcnt vmcnt(0)" ::: "memory"); }
                __syncthreads(); }
            pg8::MoeOrder S{(const LAS int*)(F.lds + TAB_ULIST) + u0, n, (const char*)FWS(unsigned char, WS_HID), 0, (const char*)FWS(unsigned char, WS_WD), (size_t)D_ * DEXP, (size_t)256 * DEXP, u0};
            pg8::gemm_phase<pg8::EpiDown, pg8::MoeOrder, true, true, 123, 124>(ring, DEXP / 2 + (F.G >> 20), S, E, gtab);
        }
        if (BOTH(7)) GRID_BAR();
    }
    if (IN(8)) final_phase(F, !(MK_N_LAUNCHES == 1 && lo <= 6));
#undef IN
#undef BOTH
}

extern "C" void kernel_launch(void* const* d_in, const int* in_sizes, int n_in, void* d_out, int out_size, void* d_ws, size_t ws_size, hipStream_t stream) {
    static int grid = 0;
    if (grid == 0) {
        if (n_in != 20 || in_sizes[0] != T_ * D_ || out_size != T_ * D_ || ws_size < WS_END) { fprintf(stderr, "kernel_launch: unexpected shapes (n_in %d, in0 %d, out %d, ws %zu)\n", n_in, n_in > 0 ? in_sizes[0] : -1, out_size, ws_size); grid = -1; return; }
        int dev = 0, cus = 0, per_cu = 0;
        if (hipGetDevice(&dev) != hipSuccess || hipDeviceGetAttribute(&cus, hipDeviceAttributeMultiprocessorCount, dev) != hipSuccess) { grid = -1; return; }
        if (hipFuncSetAttribute((const void*)mk_fwd, hipFuncAttributeMaxDynamicSharedMemorySize, LDS_BYTES) != hipSuccess) { fprintf(stderr, "kernel_launch: hipFuncSetAttribute failed\n"); grid = -1; return; }
        if (hipOccupancyMaxActiveBlocksPerMultiprocessor(&per_cu, (const void*)mk_fwd, 512, LDS_BYTES) != hipSuccess || per_cu < 1) fprintf(stderr, "kernel_launch: occupancy query reports %d\n", per_cu);
        (void)hipGetLastError();
        grid = cus - cus % 4;
    }
    if (grid < 0) return;
    if (hipMemsetAsync((char*)d_ws + WS_CTL, 0, CTL_ZERO_BYTES, stream) != hipSuccess) return;
    Args a{};
    for (int i = 0; i < 20; ++i) a.in[i] = (const float*)d_in[i];
    a.out = (float*)d_out; a.ws = (unsigned char*)d_ws;
    if (MK_N_LAUNCHES == 1) { a.ph_lo = 0; a.ph_hi = N_PHASES; a.li = 0; hipLaunchKernelGGL(mk_fwd, dim3(grid), dim3(512), LDS_BYTES, stream, a); }
    else for (int li = 0; li < N_PHASES; ++li) { a.ph_lo = li; a.ph_hi = li + 1; a.li = li; hipLaunchKernelGGL(mk_fwd, dim3(grid), dim3(512), LDS_BYTES, stream, a); }
}
```

```cpp
#include <hip/hip_runtime.h>
#include <cstdio>
#include <cstdint>

#ifndef MK_N_LAUNCHES
#define MK_N_LAUNCHES 1
#endif

#define GAS __attribute__((address_space(1)))
#define LAS __attribute__((address_space(3)))
typedef unsigned short bf16;
typedef unsigned v4u __attribute__((ext_vector_type(4)));
typedef unsigned v2u __attribute__((ext_vector_type(2)));
typedef float f32x4 __attribute__((ext_vector_type(4)));
typedef float f32x2 __attribute__((ext_vector_type(2)));
typedef short bf16x8 __attribute__((ext_vector_type(8)));
typedef short s16x4 __attribute__((ext_vector_type(4)));
typedef int v8i __attribute__((ext_vector_type(8)));
typedef int v4i __attribute__((ext_vector_type(4)));

constexpr int T_ = 65536, D_ = 1024, SEQ_ = 2048, INC_ = 3840;
constexpr int NEXP = 32, DEXP = 512;
constexpr float EPS_ = 1e-5f;
constexpr float LOG2E = 1.4426950408889634f;
constexpr float QSCALE = 0.125f * LOG2E;

constexpr size_t MiB = 1u << 20;
constexpr size_t WS_CTL = 0, CTL_ZERO_BYTES = 1 * MiB;
constexpr size_t WS_WIN = 2 * MiB;
constexpr size_t WS_WIN8Q = 6 * MiB;
constexpr size_t WS_WIN8 = 6 * MiB + 768 * 1024;
constexpr size_t WS_WA = 10 * MiB, WS_WG = 11 * MiB, WS_WOUT = 12 * MiB;
constexpr size_t WS_WR = 14 * MiB;
constexpr size_t WS_WM = 14 * MiB + 256 * 1024;
constexpr size_t WS_ROPE = 14 * MiB + 512 * 1024;
constexpr size_t WS_WGU = 16 * MiB;
constexpr size_t WS_WD = 80 * MiB;
constexpr size_t WS_LIST = 112 * MiB;
constexpr size_t WS_TOKE = 120 * MiB, WS_TOKW = 121 * MiB, WS_TOKP = 122 * MiB;
constexpr size_t WS_XN = 128 * MiB;
constexpr size_t WS_Q = 256 * MiB, WS_K = 320 * MiB, WS_V = 336 * MiB, WS_AO = 352 * MiB, WS_GO = 416 * MiB;
constexpr size_t WS_Z = 480 * MiB, WS_SGA = 608 * MiB, WS_SGG = 736 * MiB, WS_MIX = 864 * MiB;
constexpr size_t WS_XN8 = 352 * MiB;
constexpr size_t WS_X1 = 128 * MiB;
constexpr size_t WS_H2 = 352 * MiB;
constexpr size_t WS_HID = 480 * MiB;
constexpr size_t WS_Y = 616 * MiB;
constexpr size_t WS_END = 992 * MiB;
constexpr int CW_BAR = 4096;
constexpr int CW_CNT = 16384;
constexpr int CW_QUAD = 32768;
constexpr int CW_XLOC = 40960;

constexpr int RING_OFF = 0, RING_BYTES = 131072;
constexpr int LDSCTL_OFF = RING_BYTES, MISC_OFF = LDSCTL_OFF + 320;
constexpr int TAB_OFF = RING_BYTES + 512;
constexpr int TAB_CNT = TAB_OFF, TAB_TPRE = TAB_OFF + 128, TAB_ULIST = TAB_OFF + 384, TAB_GATHER = TAB_OFF + 512;
constexpr int MAX_UNITS = 12;
constexpr int LDS_BYTES = 163840;
static_assert(TAB_GATHER + MAX_UNITS * 1024 <= LDS_BYTES, "LDS map");

#define RLX_AGENT __ATOMIC_RELAXED, __HIP_MEMORY_SCOPE_AGENT
#define LDS_WAIT() asm volatile("s_waitcnt lgkmcnt(0)" ::: "memory")
#define VM_WAIT() asm volatile("s_waitcnt vmcnt(0)" ::: "memory")
__device__ __forceinline__ unsigned cvt_pk_bf16(float lo, float hi) { unsigned r; asm volatile("v_cvt_pk_bf16_f32 %0, %1, %2" : "=v"(r) : "v"(lo), "v"(hi)); return r; }
__device__ __forceinline__ float bf_lo(unsigned w) { return __uint_as_float(w << 16); }
__device__ __forceinline__ float bf_hi(unsigned w) { return __uint_as_float(w & 0xffff0000u); }
__device__ __forceinline__ float fast_exp2(float x) { return __builtin_amdgcn_exp2f(x); }
__device__ __forceinline__ float fast_rcp(float x) { return __builtin_amdgcn_rcpf(x); }
__device__ __forceinline__ float gelu_tanh(float x) { const float u = x + 0.044715f * x * x * x; return x * fast_rcp(1.0f + fast_exp2(-2.302208198f * u)); }
__device__ __forceinline__ float sigmoidf_(float x) { return fast_rcp(1.0f + fast_exp2(-LOG2E * x)); }
__device__ __forceinline__ float sat448(float v) { return __builtin_amdgcn_fmed3f(v, -448.0f, 448.0f); }
__device__ __forceinline__ unsigned pk4_fp8(float a, float b, float c, float d) { int w = 0; w = __builtin_amdgcn_cvt_pk_fp8_f32(a, b, w, false); w = __builtin_amdgcn_cvt_pk_fp8_f32(c, d, w, true); return (unsigned)w; }
__device__ __forceinline__ void unpack8_fp8(const v2u w, f32x4& v0, f32x4& v1) {
    const f32x2 a = __builtin_amdgcn_cvt_pk_f32_fp8((int)w.x, false), b = __builtin_amdgcn_cvt_pk_f32_fp8((int)w.x, true), c = __builtin_amdgcn_cvt_pk_f32_fp8((int)w.y, false), d = __builtin_amdgcn_cvt_pk_f32_fp8((int)w.y, true);
    v0 = (f32x4){a.x, a.y, b.x, b.y}; v1 = (f32x4){c.x, c.y, d.x, d.y};
}
template <int CTRL> __device__ __forceinline__ float dpp_f(float v) { return __builtin_bit_cast(float, __builtin_amdgcn_update_dpp(0, __builtin_bit_cast(int, v), CTRL, 0xF, 0xF, true)); }
__device__ __forceinline__ float wave_sum(float v) {
    v += dpp_f<0xB1>(v); v += dpp_f<0x4E>(v); v += dpp_f<0x141>(v); v += dpp_f<0x140>(v);
    { const auto rr = __builtin_amdgcn_permlane16_swap(__float_as_uint(v), __float_as_uint(v), false, false); v = __uint_as_float(rr[0]) + __uint_as_float(rr[1]); }
    { const auto rr = __builtin_amdgcn_permlane32_swap(__float_as_uint(v), __float_as_uint(v), false, false); v = __uint_as_float(rr[0]) + __uint_as_float(rr[1]); }
    return v;
}
__device__ __forceinline__ f32x4 mfma16(bf16x8 a, bf16x8 b, f32x4 c) { return __builtin_amdgcn_mfma_f32_16x16x32_bf16(a, b, c, 0, 0, 0); }
typedef short v4i16_t __attribute__((ext_vector_type(4)));
__device__ __forceinline__ s16x4 vtr(LAS const unsigned char* p) { return __builtin_bit_cast(s16x4, __builtin_amdgcn_ds_read_tr16_b64_v4i16((LAS v4i16_t*)p)); }

namespace pg8 {
#define PG8_LAS __attribute__((address_space(3)))
typedef unsigned short bf16_t;
typedef unsigned u32x4 __attribute__((ext_vector_type(4)));
constexpr int BM = 256, BK = 64, HALF = 128, HTB = HALF * BK * 2, STAGE_BYTES = 8 * HTB, NXCD = 8, WGM = 8;
__host__ __device__ __forceinline__ int lds_byte(int r, int c) { const int st = (r >> 4) * 2 + (c >> 5), rr = r & 15, cc = c & 31, ob = rr * 64 + cc * 2; return st * 1024 + (ob ^ (((ob >> 9) & 1) << 5)); }
__host__ __device__ __forceinline__ void stage_rc(int b, int& R, int& C) { const int st = b / 1024, sb = b % 1024, swz = sb ^ (((sb >> 9) & 1) << 5); R = (st >> 1) * 16 + swz / 64; C = (st & 1) * 32 + (swz % 64) / 2; }
__host__ __device__ __forceinline__ int perm32(int rho) { const int n = rho >> 4, i = rho & 15; return 8 * (i >> 2) + 4 * n + (i & 3); }

template <int OFF> __device__ __forceinline__ void glds16s(const char* sbase, unsigned voff, unsigned lds_base) {
    unsigned keep;
    asm volatile("s_mov_b32 %0, m0\n\ts_add_u32 m0, %3, %4\n\ts_nop 2\n\tglobal_load_lds_dwordx4 %2, %1\n\ts_mov_b32 m0, %0" : "=&s"(keep) : "s"(sbase), "v"(voff), "s"(lds_base), "n"(OFF) : "memory", "scc");
}
struct Unit { int pm, pn; const char* a; const char* b; int aux; };

struct DenseOrder {
    const char* A; const char* Bt; int K, nM, nN, nwg, G, c; bool idg, panel;
    __device__ void init(const void* A_, const void* Bt_, int M, int N, int K_, int G_, int c_, bool idg_ = false, bool panel_ = false) { A = (const char*)A_; Bt = (const char*)Bt_; K = K_; nM = M / BM; nN = N / BM; nwg = nM * nN; G = G_; c = c_; idg = idg_; panel = panel_; }
    __device__ bool next(int i, Unit& u) const {
        if (panel) { u.pn = c & 3; u.pm = (c & ~3) + (i & 3) + (i >> 2) * G; if (u.pm >= nM) return false; }
        else {
        const long L = (long)i * G + c; if (L >= nwg) return false;
        int wgid = (int)L; { const int q = nwg / NXCD, r = nwg % NXCD, xcd = wgid % NXCD, off = wgid / NXCD; wgid = (xcd < r ? xcd * (q + 1) : r * (q + 1) + (xcd - r) * q) + off; }
        const int nig = WGM * nN, gid = wgid / nig, fm = gid * WGM, gsz = (nM - fm) < WGM ? (nM - fm) : WGM;
        u.pm = fm + ((wgid % nig) % gsz); u.pn = (wgid % nig) / gsz; }
        u.a = idg ? A : A + (size_t)u.pm * BM * K * 2; u.b = Bt + (size_t)u.pn * BM * K * 2; u.aux = idg ? i : 0; return true;
    }
};
struct DualOrder {
    const char* A[2]; const char* Bt[2]; int K, nM, nN, nwg, G, c;
    __device__ void init(const void* A0, const void* B0, const void* A1, const void* B1, int M, int N, int K_, int G_, int c_) { A[0] = (const char*)A0; Bt[0] = (const char*)B0; A[1] = (const char*)A1; Bt[1] = (const char*)B1; K = K_; nM = M / BM; nN = N / BM; nwg = nM * nN; G = G_; c = c_; }
    __device__ bool next(int i, Unit& u) const {
        const int seg = i & 1, t = i >> 1; u.pn = c & 3; u.pm = (c & ~3) + (t & 3) + (t >> 2) * G; if (u.pm >= nM) return false;
        u.a = (seg ? A[1] : A[0]) + (size_t)u.pm * BM * K * 2; u.b = (seg ? Bt[1] : Bt[0]) + (size_t)u.pn * BM * K * 2; u.aux = seg; return true;
    }
};
struct MoeOrder {
    const PG8_LAS int* ulist; int nu; const char* Abase; size_t a_tile; const char* Bbase; size_t b_exp, b_pn; int aux0;
    __device__ bool next(int i, Unit& u) const {
        if (i >= nu) return false;
        const int w = __builtin_amdgcn_readfirstlane(ulist[i]); const int e = w >> 16, ti = (w >> 2) & 0x3fff, pn = w & 3;
        u.pm = ti; u.pn = pn; u.a = Abase + (size_t)ti * a_tile; u.b = Bbase + (size_t)e * b_exp + (size_t)pn * b_pn; u.aux = i + aux0; return true;
    }
};

template <class Epi, class Sched, bool ALIGN_EPI, bool GATHER, int SA8 = 0, int SB8 = 0>
__device__ __forceinline__ void gemm_phase(PG8_LAS unsigned char* lds, const int K, const Sched& S, const Epi& E, const PG8_LAS unsigned char* gtab) {
    const int tid = threadIdx.x, wid = __builtin_amdgcn_readfirstlane(tid >> 6), lane = tid & 63, wr = wid >> 2, wc = wid & 3, fr = lane & 15, fq = lane >> 4;
    const int nt = K / BK;
    unsigned voffA[2], voffB[2]; int gRow[2]; unsigned gCol[2];
#pragma unroll
    for (int i = 0; i < 2; ++i) { int R, C; stage_rc(tid * 16 + i * 8192, R, C); const int Rb = (R & ~31) + perm32(R & 31);
        voffA[i] = (unsigned)(R * K + C) * 2u; voffB[i] = (unsigned)(Rb * K + C) * 2u; gRow[i] = R; gCol[i] = (unsigned)C * 2u; }
    const size_t kstep = (size_t)(BK * 2);
    const size_t hstep = (size_t)HALF * K * 2;
    const unsigned ldsw = (unsigned)wid * 1024u;
    const unsigned ldsb = (unsigned)(size_t)lds + ldsw;
    const int aoff = lds_byte(wr * 64 + fr, fq * 8), boff = lds_byte(wc * 32 + fr, fq * 8);
    unsigned gC[2][2], gN[2][2];
#define PG8_SA(b, h) (((b) * 2 + (h)) * HTB)
#define PG8_SB(b, h) ((4 + (b) * 2 + (h)) * HTB)
#define PG8_STAGE(bufoff, gbase, voff) do { glds16s<(bufoff)>((const char*)(gbase), (voff)[0], ldsb); glds16s<(bufoff) + 8192>((const char*)(gbase), (voff)[1], ldsb); } while (0)
#define PG8_STAGE_A(bufoff, kptr, h) PG8_STAGE(bufoff, kptr, gC[h])
#define PG8_GLOAD(dst, unit) do { _Pragma("unroll") for (int _h = 0; _h < 2; ++_h) _Pragma("unroll") for (int _i = 0; _i < 2; ++_i) \
        dst[_h][_i] = *(const PG8_LAS unsigned*)(gtab + (unit) * 1024 + (gRow[_i] + _h * HALF) * 4) + gCol[_i]; } while (0)
#define PG8_LDA(dst, b, h) do { _Pragma("unroll") for (int m = 0; m < 4; ++m) _Pragma("unroll") for (int k = 0; k < 2; ++k) dst[m][k] = *(const PG8_LAS bf16x8*)(lds + PG8_SA(b, h) + aoff + m * 2048 + k * 1024); } while (0)
#define PG8_LDB(dst, b, h) do { _Pragma("unroll") for (int n = 0; n < 2; ++n) _Pragma("unroll") for (int k = 0; k < 2; ++k) dst[n][k] = *(const PG8_LAS bf16x8*)(lds + PG8_SB(b, h) + boff + n * 2048 + k * 1024); } while (0)
#define PG8_CAT8(x0, x1) __builtin_shufflevector(__builtin_bit_cast(v4i, x0), __builtin_bit_cast(v4i, x1), 0, 1, 2, 3, 4, 5, 6, 7)
#define PG8_MMA(ai, bj, At, Bt) do { __builtin_amdgcn_s_setprio(1); _Pragma("unroll") for (int m = 0; m < 4; ++m) _Pragma("unroll") for (int n = 0; n < 2; ++n) { \
        if constexpr (SA8 != 0) { acc[ai][bj][m][n] = __builtin_amdgcn_mfma_scale_f32_16x16x128_f8f6f4(PG8_CAT8(Bt[n][0], Bt[n][1]), PG8_CAT8(At[m][0], At[m][1]), acc[ai][bj][m][n], 0, 0, 0, SA8 * 0x01010101, 0, SB8 * 0x01010101); } \
        else { _Pragma("unroll") for (int k = 0; k < 2; ++k) acc[ai][bj][m][n] = __builtin_amdgcn_mfma_f32_16x16x32_bf16(Bt[n][k], At[m][k], acc[ai][bj][m][n], 0, 0, 0); } } \
        __builtin_amdgcn_s_setprio(0); } while (0)
#define PG8_WAIT_V(n) asm volatile("s_waitcnt vmcnt(" #n ")" ::: "memory")
#define PG8_WAIT_L(n) asm volatile("s_waitcnt lgkmcnt(" #n ")" ::: "memory")
#define PG8_BAR __builtin_amdgcn_s_barrier()
#define PG8_SCHED __builtin_amdgcn_sched_barrier(0)
    Unit cur, nxt; int ui = 0;
    if (!S.next(0, cur)) return;
    f32x4 acc[2][2][4][2];
#pragma unroll
    for (int a = 0; a < 2; ++a)
#pragma unroll
        for (int b = 0; b < 2; ++b)
#pragma unroll
            for (int m = 0; m < 4; ++m)
#pragma unroll
                for (int n = 0; n < 2; ++n) acc[a][b][m][n] = (f32x4){0.f, 0.f, 0.f, 0.f};
    bf16x8 At[4][2], B0[2][2], B1[2][2];
    const char* cA = cur.a; const char* cB = cur.b;
    if constexpr (GATHER) { PG8_GLOAD(gC, cur.aux); PG8_WAIT_L(0); }
    else {
#pragma unroll
        for (int h = 0; h < 2; ++h)
#pragma unroll
            for (int i = 0; i < 2; ++i) gC[h][i] = voffA[i] + (unsigned)h * (unsigned)hstep; }
    PG8_STAGE(PG8_SB(0, 0), cB, voffB); PG8_STAGE(PG8_SB(0, 1), cB + hstep, voffB); PG8_STAGE_A(PG8_SA(0, 0), cA, 0); PG8_STAGE_A(PG8_SA(0, 1), cA, 1);
    if (wr == 1) PG8_BAR;
    PG8_WAIT_V(2); PG8_BAR;
    PG8_STAGE(PG8_SB(1, 0), cB + kstep, voffB); PG8_STAGE_A(PG8_SA(1, 0), cA + kstep, 0); PG8_STAGE(PG8_SB(1, 1), cB + hstep + kstep, voffB);
    PG8_WAIT_V(6); PG8_BAR;
    for (;;) {
        const bool has_next = S.next(ui + 1, nxt);
        const char* nA = has_next ? nxt.a : cA; const char* nB = has_next ? nxt.b : cB;
        if constexpr (GATHER) { if (has_next) { PG8_GLOAD(gN, nxt.aux); } else {
#pragma unroll
            for (int h = 0; h < 2; ++h)
#pragma unroll
                for (int i = 0; i < 2; ++i) gN[h][i] = gC[h][i]; } }
#pragma unroll 1
        for (int t = 0; t < nt; t += 2) {
            const bool last = (t == nt - 2);
            const char* a1 = cA + (size_t)(t + 1) * kstep;
            const char* a2 = last ? nA : cA + (size_t)(t + 2) * kstep; const char* b2 = last ? nB : cB + (size_t)(t + 2) * kstep;
            const char* a3 = a2 + kstep; const char* b3 = b2 + kstep;
            PG8_LDB(B0, 0, 0); PG8_LDB(B1, 0, 1); PG8_SCHED; PG8_LDA(At, 0, 0); PG8_STAGE_A(PG8_SA(1, 1), a1, 1);
            if constexpr (GATHER) { if (last) {
#pragma unroll
                for (int h = 0; h < 2; ++h)
#pragma unroll
                    for (int i = 0; i < 2; ++i) gC[h][i] = gN[h][i]; } }
            PG8_WAIT_V(8); PG8_WAIT_L(0); PG8_BAR; PG8_MMA(0, 0, At, B0); PG8_MMA(0, 1, At, B1); PG8_BAR; PG8_SCHED;
            PG8_LDA(At, 0, 1); PG8_STAGE(PG8_SB(0, 0), b2, voffB); PG8_STAGE(PG8_SB(0, 1), b2 + hstep, voffB); PG8_STAGE_A(PG8_SA(0, 0), a2, 0);
            PG8_WAIT_V(8); PG8_WAIT_L(0); PG8_BAR; PG8_MMA(1, 0, At, B0); PG8_MMA(1, 1, At, B1); PG8_BAR; PG8_SCHED;
            PG8_LDB(B0, 1, 0); PG8_LDB(B1, 1, 1); PG8_SCHED; PG8_LDA(At, 1, 0); PG8_STAGE_A(PG8_SA(0, 1), a2, 1);
            PG8_WAIT_V(8); PG8_WAIT_L(0); PG8_BAR; PG8_MMA(0, 0, At, B0); PG8_MMA(0, 1, At, B1); PG8_BAR; PG8_SCHED;
            PG8_LDA(At, 1, 1); PG8_STAGE(PG8_SB(1, 0), b3, voffB); PG8_STAGE(PG8_SB(1, 1), b3 + hstep, voffB); PG8_STAGE_A(PG8_SA(1, 0), a3, 0);
            PG8_WAIT_V(8); PG8_WAIT_L(0); PG8_BAR; PG8_MMA(1, 0, At, B0); PG8_MMA(1, 1, At, B1); PG8_BAR; PG8_SCHED;
        }
        if constexpr (ALIGN_EPI) { if (wr == 0) PG8_BAR; }
        E(acc, cur, wr, wc, fr, fq);
        if (!has_next) break;
        if (!(Epi::SEG && cur.aux == 0))
#pragma unroll
        for (int a = 0; a < 2; ++a)
#pragma unroll
            for (int b = 0; b < 2; ++b)
#pragma unroll
                for (int m = 0; m < 4; ++m)
#pragma unroll
                    for (int n = 0; n < 2; ++n) acc[a][b][m][n] = (f32x4){0.f, 0.f, 0.f, 0.f};
        cur = nxt; cA = nA; cB = nB; ++ui;
        if constexpr (ALIGN_EPI) { if (wr == 1) PG8_BAR; }
    }
    PG8_WAIT_V(0);
    if constexpr (!ALIGN_EPI) { if (wr == 0) PG8_BAR; }
    PG8_BAR;
#undef PG8_SA
#undef PG8_SB
#undef PG8_STAGE
#undef PG8_STAGE_A
#undef PG8_GLOAD
#undef PG8_LDA
#undef PG8_LDB
#undef PG8_MMA
#undef PG8_CAT8
#undef PG8_WAIT_V
#undef PG8_WAIT_L
#undef PG8_BAR
#undef PG8_SCHED
}

__device__ __forceinline__ u32x4 pack8(const f32x4 v0, const f32x4 v1) { u32x4 w; w.x = cvt_pk_bf16(v0[0], v0[1]); w.y = cvt_pk_bf16(v0[2], v0[3]); w.z = cvt_pk_bf16(v1[0], v1[1]); w.w = cvt_pk_bf16(v1[2], v1[3]); return w; }
__device__ __forceinline__ void unpack8(const u32x4 w, f32x4& v0, f32x4& v1) { v0 = (f32x4){bf_lo(w.x), bf_hi(w.x), bf_lo(w.y), bf_hi(w.y)}; v1 = (f32x4){bf_lo(w.z), bf_hi(w.z), bf_lo(w.w), bf_hi(w.w)}; }

struct EpiInProj {
    static constexpr bool SEG = false;
    bf16_t *Q, *Kb, *Vb, *Z; const float* rope; int pn0;
    __device__ __forceinline__ void operator()(const f32x4 (&acc)[2][2][4][2], const Unit& u, int wr, int wc, int fr, int fq) const {
        const int row0 = u.pm * BM + wr * 64 + fr, c8 = wc * 32 + 8 * fq, pn = u.pn + pn0;
        if (pn <= 2) {
            const bool rot_lane = ((wc & 1) == 0) && (fq < 2);
            const float sgn = (fq == 0) ? -1.f : 1.f;
#pragma unroll
            for (int ai = 0; ai < 2; ++ai)
#pragma unroll
                for (int m = 0; m < 4; ++m) {
                    const int row = row0 + ai * HALF + m * 16, pos = row & (SEQ_ - 1);
                    const f32x4 cs0 = *(const f32x4*)(rope + pos * 16), cs1 = *(const f32x4*)(rope + pos * 16 + 4), sn0 = *(const f32x4*)(rope + pos * 16 + 8), sn1 = *(const f32x4*)(rope + pos * 16 + 12);
#pragma unroll
                    for (int bj = 0; bj < 2; ++bj) {
                        f32x4 v0 = acc[ai][bj][m][0], v1 = acc[ai][bj][m][1];
                        const bool isv = (pn == 2) && (bj == 1);
                        if (!isv) {
                            f32x4 o0, o1;
#pragma unroll
                            for (int j = 0; j < 4; ++j) { o0[j] = __shfl_xor(v0[j], 16); o1[j] = __shfl_xor(v1[j], 16); }
                            if (rot_lane) { v0 = v0 * cs0 + sgn * (o0 * sn0); v1 = v1 * cs1 + sgn * (o1 * sn1); }
                        }
                        bf16_t* dst;
                        if (pn < 2) { v0 = v0 * QSCALE; v1 = v1 * QSCALE; dst = Q + (size_t)row * 512 + pn * 256 + bj * HALF + c8; }
                        else dst = (bj == 0 ? Kb : Vb) + (size_t)row * 128 + c8;
                        *(u32x4*)dst = pack8(v0, v1);
                    }
                }
        } else if (pn <= 6) {
#pragma unroll
            for (int ai = 0; ai < 2; ++ai)
#pragma unroll
                for (int m = 0; m < 4; ++m) {
                    bf16_t* rowp = Z + (size_t)(row0 + ai * HALF + m * 16) * 1024 + (pn - 3) * 256 + c8;
#pragma unroll
                    for (int bj = 0; bj < 2; ++bj) { f32x4 v0 = acc[ai][bj][m][0], v1 = acc[ai][bj][m][1];
#pragma unroll
                        for (int j = 0; j < 4; ++j) { v0[j] = gelu_tanh(v0[j]); v1[j] = gelu_tanh(v1[j]); }
                        *(u32x4*)(rowp + bj * HALF) = pack8(v0, v1); }
                }
        }
    }
};
struct EpiGates {
    static constexpr bool SEG = false;
    bf16_t *R, *S;
    __device__ __forceinline__ void operator()(const f32x4 (&acc)[2][2][4][2], const Unit& u, int wr, int wc, int fr, int fq) const {
        const int row0 = u.pm * BM + wr * 64 + fr, col0 = u.pn * HALF + wc * 32 + 8 * fq;
#pragma unroll
        for (int ai = 0; ai < 2; ++ai)
#pragma unroll
            for (int m = 0; m < 4; ++m) { f32x4 r0, r1, s0, s1;
#pragma unroll
                for (int j = 0; j < 4; ++j) { const float ea0 = fast_exp2(-LOG2E * acc[ai][0][m][0][j]), ea1 = fast_exp2(-LOG2E * acc[ai][0][m][1][j]), eg0 = fast_exp2(-LOG2E * acc[ai][1][m][0][j]), eg1 = fast_exp2(-LOG2E * acc[ai][1][m][1][j]);
                    r0[j] = (1.0f + eg0) * fast_rcp(1.0f + ea0); r1[j] = (1.0f + eg1) * fast_rcp(1.0f + ea1); s0[j] = fast_rcp(1.0f + eg0); s1[j] = fast_rcp(1.0f + eg1); }
                const size_t off = (size_t)(row0 + ai * HALF + m * 16) * 1024 + col0;
                *(u32x4*)(R + off) = pack8(r0, r1); *(u32x4*)(S + off) = pack8(s0, s1); }
    }
};
struct EpiInProj8 {
    static constexpr bool SEG = false;
    EpiInProj qkv; EpiGates gates;
    __device__ __forceinline__ void operator()(const f32x4 (&acc)[2][2][4][2], const Unit& u, int wr, int wc, int fr, int fq) const {
        if (u.pn < 3) qkv(acc, u, wr, wc, fr, fq); else { Unit v = u; v.pn = u.pn - 3; gates(acc, v, wr, wc, fr, fq); }
    }
};
struct EpiMixFused {
    static constexpr bool SEG = true;
    bf16_t* MIX; const bf16_t *SGA, *SGG;
    __device__ __forceinline__ void operator()(f32x4 (&acc)[2][2][4][2], const Unit& u, int wr, int wc, int fr, int fq) const {
        const int row0 = u.pm * BM + wr * 64 + fr, col0 = u.pn * BM + wc * 32 + 8 * fq;
        if (u.aux == 0) {
#pragma unroll
            for (int ai = 0; ai < 2; ++ai)
#pragma unroll
                for (int m = 0; m < 4; ++m) { const size_t off = (size_t)(row0 + ai * HALF + m * 16) * 1024 + col0;
#pragma unroll
                    for (int bj = 0; bj < 2; ++bj) { f32x4 a0, a1; unpack8(*(const u32x4*)(SGA + off + bj * HALF), a0, a1);
                        acc[ai][bj][m][0] = acc[ai][bj][m][0] * a0; acc[ai][bj][m][1] = acc[ai][bj][m][1] * a1; } }
        } else {
#pragma unroll
            for (int ai = 0; ai < 2; ++ai)
#pragma unroll
                for (int m = 0; m < 4; ++m) { const size_t off = (size_t)(row0 + ai * HALF + m * 16) * 1024 + col0;
#pragma unroll
                    for (int bj = 0; bj < 2; ++bj) { f32x4 g0, g1; unpack8(*(const u32x4*)(SGG + off + bj * HALF), g0, g1);
                        *(u32x4*)(MIX + off + bj * HALF) = pack8(acc[ai][bj][m][0] * g0, acc[ai][bj][m][1] * g1); } }
        }
    }
};
struct EpiResid {
    static constexpr bool SEG = false;
    const float* X; bf16_t* X1;
    __device__ __forceinline__ void operator()(const f32x4 (&acc)[2][2][4][2], const Unit& u, int wr, int wc, int fr, int fq) const {
        const int row0 = u.pm * BM + wr * 64 + fr, col0 = u.pn * BM + wc * 32 + 8 * fq;
#pragma unroll
        for (int ai = 0; ai < 2; ++ai)
#pragma unroll
            for (int m = 0; m < 4; ++m) { const size_t off = (size_t)(row0 + ai * HALF + m * 16) * 1024 + col0;
#pragma unroll
                for (int bj = 0; bj < 2; ++bj) { const f32x4 x0 = *(const f32x4*)(X + off + bj * HALF), x1 = *(const f32x4*)(X + off + bj * HALF + 4);
                    *(u32x4*)(X1 + off + bj * HALF) = pack8(acc[ai][bj][m][0] + x0, acc[ai][bj][m][1] + x1); } }
    }
};
struct EpiGateUp {
    static constexpr bool SEG = false;
    unsigned char* HID;
    __device__ __forceinline__ void operator()(const f32x4 (&acc)[2][2][4][2], const Unit& u, int wr, int wc, int fr, int fq) const {
        const int row0 = u.pm * BM + wr * 64 + fr, col0 = u.pn * HALF + wc * 32 + 8 * fq;
#pragma unroll
        for (int ai = 0; ai < 2; ++ai)
#pragma unroll
            for (int m = 0; m < 4; ++m) { f32x4 v0, v1;
#pragma unroll
                for (int j = 0; j < 4; ++j) { const float g0 = acc[ai][0][m][0][j], g1 = acc[ai][0][m][1][j];
                    v0[j] = 8.0f * g0 * sigmoidf_(g0) * acc[ai][1][m][0][j]; v1[j] = 8.0f * g1 * sigmoidf_(g1) * acc[ai][1][m][1][j]; }
                v2u o; o.x = pk4_fp8(sat448(v0[0]), sat448(v0[1]), sat448(v0[2]), sat448(v0[3])); o.y = pk4_fp8(sat448(v1[0]), sat448(v1[1]), sat448(v1[2]), sat448(v1[3]));
                *(v2u*)(HID + (size_t)(row0 + ai * HALF + m * 16) * DEXP + col0) = o; }
    }
};
struct EpiDown {
    static constexpr bool SEG = false;
    unsigned char* Y;
    __device__ __forceinline__ void operator()(const f32x4 (&acc)[2][2][4][2], const Unit& u, int wr, int wc, int fr, int fq) const {
        const int row0 = u.pm * BM + wr * 64 + fr, col0 = u.pn * BM + wc * 32 + 8 * fq;
#pragma unroll
        for (int ai = 0; ai < 2; ++ai)
#pragma unroll
            for (int m = 0; m < 4; ++m) { unsigned char* rowp = Y + (size_t)(row0 + ai * HALF + m * 16) * 1024 + col0;
#pragma unroll
                for (int bj = 0; bj < 2; ++bj) { const f32x4 v0 = acc[ai][bj][m][0] * 16.0f, v1 = acc[ai][bj][m][1] * 16.0f;
                    v2u o; o.x = pk4_fp8(sat448(v0[0]), sat448(v0[1]), sat448(v0[2]), sat448(v0[3])); o.y = pk4_fp8(sat448(v1[0]), sat448(v1[1]), sat448(v1[2]), sat448(v1[3])); *(v2u*)(rowp + bj * HALF) = o; } }
    }
};
}

#define XB_TMO      128
#define XB_XCNT(j)  (256  + 64 * (j))
#define XB_XSUB(j)  (1280 + 64 * (j))
#define XB_XGEN(j)  (2304 + 64 * (j))
#define XB_TOP      3328
#define XB_TOPGEN   3392
#define XCD_BAR_WORDS 3456
#define XB_SPIN_CAP (1u << 18)
__device__ __forceinline__ unsigned xb_ld(unsigned* p)              { return __hip_atomic_load(p, __ATOMIC_RELAXED, __HIP_MEMORY_SCOPE_AGENT); }
__device__ __forceinline__ unsigned xb_add(unsigned* p, unsigned v) { return __hip_atomic_fetch_add(p, v, __ATOMIC_RELAXED, __HIP_MEMORY_SCOPE_AGENT); }
__device__ __forceinline__ unsigned xb_xcc_id() { return (unsigned)__builtin_amdgcn_s_getreg((3 << 11) | 20) & 0xFu; }
#define XB_SPIN(cond, bar) do { unsigned _sp = 0; while (cond) { __builtin_amdgcn_s_sleep(1); \
    if ((++_sp & 255u) == 0u) { if (xb_ld(&(bar)[XB_TMO])) break; if (_sp > XB_SPIN_CAP) { atomicAdd(&(bar)[XB_TMO], 1u); break; } } } } while (0)
struct XcdBarrier { unsigned* bar; unsigned x; volatile LAS unsigned* st; };
__device__ __forceinline__ XcdBarrier xcd_barrier_post(unsigned* bar, volatile LAS unsigned* st) {
    XcdBarrier b; b.bar = bar; b.x = xb_xcc_id(); b.st = st;
    if (threadIdx.x == 0) (void)xb_add(&bar[XB_XCNT(b.x)], 1u);
    return b;
}
__device__ __forceinline__ void xcd_barrier_complete(unsigned* bar, unsigned x, unsigned& nloc, unsigned& nx) {
    const unsigned G = gridDim.x * gridDim.y * gridDim.z;
    unsigned sum, cnt, mine, sp = 0u;
    for (;;) {
        sum = 0u; cnt = 0u; mine = 0u;
#pragma unroll
        for (unsigned j = 0; j < 16; ++j) { const unsigned c = xb_ld(&bar[XB_XCNT(j)]); sum += c; cnt += (c > 0u) ? 1u : 0u; mine = (j == x) ? c : mine; }
        if (sum == G) break;
        __builtin_amdgcn_s_sleep(1);
        if ((++sp & 255u) == 0u) { if (xb_ld(&bar[XB_TMO])) break; if (sp > XB_SPIN_CAP) { atomicAdd(&bar[XB_TMO], 1u); break; } }
    }
    nloc = mine > 0u ? mine : 1u; nx = cnt > 0u ? cnt : 1u;
}
__device__ __forceinline__ void xcd_barrier(const XcdBarrier& b) {
    asm volatile("s_waitcnt vmcnt(0)" ::: "memory");
    __syncthreads();
    if (threadIdx.x == 0) {
        unsigned* bar = b.bar;
        __builtin_amdgcn_s_waitcnt(0);
        unsigned nloc = b.st[0], nx = b.st[1];
        if (nloc == 0u) { xcd_barrier_complete(bar, b.x, nloc, nx); b.st[0] = nloc; b.st[1] = nx; }
        const unsigned old = xb_add(&bar[XB_XSUB(b.x)], 1u);
        const unsigned gen = old / nloc;
        if (old + 1u == (gen + 1u) * nloc) {
            __builtin_amdgcn_fence(__ATOMIC_RELEASE, "agent");
            asm volatile("s_waitcnt vmcnt(0)" ::: "memory");
            const unsigned og = xb_add(&bar[XB_TOP], 1u);
            const unsigned tg = og / nx;
            if (og + 1u == (tg + 1u) * nx) xb_add(&bar[XB_TOPGEN], 1u);
            else XB_SPIN(xb_ld(&bar[XB_TOPGEN]) == tg, bar);
            __builtin_amdgcn_fence(__ATOMIC_ACQUIRE, "agent");
            xb_add(&bar[XB_XGEN(b.x)], 1u);
            asm volatile("s_waitcnt vmcnt(0)" ::: "memory");
        } else {
            XB_SPIN(xb_ld(&bar[XB_XGEN(b.x)]) == gen, bar);
            __builtin_amdgcn_fence(__ATOMIC_ACQUIRE, "agent");
            asm volatile("s_waitcnt vmcnt(0)" ::: "memory");
        }
    }
    __syncthreads();
}

__device__ __forceinline__ void quad_barrier(unsigned* cnt, unsigned target, bool same_xcd, unsigned* bar) {
    asm volatile("s_waitcnt vmcnt(0)" ::: "memory");
    __syncthreads();
    if (threadIdx.x == 0) {
        if (!same_xcd) { __builtin_amdgcn_fence(__ATOMIC_RELEASE, "agent"); asm volatile("s_waitcnt vmcnt(0)" ::: "memory"); }
        (void)xb_add(cnt, 1u);
        XB_SPIN(xb_ld(cnt) < target, bar);
        __builtin_amdgcn_fence(__ATOMIC_ACQUIRE, "agent");
        asm volatile("s_waitcnt vmcnt(0)" ::: "memory");
    }
    __syncthreads();
}

struct Frame {
    LAS unsigned char* lds;
    unsigned* ctl;
    int tid, lane, wave, vcu, G;
    unsigned char* wsp; const float* const* in; float* out;
};
#define FIN(k) (F.in[k])
#define FWS(T, off) ((T*)(F.wsp + (off)))

__device__ __forceinline__ void p0_transpose_item(const float* W, int K, int N, int ldw, bf16* WT, int mode, LAS float* scr, int item, int lane) {
    const int nblk = N / 32, kb = item / nblk, nb = item % nblk, k0 = 64 * kb, n0 = 32 * nb;
    float tv[32];
#pragma unroll
    for (int i = 0; i < 32; ++i) { const int kk = 2 * i + (lane >> 5); tv[i] = __builtin_nontemporal_load(W + (size_t)(k0 + kk) * ldw + n0 + (lane & 31)); }
#pragma unroll
    for (int i = 0; i < 32; ++i) { const int kk = 2 * i + (lane >> 5); scr[kk * 33 + (lane & 31)] = tv[i]; }
    LDS_WAIT(); asm volatile("" ::: "memory");
    const int c = lane & 7;
    const int rowbase = (mode == 0) ? n0 : ((n0 >> 7) * 256 + (n0 & 127) + (mode == 2 ? 128 : 0));
#pragma unroll
    for (int j = 0; j < 4; ++j) { const int n = (lane >> 3) + 8 * j; const LAS float* s = scr + (8 * c) * 33 + n;
        v4u o; o.x = cvt_pk_bf16(s[0 * 33], s[1 * 33]); o.y = cvt_pk_bf16(s[2 * 33], s[3 * 33]); o.z = cvt_pk_bf16(s[4 * 33], s[5 * 33]); o.w = cvt_pk_bf16(s[6 * 33], s[7 * 33]);
        *(GAS v4u*)(WT + (size_t)(rowbase + n) * K + k0 + 8 * c) = o; }
    LDS_WAIT(); asm volatile("" ::: "memory");
}
__device__ __forceinline__ void p0_transpose_item8(const float* W, int K, int N, int ldw, unsigned char* WT, int mode, float scale, LAS float* scr, int item, int lane) {
    const int nblk = N / 32, kb = item / nblk, nb = item % nblk, k0 = 64 * kb, n0 = 32 * nb;
    float tv[32];
#pragma unroll
    for (int i = 0; i < 32; ++i) { const int kk = 2 * i + (lane >> 5); tv[i] = __builtin_nontemporal_load(W + (size_t)(k0 + kk) * ldw + n0 + (lane & 31)); }
#pragma unroll
    for (int i = 0; i < 32; ++i) { const int kk = 2 * i + (lane >> 5); scr[kk * 33 + (lane & 31)] = tv[i] * scale; }
    LDS_WAIT(); asm volatile("" ::: "memory");
    const int c = lane & 3;
    const int rowbase = (mode == 0) ? n0 : ((n0 >> 7) * 256 + (n0 & 127) + (mode == 2 ? 128 : 0));
#pragma unroll
    for (int j = 0; j < 2; ++j) { const int n = (lane >> 2) + 16 * j; const LAS float* sp = scr + (16 * c) * 33 + n;
        v4u o; o.x = pk4_fp8(sp[0 * 33], sp[1 * 33], sp[2 * 33], sp[3 * 33]); o.y = pk4_fp8(sp[4 * 33], sp[5 * 33], sp[6 * 33], sp[7 * 33]);
        o.z = pk4_fp8(sp[8 * 33], sp[9 * 33], sp[10 * 33], sp[11 * 33]); o.w = pk4_fp8(sp[12 * 33], sp[13 * 33], sp[14 * 33], sp[15 * 33]);
        *(GAS v4u*)(WT + (size_t)(rowbase + n) * K + k0 + 16 * c) = o; }
    LDS_WAIT(); asm volatile("" ::: "memory");
}
template <int NR> __device__ __forceinline__ void rms_rows_to_bf16(int lane, const float* xrow0, size_t rstride, const float* gain, bf16* orow0, unsigned char* o8row0) {
    f32x4 v[NR][4]; float rstd[NR];
#pragma unroll
    for (int r = 0; r < NR; ++r) { const GAS f32x4* xr = (const GAS f32x4*)(xrow0 + r * rstride) + lane;
#pragma unroll
        for (int j = 0; j < 4; ++j) v[r][j] = __builtin_nontemporal_load(xr + 64 * j); }
    const GAS f32x4* gr = (const GAS f32x4*)gain + lane; f32x4 g[4];
#pragma unroll
    for (int j = 0; j < 4; ++j) g[j] = gr[64 * j];
#pragma unroll
    for (int r = 0; r < NR; ++r) { float s = 0.f;
#pragma unroll
        for (int j = 0; j < 4; ++j) s += (v[r][j].x * v[r][j].x + v[r][j].y * v[r][j].y) + (v[r][j].z * v[r][j].z + v[r][j].w * v[r][j].w);
        rstd[r] = rsqrtf(wave_sum(s) * (1.f / D_) + EPS_); }
#pragma unroll
    for (int r = 0; r < NR; ++r) { GAS v2u* o8 = (GAS v2u*)(orow0 + r * rstride) + lane;
#pragma unroll
        for (int j = 0; j < 4; ++j) { const f32x4 h = v[r][j] * rstd[r] * g[j]; v2u o; o.x = cvt_pk_bf16(h.x, h.y); o.y = cvt_pk_bf16(h.z, h.w); o8[64 * j] = o;
            ((GAS unsigned*)(o8row0 + r * rstride))[lane + 64 * j] = pk4_fp8(h.x, h.y, h.z, h.w); } }
}
__device__ __forceinline__ void p0_prologue(Frame& F) {
    LAS float* scr = (LAS float*)(F.lds + RING_OFF + F.wave * 16384);
    const int gw = F.vcu * 8 + F.wave, NGW = F.G * 8;
    constexpr int I_IN = 16 * 32, I_QKV = 16 * 24, I_GA = 16 * 32, I_A = 8 * 32, I_O = 16 * 32, I_DENSE = I_IN + I_QKV + 2 * I_GA + 2 * I_A + I_O;
    for (int it = gw; it < I_DENSE; it += NGW) {
        int r = it;
        if (r < I_IN) { p0_transpose_item(FIN(2) + 768, D_, 1024, INC_, FWS(bf16, WS_WIN), 0, scr, r, F.lane); continue; } r -= I_IN;
        if (r < I_QKV) { p0_transpose_item8(FIN(2), D_, 768, INC_, FWS(unsigned char, WS_WIN8Q), 0, 32.0f, scr, r, F.lane); continue; } r -= I_QKV;
        if (r < I_GA) { p0_transpose_item8(FIN(2) + 1792, D_, 1024, INC_, FWS(unsigned char, WS_WIN8), 1, 32.0f, scr, r, F.lane); continue; } r -= I_GA;
        if (r < I_GA) { p0_transpose_item8(FIN(2) + 2816, D_, 1024, INC_, FWS(unsigned char, WS_WIN8), 2, 32.0f, scr, r, F.lane); continue; } r -= I_GA;
        if (r < I_A) { p0_transpose_item(FIN(8), 512, D_, D_, FWS(bf16, WS_WA), 0, scr, r, F.lane); continue; } r -= I_A;
        if (r < I_A) { p0_transpose_item(FIN(9), 512, D_, D_, FWS(bf16, WS_WG), 0, scr, r, F.lane); continue; } r -= I_A;
        p0_transpose_item(FIN(10), D_, D_, D_, FWS(bf16, WS_WOUT), 0, scr, r, F.lane);
    }
    const int gt = F.vcu * 512 + F.tid, NGT = F.G * 512;
    for (int i = gt; i < 48 * 1024; i += NGT) { const int o = i >> 10, k = i & 1023; float v = 0.f; if (o < 4) v = FIN(12)[k * 4 + o]; else if (o < 36) v = FIN(14)[k * 32 + (o - 4)];
        FWS(bf16, WS_WR)[i] = (bf16)(cvt_pk_bf16(v, 0.f) & 0xffffu); }
    for (int i = gt; i < 8 * 128 * 128; i += NGT) { const int p = i & 127, q = (i >> 7) & 127; const float v = (p <= q) ? FIN(6)[i] : 0.f; FWS(bf16, WS_WM)[i] = (bf16)(cvt_pk_bf16(v, 0.f) & 0xffffu); }
    for (int i = gt; i < SEQ_ * 8; i += NGT) { const int pos = i >> 3, j = i & 7; const float inv = powf(500000.0f, -(float)(2 * j) / 16.0f); const float ang = (float)pos * inv;
        FWS(float, WS_ROPE)[pos * 16 + j] = cosf(ang); FWS(float, WS_ROPE)[pos * 16 + 8 + j] = sinf(ang); }
    for (int m = 4 * gw; m < T_; m += 4 * NGW) rms_rows_to_bf16<4>(F.lane, FIN(0) + (size_t)m * D_, (size_t)D_, FIN(1), FWS(bf16, WS_XN) + (size_t)m * D_, FWS(unsigned char, WS_XN8) + (size_t)m * D_);
}

__device__ __forceinline__ void attn_load(Frame& F, int au, v4u (&kv)[4], v4u (&vv)[4], bf16x8 (&qf)[2][2][2]) {
    const int tid = F.tid, lane = F.lane, w = F.wave;
    const int hk = au & 1, n = (au >> 1) & 15, b = au >> 5;
#pragma unroll
    for (int it = 0; it < 4; ++it) { const int q = it * 512 + tid, kr = q >> 3, c16 = q & 7;
        int rel = 128 * (n - 1) + kr; if (rel < 0) rel = 0;
        const size_t trow = (size_t)(b * SEQ_ + rel);
        kv[it] = *(const GAS v4u*)(FWS(bf16, WS_K) + trow * 128 + hk * 64 + c16 * 8);
        vv[it] = *(const GAS v4u*)(FWS(bf16, WS_V) + trow * 128 + hk * 64 + c16 * 8); }
    const int hq = 4 * hk + (w >> 1), qh = w & 1, c = lane & 15, g = lane >> 4, tok0 = b * SEQ_ + 128 * n;
#pragma unroll
    for (int gi = 0; gi < 2; ++gi)
#pragma unroll
        for (int qt = 0; qt < 2; ++qt)
#pragma unroll
            for (int sx = 0; sx < 2; ++sx) qf[gi][qt][sx] = *(const GAS bf16x8*)(FWS(bf16, WS_Q) + (size_t)(tok0 + 64 * qh + 32 * gi + 16 * qt + c) * 512 + hq * 64 + 32 * sx + 8 * g);
}
template <bool FIRST>
__device__ __forceinline__ void attn_unit(Frame& F, int au, const bf16x8 (&qc)[2][2][2]) {
    const int lane = F.lane, w = F.wave;
    const int hk = au & 1, n = (au >> 1) & 15, b = au >> 5;
    const int tok0 = b * SEQ_ + 128 * n;
    LAS unsigned char* Kl = F.lds;
    LAS unsigned char* Vl = F.lds + 36864;
    const int hq = 4 * hk + (w >> 1), qh = w & 1, c = lane & 15, g = lane >> 4, qq = c >> 2, pp = c & 3;
    const float sink2 = FIN(3)[hq] * LOG2E;
#pragma unroll 1
    for (int gi = 0; gi < 2; ++gi) {
        const int q0 = 64 * qh + 32 * gi;
        bf16x8 qf[2][2];
#pragma unroll
        for (int qt = 0; qt < 2; ++qt)
#pragma unroll
            for (int s = 0; s < 2; ++s) qf[qt][s] = gi ? qc[1][qt][s] : qc[0][qt][s];
        f32x4 S[10][2];
#pragma unroll
        for (int kt = 0; kt < 10; ++kt) { S[kt][0] = (f32x4){0.f, 0.f, 0.f, 0.f}; S[kt][1] = (f32x4){0.f, 0.f, 0.f, 0.f}; }
#pragma unroll
        for (int kt = 0; kt < 10; ++kt)
#pragma unroll
            for (int s = 0; s < 2; ++s) { const bf16x8 kf = *(const LAS bf16x8*)(Kl + (q0 + 16 * kt + c) * 144 + 64 * s + 16 * g);
                S[kt][0] = mfma16(kf, qf[0][s], S[kt][0]); S[kt][1] = mfma16(kf, qf[1][s], S[kt][1]); }
        float inv[2];
#pragma unroll
        for (int qt = 0; qt < 2; ++qt) {
            float m = sink2;
#pragma unroll
            for (int kt = 0; kt < 10; ++kt) {
                const int d = kt - qt;
                if (d < 0 || d > 8) continue;
#pragma unroll
                for (int i = 0; i < 4; ++i) { bool valid = true;
                    if (d == 0 || d == 8) { const int relp = 16 * d + 4 * g + i - c; valid = (relp >= 1) && (relp <= 128); }
                    if (FIRST) valid = valid && (q0 + 16 * kt + 4 * g + i >= 128);
                    const float s = valid ? S[kt][qt][i] : -1e30f; S[kt][qt][i] = s; m = fmaxf(m, s); } }
            m = fmaxf(m, __shfl_xor(m, 16)); m = fmaxf(m, __shfl_xor(m, 32));
            float sum = 0.f;
#pragma unroll
            for (int kt = 0; kt < 10; ++kt) { const int d = kt - qt;
#pragma unroll
                for (int i = 0; i < 4; ++i) { const float p = (d < 0 || d > 8) ? 0.f : fast_exp2(S[kt][qt][i] - m); S[kt][qt][i] = p; sum += p; } }
            sum += __shfl_xor(sum, 16); sum += __shfl_xor(sum, 32);
            inv[qt] = 1.0f / (sum + fast_exp2(sink2 - m));
        }
        f32x4 O[4][2];
#pragma unroll
        for (int dt = 0; dt < 4; ++dt) { O[dt][0] = (f32x4){0.f, 0.f, 0.f, 0.f}; O[dt][1] = (f32x4){0.f, 0.f, 0.f, 0.f}; }
#pragma unroll
        for (int ks = 0; ks < 5; ++ks) {
            bf16x8 pf[2];
#pragma unroll
            for (int qt = 0; qt < 2; ++qt) { const v4u pw = {cvt_pk_bf16(S[2 * ks][qt][0], S[2 * ks][qt][1]), cvt_pk_bf16(S[2 * ks][qt][2], S[2 * ks][qt][3]),
                                                              cvt_pk_bf16(S[2 * ks + 1][qt][0], S[2 * ks + 1][qt][1]), cvt_pk_bf16(S[2 * ks + 1][qt][2], S[2 * ks + 1][qt][3])};
                pf[qt] = __builtin_bit_cast(bf16x8, pw); }
            const int r1 = q0 + 32 * ks + 4 * g + qq, r2 = r1 + 16;
#pragma unroll
            for (int dt = 0; dt < 4; ++dt) {
                const s16x4 lo = vtr(Vl + r1 * 128 + ((dt ^ ((r1 >> 1) & 3)) * 32) + pp * 8);
                const s16x4 hi = vtr(Vl + r2 * 128 + ((dt ^ ((r2 >> 1) & 3)) * 32) + pp * 8);
                const bf16x8 af = (bf16x8){lo[0], lo[1], lo[2], lo[3], hi[0], hi[1], hi[2], hi[3]};
                O[dt][0] = mfma16(af, pf[0], O[dt][0]); O[dt][1] = mfma16(af, pf[1], O[dt][1]); }
        }
#pragma unroll
        for (int qt = 0; qt < 2; ++qt) { bf16* orow = FWS(bf16, WS_AO) + (size_t)(tok0 + q0 + 16 * qt + c) * 512 + hq * 64 + 4 * g;
#pragma unroll
            for (int dt = 0; dt < 4; ++dt) { const f32x4 o = O[dt][qt] * inv[qt]; v2u wv; wv.x = cvt_pk_bf16(o[0], o[1]); wv.y = cvt_pk_bf16(o[2], o[3]); *(GAS v2u*)(orow + 16 * dt) = wv; } }
    }
}
__device__ __forceinline__ int attn_unit_id(const Frame& F, int q) {
    const int pm = F.vcu + (q >> 2) * F.G, j = q & 3; if (pm >= T_ / 256) return -1;
    return ((pm >> 3) << 5) | ((2 * (pm & 7) + (j >> 1)) << 1) | (j & 1);
}
__device__ __forceinline__ void attn_phase(Frame& F) {
    int q = 0, a = attn_unit_id(F, 0); if (a < 0) return;
    LAS unsigned char* Kl = F.lds; LAS unsigned char* Vl = F.lds + 36864;
    v4u kv[4], vv[4]; bf16x8 qf[2][2][2];
    attn_load(F, a, kv, vv, qf);
    for (;;) {
#pragma unroll
        for (int it = 0; it < 4; ++it) { const int qi = it * 512 + F.tid, kr = qi >> 3, c16 = qi & 7;
            *(LAS v4u*)(Kl + kr * 144 + c16 * 16) = kv[it];
            *(LAS v4u*)(Vl + kr * 128 + (((c16 >> 1) ^ ((kr >> 1) & 3)) * 32) + (c16 & 1) * 16) = vv[it]; }
        bf16x8 qc[2][2][2];
#pragma unroll
        for (int gi = 0; gi < 2; ++gi)
#pragma unroll
            for (int qt = 0; qt < 2; ++qt)
#pragma unroll
                for (int sx = 0; sx < 2; ++sx) qc[gi][qt][sx] = qf[gi][qt][sx];
        __syncthreads();
        const int an = attn_unit_id(F, q + 1); const bool has_next = an >= 0;
        if (has_next) attn_load(F, an, kv, vv, qf);
        if (((a >> 1) & 15) == 0) attn_unit<true>(F, a, qc); else attn_unit<false>(F, a, qc);
        __syncthreads();
        if (!has_next) break;
        a = an; ++q;
    }
}
template <int H> __device__ __forceinline__ void gmlp_half(Frame& F, LAS unsigned char* tile, int tb, int w, int lane) {
    const int c = lane & 15, g = lane >> 4, qq = c >> 2, pp = c & 3;
    f32x4 acc[4][4];
#pragma unroll
    for (int dt = 0; dt < 4; ++dt)
#pragma unroll
        for (int q4 = 0; q4 < 4; ++q4) acc[dt][q4] = (f32x4){0.f, 0.f, 0.f, 0.f};
    const bf16* Wg = FWS(bf16, WS_WM) + (size_t)w * 128 * 128;
    v2u uw[4][4];
#pragma unroll
    for (int q4 = 0; q4 < 4; ++q4)
#pragma unroll
        for (int dt = 0; dt < 4; ++dt) uw[q4][dt] = *(const GAS v2u*)(FWS(bf16, WS_Z) + (size_t)(tb + 16 * (4 * H + q4) + c) * 1024 + 64 * w + 4 * g + 16 * dt);
#pragma unroll
    for (int ks = 0; ks < 2 + 2 * H; ++ks) {
        bf16x8 af[4];
        const int r1 = 32 * ks + 4 * g + qq, r2 = r1 + 16;
#pragma unroll
        for (int dt = 0; dt < 4; ++dt) { const s16x4 lo = vtr(tile + r1 * 128 + ((dt ^ ((r1 >> 1) & 3)) * 32) + pp * 8), hi = vtr(tile + r2 * 128 + ((dt ^ ((r2 >> 1) & 3)) * 32) + pp * 8);
            af[dt] = (bf16x8){lo[0], lo[1], lo[2], lo[3], hi[0], hi[1], hi[2], hi[3]}; }
#pragma unroll
        for (int q4 = 0; q4 < 4; ++q4) { const int qt = 4 * H + q4;
            if (2 * ks <= qt) {
                const v2u b0 = *(const GAS v2u*)(Wg + (size_t)(16 * qt + c) * 128 + 32 * ks + 4 * g), b1 = *(const GAS v2u*)(Wg + (size_t)(16 * qt + c) * 128 + 32 * ks + 16 + 4 * g);
                const v4u bw = {b0.x, b0.y, b1.x, b1.y}; const bf16x8 bf = __builtin_bit_cast(bf16x8, bw);
#pragma unroll
                for (int dt = 0; dt < 4; ++dt) acc[dt][q4] = mfma16(af[dt], bf, acc[dt][q4]);
            } }
    }
#pragma unroll
    for (int q4 = 0; q4 < 4; ++q4) { const int q = 16 * (4 * H + q4) + c; const float bias = FIN(7)[w * 128 + q];
        const size_t off = (size_t)(tb + q) * 1024 + 64 * w + 4 * g; bf16* go = FWS(bf16, WS_GO) + (size_t)(tb + q) * 512 + 64 * w + 4 * g;
#pragma unroll
        for (int dt = 0; dt < 4; ++dt) { const v2u uq = uw[q4][dt];
            const f32x4 mx = acc[dt][q4] + bias; v2u o; o.x = cvt_pk_bf16(bf_lo(uq.x) * mx[0], bf_hi(uq.x) * mx[1]); o.y = cvt_pk_bf16(bf_lo(uq.y) * mx[2], bf_hi(uq.y) * mx[3]);
            *(GAS v2u*)(go + 16 * dt) = o; } }
}
__device__ __forceinline__ void gmlp_load(Frame& F, int cu, v4u (&sl)[16]) {
    const int lane = F.lane, w = F.wave, c16 = lane & 7, ch0 = 64 * w + 8 * c16, p0 = lane >> 3;
    const GAS char* zb = (const GAS char*)(FWS(bf16, WS_Z) + (size_t)cu * 128 * 1024 + 512);
    const unsigned lo_s = (unsigned)(p0 * 2048 + ch0 * 2);
#pragma unroll
    for (int it = 0; it < 16; ++it) sl[it] = *(const GAS v4u*)(zb + it * 16384 + (size_t)lo_s);
}
__device__ __forceinline__ void gmlp_front(Frame& F, v4u (&sl)[16]) {
    const int lane = F.lane, w = F.wave, c16 = lane & 7, ch0 = 64 * w + 8 * c16, p0 = lane >> 3;
    LAS f32x2* stats = (LAS f32x2*)(F.lds + TAB_GATHER);
    LAS f32x2* part = stats + 128;
    LAS unsigned char* tile = F.lds + w * 16384;
    LAS f32x2* pw = part + w * 128 + p0;
#pragma unroll
    for (int it = 0; it < 16; ++it) { f32x4 a, bq; pg8::unpack8(sl[it], a, bq);
        float sm = ((a[0] + a[1]) + (a[2] + a[3])) + ((bq[0] + bq[1]) + (bq[2] + bq[3]));
        float sq = ((a[0] * a[0] + a[1] * a[1]) + (a[2] * a[2] + a[3] * a[3])) + ((bq[0] * bq[0] + bq[1] * bq[1]) + (bq[2] * bq[2] + bq[3] * bq[3]));
        sm += dpp_f<0xB1>(sm); sq += dpp_f<0xB1>(sq); sm += dpp_f<0x4E>(sm); sq += dpp_f<0x4E>(sq); sm += dpp_f<0x141>(sm); sq += dpp_f<0x141>(sq);
        if (c16 == 0) pw[8 * it] = (f32x2){sm, sq}; }
#pragma unroll
    for (int it = 0; it < 16; ++it) asm volatile("" : "+v"(sl[it]));
    __syncthreads();
    {   const int r = 16 * w + (lane >> 2), j = lane & 3;
        const f32x2 pa = part[j * 128 + r], pb = part[(j + 4) * 128 + r];
        float sm = pa.x + pb.x, sq = pa.y + pb.y;
        sm += dpp_f<0xB1>(sm); sq += dpp_f<0xB1>(sq); sm += dpp_f<0x4E>(sm); sq += dpp_f<0x4E>(sq);
        const float mean = sm * (1.f / 512.f), var = fmaxf(sq * (1.f / 512.f) - mean * mean, 0.f);
        if (j == 0) stats[r] = (f32x2){mean, rsqrtf(var + EPS_)}; }
    __syncthreads();
    const f32x4 lg0 = *(const f32x4*)(FIN(4) + ch0), lg1 = *(const f32x4*)(FIN(4) + ch0 + 4), lb0 = *(const f32x4*)(FIN(5) + ch0), lb1 = *(const f32x4*)(FIN(5) + ch0 + 4);
    const LAS f32x2* sp = stats + p0;
    LAS unsigned char* tp = tile + p0 * 128 + (((c16 >> 1) ^ ((p0 >> 1) & 3)) * 32) + (c16 & 1) * 16;
#pragma unroll
    for (int it = 0; it < 16; ++it) {
        f32x4 a, bq; pg8::unpack8(sl[it], a, bq); const f32x2 st = sp[8 * it];
        a = (a - st.x) * st.y * lg0 + lb0; bq = (bq - st.x) * st.y * lg1 + lb1;
        *(LAS v4u*)(tp + 1024 * it) = pg8::pack8(a, bq); }
    LDS_WAIT(); asm volatile("" ::: "memory");
}
__device__ __forceinline__ void gmlp_back(Frame& F, int cu) {
    LAS unsigned char* tile = F.lds + F.wave * 16384;
    gmlp_half<0>(F, tile, cu * 128, F.wave, F.lane);
    gmlp_half<1>(F, tile, cu * 128, F.wave, F.lane);
}
__device__ __forceinline__ void gmlp_pair(Frame& F, int cu) {
    v4u sa[16], sb[16];
    gmlp_load(F, cu, sa);
    gmlp_front(F, sa);
    gmlp_back(F, cu);
    __syncthreads();
    gmlp_load(F, cu + 1, sb);
    gmlp_front(F, sb);
    gmlp_back(F, cu + 1);
    __syncthreads();
}

__device__ __forceinline__ void router_phase(Frame& F) {
    const int tid = F.tid, lane = F.lane, w = F.wave;
    LAS unsigned char* wrl = F.lds;
    LAS float* g2l = (LAS float*)(F.lds + 99328);
    LAS float* lgw = (LAS float*)(F.lds + 103424) + w * 800;
    LAS unsigned* lcnt = (LAS unsigned*)(F.lds + 129024);
    LAS unsigned* lbase = (LAS unsigned*)(F.lds + 129024 + 128);
    for (int i = tid; i < 48 * 128; i += 512) { const int row = i >> 7, ch = i & 127;
        *(LAS v4u*)(wrl + row * 2064 + ch * 16) = *(const GAS v4u*)(FWS(bf16, WS_WR) + (size_t)row * 1024 + ch * 8); }
    for (int i = tid; i < 1024; i += 512) g2l[i] = FIN(11)[i];
    if (tid < 32) lcnt[tid] = 0u;
    __syncthreads();
    const int c = lane & 15, g = lane >> 4;
    for (int bq = w; bq < 16 * ((T_ / 256 - F.vcu + F.G - 1) / F.G); bq += 8) { const int bi = 16 * (F.vcu + (bq >> 4) * F.G) + (bq & 15);
        const int t0 = bi * 16;
        const GAS v4u* xrow = (const GAS v4u*)(FWS(bf16, WS_X1) + (size_t)(t0 + c) * 1024) + g;
        GAS v2u* hrow = (GAS v2u*)(FWS(unsigned char, WS_H2) + (size_t)(t0 + c) * 1024) + g;
        v4u xr[32]; float ss = 0.f;
#pragma unroll
        for (int s = 0; s < 32; ++s) xr[s] = xrow[4 * s];
#pragma unroll
        for (int s = 0; s < 32; ++s) { f32x4 a, bq; pg8::unpack8(xr[s], a, bq); ss += (a[0] * a[0] + a[1] * a[1]) + (a[2] * a[2] + a[3] * a[3]) + (bq[0] * bq[0] + bq[1] * bq[1]) + (bq[2] * bq[2] + bq[3] * bq[3]); }
#pragma unroll
        for (int s = 0; s < 32; ++s) asm volatile("" : "+v"(xr[s]));
        ss += __shfl_xor(ss, 16); ss += __shfl_xor(ss, 32);
        const float rstd = rsqrtf(ss * (1.f / D_) + EPS_);
        f32x4 acc[3] = {(f32x4){0.f, 0.f, 0.f, 0.f}, (f32x4){0.f, 0.f, 0.f, 0.f}, (f32x4){0.f, 0.f, 0.f, 0.f}};
        const LAS unsigned char* wl = wrl + c * 2064 + g * 16; const LAS unsigned char* wl2 = wl + 2 * 16 * 2064;
#pragma unroll
        for (int s = 0; s < 32; ++s) {
            f32x4 a, bq; pg8::unpack8(xr[s], a, bq);
            const f32x4 ga = *(const LAS f32x4*)(g2l + 32 * s + 8 * g), gb = *(const LAS f32x4*)(g2l + 32 * s + 8 * g + 4);
            const f32x4 ha = a * rstd * ga, hb = bq * rstd * gb;
            const v4u hw = pg8::pack8(ha, hb);
            { v2u h8; h8.x = pk4_fp8(ha[0], ha[1], ha[2], ha[3]); h8.y = pk4_fp8(hb[0], hb[1], hb[2], hb[3]); hrow[4 * s] = h8; }
            const bf16x8 af = __builtin_bit_cast(bf16x8, hw);
#pragma unroll
            for (int ot = 0; ot < 3; ++ot) { const bf16x8 bfr = *(const LAS bf16x8*)((ot == 2 ? wl2 : wl + ot * 16 * 2064) + 64 * s); acc[ot] = mfma16(af, bfr, acc[ot]); }
            if ((s & 1) == 1) asm volatile("" ::: "memory");
        }
#pragma unroll
        for (int ot = 0; ot < 3; ++ot)
#pragma unroll
            for (int i = 0; i < 4; ++i) lgw[(4 * g + i) * 49 + 16 * ot + c] = acc[ot][i];
        LDS_WAIT(); asm volatile("" ::: "memory");
        {
            const LAS float* lg = lgw + c * 49;
            float gl[4]; int gsel = 0; float gmax;
#pragma unroll
            for (int j = 0; j < 4; ++j) gl[j] = lg[j] + FIN(13)[j];
            gmax = gl[0];
#pragma unroll
            for (int j = 1; j < 4; ++j) if (gl[j] > gmax) { gmax = gl[j]; gsel = j; }
            float den = 0.f;
#pragma unroll
            for (int j = 0; j < 4; ++j) den += expf(gl[j] - gmax);
            const float gwt = 1.0f / den;
            float el[8];
#pragma unroll
            for (int j = 0; j < 8; ++j) el[j] = lg[4 + 8 * gsel + j] + FIN(15)[8 * gsel + j];
            int i1 = 0; float l1 = el[0];
#pragma unroll
            for (int j = 1; j < 8; ++j) if (el[j] > l1) { l1 = el[j]; i1 = j; }
            int i2 = -1; float l2 = -3.0e38f;
#pragma unroll
            for (int j = 0; j < 8; ++j) if (j != i1 && el[j] > l2) { l2 = el[j]; i2 = j; }
            const float e21 = expf(l2 - l1); const float w0 = gwt / (1.0f + e21), w1 = gwt * e21 / (1.0f + e21);
            if (lane < 16) {
                const int t = t0 + lane, e0 = 8 * gsel + i1, e1 = 8 * gsel + i2;
                const unsigned p0 = __hip_atomic_fetch_add(lcnt + e0, 1u, __ATOMIC_RELAXED, __HIP_MEMORY_SCOPE_WORKGROUP);
                const unsigned p1 = __hip_atomic_fetch_add(lcnt + e1, 1u, __ATOMIC_RELAXED, __HIP_MEMORY_SCOPE_WORKGROUP);
                FWS(int, WS_TOKE)[2 * t] = e0; FWS(int, WS_TOKE)[2 * t + 1] = e1; FWS(float, WS_TOKW)[2 * t] = w0; FWS(float, WS_TOKW)[2 * t + 1] = w1; FWS(int, WS_TOKP)[2 * t] = (int)p0; FWS(int, WS_TOKP)[2 * t + 1] = (int)p1;
            }
        }
        LDS_WAIT(); asm volatile("" ::: "memory");
    }
    __syncthreads();
    if (tid < 32) lbase[tid] = __hip_atomic_fetch_add(F.ctl + CW_CNT + tid, lcnt[tid], RLX_AGENT);
    __syncthreads();
    for (int bq = w; bq < 16 * ((T_ / 256 - F.vcu + F.G - 1) / F.G); bq += 8) { const int bi = 16 * (F.vcu + (bq >> 4) * F.G) + (bq & 15);
        if (lane < 16) { const int t = bi * 16 + lane;
#pragma unroll
            for (int k = 0; k < 2; ++k) { const int e = FWS(int, WS_TOKE)[2 * t + k]; const int pos = (int)lbase[e] + FWS(int, WS_TOKP)[2 * t + k]; FWS(int, WS_TOKP)[2 * t + k] = pos; FWS(int, WS_LIST)[(size_t)e * T_ + pos] = t; } }
    }
}

__device__ __forceinline__ int moe_tables(Frame& F, int gather, bool reuse = false) {
    LAS int* s_cnt = (LAS int*)(F.lds + TAB_CNT); LAS int* s_tpre = (LAS int*)(F.lds + TAB_TPRE); LAS int* s_ul = (LAS int*)(F.lds + TAB_ULIST); LAS unsigned* s_tab = (LAS unsigned*)(F.lds + TAB_GATHER);
    __syncthreads();
    if (!reuse) {
        if (F.tid < 32) s_cnt[F.tid] = (int)__hip_atomic_load(F.ctl + CW_CNT + F.tid, RLX_AGENT);
        __syncthreads();
        if (F.tid == 0) { int a = 0; for (int e = 0; e < 32; ++e) { s_tpre[e] = a; a += (s_cnt[e] + 255) >> 8; } s_tpre[32] = a; }
        __syncthreads();
    }
    const int NT = s_tpre[32];
    const int tot = 4 * NT, R = tot / F.G, rem = tot - R * F.G;
    int ex = -1, prodq = F.vcu >> 2;
    if (F.G == 256) { const int x = F.vcu >> 5, a = (F.vcu >> 2) & 7, as = (gather == 2) ? ((a + 4) & 7) : a, e4 = 4 * (8 * as + x) + (F.vcu & 3); if (e4 < rem) { ex = e4; prodq = 8 * x + as; } }
    else if (F.vcu < rem) ex = F.vcu;
    const int n_main = R < MAX_UNITS - 1 ? R : MAX_UNITS - 1, nu = n_main + (ex >= 0 ? 1 : 0);
    if (F.tid < nu) { const int L = (F.tid < n_main) ? ((gather == 2) ? n_main - 1 - F.tid : F.tid) * F.G + F.vcu : R * F.G + ex, ti = L >> 2, pn = L & 3;       int e = 0; for (int j = 1; j < 32; ++j) if (s_tpre[j] <= ti) e = j; s_ul[F.tid] = (e << 16) | (ti << 2) | pn; }
    __syncthreads();
    if (gather == 2) {
        for (int idx = F.tid; idx < nu * 256; idx += 512) { const int wd = s_ul[idx >> 8]; s_tab[idx] = (unsigned)(256 * ((wd >> 2) & 0x3fff) + (idx & 255)) * 512u; }
        __syncthreads();
    } else if (gather == 1) {
        for (int idx = F.tid; idx < nu * 256; idx += 512) { const int i = idx >> 8, r = idx & 255; const int wd = s_ul[i]; const int e = wd >> 16, ti = (wd >> 2) & 0x3fff;
            int rr = 256 * (ti - s_tpre[e]) + r; if (rr >= s_cnt[e]) rr = s_cnt[e] - 1;
            s_tab[idx] = (unsigned)FWS(int, WS_LIST)[(size_t)e * T_ + rr] * 1024u; }
        __syncthreads();
    }
    return nu | (n_main << 8) | (prodq << 16);
}

__device__ __forceinline__ void final_phase(Frame& F, bool fresh) {
    LAS int* s_tpre = (LAS int*)(F.lds + TAB_TPRE);
    if (fresh) (void)moe_tables(F, 0);
    const int gw = F.vcu * 8 + F.wave, NGW = F.G * 8, lane = F.lane;
    f32x4 gfv[4];
#pragma unroll
    for (int q = 0; q < 4; ++q) gfv[q] = *((const GAS f32x4*)FIN(19) + lane + 64 * q);
    constexpr int NR = 4;
    for (int tb = NR * gw; tb < T_; tb += NR * NGW) {
        v2u ev[NR], pv[NR]; f32x2 wv[NR];
#pragma unroll
        for (int r = 0; r < NR; ++r) { ev[r] = *(const GAS v2u*)(FWS(int, WS_TOKE) + 2 * (tb + r)); pv[r] = *(const GAS v2u*)(FWS(int, WS_TOKP) + 2 * (tb + r)); wv[r] = *(const GAS f32x2*)(FWS(float, WS_TOKW) + 2 * (tb + r)); }
        v2u xr[NR][4]; unsigned ya[NR][4], yb[NR][4];
#pragma unroll
        for (int r = 0; r < NR; ++r) {
            const size_t r0 = (size_t)(256 * s_tpre[ev[r].x] + (int)pv[r].x), r1 = (size_t)(256 * s_tpre[ev[r].y] + (int)pv[r].y);
            const GAS v2u* xp = (const GAS v2u*)(FWS(bf16, WS_X1) + (size_t)(tb + r) * 1024) + lane; const GAS unsigned* y0 = (const GAS unsigned*)(FWS(unsigned char, WS_Y) + r0 * 1024) + lane; const GAS unsigned* y1 = (const GAS unsigned*)(FWS(unsigned char, WS_Y) + r1 * 1024) + lane;
#pragma unroll
            for (int q = 0; q < 4; ++q) { xr[r][q] = __builtin_nontemporal_load(xp + 64 * q); ya[r][q] = __builtin_nontemporal_load(y0 + 64 * q); yb[r][q] = __builtin_nontemporal_load(y1 + 64 * q); } }
#pragma unroll
        for (int r = 0; r < NR; ++r) {
            f32x4 v[4]; float ss = 0.f; const float w0 = wv[r].x * (1.0f / 16.0f), w1 = wv[r].y * (1.0f / 16.0f);
#pragma unroll
            for (int q = 0; q < 4; ++q) {
                const f32x4 xa = (f32x4){bf_lo(xr[r][q].x), bf_hi(xr[r][q].x), bf_lo(xr[r][q].y), bf_hi(xr[r][q].y)};
                const f32x2 a0 = __builtin_amdgcn_cvt_pk_f32_fp8((int)ya[r][q], false), a1 = __builtin_amdgcn_cvt_pk_f32_fp8((int)ya[r][q], true), b0 = __builtin_amdgcn_cvt_pk_f32_fp8((int)yb[r][q], false), b1 = __builtin_amdgcn_cvt_pk_f32_fp8((int)yb[r][q], true);
                v[q] = xa + w0 * (f32x4){a0.x, a0.y, a1.x, a1.y} + w1 * (f32x4){b0.x, b0.y, b1.x, b1.y};
                ss += (v[q][0] * v[q][0] + v[q][1] * v[q][1]) + (v[q][2] * v[q][2] + v[q][3] * v[q][3]); }
            const float rstd = rsqrtf(wave_sum(ss) * (1.f / D_) + EPS_);
            GAS f32x4* op = (GAS f32x4*)(F.out + (size_t)(tb + r) * 1024) + lane;
#pragma unroll
            for (int q = 0; q < 4; ++q) __builtin_nontemporal_store(v[q] * rstd * gfv[q], op + 64 * q);
        }
    }
}

struct ExpItem { const float* W; unsigned char* WT; int K, N, mode, item; float scale; };
__device__ __forceinline__ ExpItem exp_item(Frame& F, int it) {
    const int e = it / 768, q = it % 768;
    if (q < 256) return ExpItem{FIN(16) + (size_t)e * D_ * DEXP, FWS(unsigned char, WS_WGU) + (size_t)e * D_ * D_, D_, DEXP, 1, q, 32.0f};
    if (q < 512) return ExpItem{FIN(17) + (size_t)e * D_ * DEXP, FWS(unsigned char, WS_WGU) + (size_t)e * D_ * D_, D_, DEXP, 2, q - 256, 32.0f};
    return ExpItem{FIN(18) + (size_t)e * DEXP * D_, FWS(unsigned char, WS_WD) + (size_t)e * D_ * DEXP, DEXP, D_, 0, q - 512, 16.0f};
}
__device__ __forceinline__ void exp_item_load(const ExpItem& d, int lane, float (&tv)[32]) {
    const int nblk = d.N / 32, kb = d.item / nblk, nb = d.item % nblk;
    const float* wp = d.W + (size_t)(64 * kb) * d.N + 32 * nb + (size_t)(lane >> 5) * d.N + (lane & 31);
#pragma unroll
    for (int i = 0; i < 32; ++i) tv[i] = __builtin_nontemporal_load(wp + (size_t)(2 * i) * d.N);
}
__device__ __forceinline__ void exp_item_finish(const ExpItem& d, int lane, LAS float* scr, const float (&tv)[32]) {
    const int nblk = d.N / 32, kb = d.item / nblk, nb = d.item % nblk, k0 = 64 * kb, n0 = 32 * nb;
#pragma unroll
    for (int i = 0; i < 32; ++i) { const int kk = 2 * i + (lane >> 5); scr[kk * 33 + (lane & 31)] = tv[i] * d.scale; }
    LDS_WAIT(); asm volatile("" ::: "memory");
    const int c = lane & 3, rowbase = (d.mode == 0) ? n0 : ((n0 >> 7) * 256 + (n0 & 127) + (d.mode == 2 ? 128 : 0));
#pragma unroll
    for (int j = 0; j < 2; ++j) { const int n = (lane >> 2) + 16 * j; const LAS float* sp = scr + (16 * c) * 33 + n;
        v4u o; o.x = pk4_fp8(sp[0 * 33], sp[1 * 33], sp[2 * 33], sp[3 * 33]); o.y = pk4_fp8(sp[4 * 33], sp[5 * 33], sp[6 * 33], sp[7 * 33]);
        o.z = pk4_fp8(sp[8 * 33], sp[9 * 33], sp[10 * 33], sp[11 * 33]); o.w = pk4_fp8(sp[12 * 33], sp[13 * 33], sp[14 * 33], sp[15 * 33]);
        *(GAS v4u*)(d.WT + (size_t)(rowbase + n) * d.K + k0 + 16 * c) = o; }
    LDS_WAIT(); asm volatile("" ::: "memory");
}
__device__ __forceinline__ void conv_expert_items(Frame& F, int j0, int cnt) {
    LAS float* scr = (LAS float*)(F.lds + RING_OFF + F.wave * 16384);
    const int gw = F.vcu * 8 + F.wave, NGW = F.G * 8, NIT = NEXP * 768;
    __syncthreads();
    int j = j0; const int jend = j0 + cnt;
    if (j < jend && gw + j * NGW < NIT) {
        ExpItem cur = exp_item(F, gw + j * NGW); float tv[32]; exp_item_load(cur, F.lane, tv);
        for (;;) {
            const int jn = j + 1; const bool hn = (jn < jend) && (gw + jn * NGW < NIT); ExpItem nd = cur; float tn[32];
            if (hn) { nd = exp_item(F, gw + jn * NGW); exp_item_load(nd, F.lane, tn); }
            exp_item_finish(cur, F.lane, scr, tv);
            if (!hn) break;
            cur = nd; j = jn;
#pragma unroll
            for (int i = 0; i < 32; ++i) tv[i] = tn[i];
        }
    }
    __syncthreads();
}
constexpr int N_PHASES = 9;

struct Args { const float* in[20]; float* out; unsigned char* ws; int ph_lo, ph_hi, li, pad; };
__global__ void __launch_bounds__(512, 2) mk_fwd(Args args) {
    extern __shared__ __attribute__((aligned(16))) unsigned char lds[];
    Frame F;
    F.lds = (LAS unsigned char*)lds;
    F.tid = threadIdx.x; F.lane = F.tid & 63; F.wave = __builtin_amdgcn_readfirstlane(F.tid >> 6);
    F.G = gridDim.x; { const int bx = blockIdx.x; F.vcu = (F.G % 8 == 0) ? (bx % 8) * (F.G / 8) + bx / 8 : bx; }
    unsigned char* ws = args.ws;
    F.ctl = (unsigned*)(ws + WS_CTL);
    F.wsp = ws; F.in = args.in; F.out = args.out;
    for (int u = F.tid; u < 128; u += 512) ((LAS unsigned*)(F.lds + LDSCTL_OFF))[u] = 0u;
    __syncthreads();
    volatile LAS unsigned* MISC = (volatile LAS unsigned*)(F.lds + MISC_OFF);
    XcdBarrier bar; bar.bar = F.ctl + CW_BAR; bar.x = 0; bar.st = nullptr;
    if (MK_N_LAUNCHES == 1) bar = xcd_barrier_post(F.ctl + CW_BAR, MISC + 8);
    unsigned* const qw = F.ctl + CW_QUAD + 32 * (F.vcu >> 2);
    if (MK_N_LAUNCHES == 1 && F.tid == 0) (void)__hip_atomic_fetch_or(qw + 16, 1u << xb_xcc_id(), __ATOMIC_RELAXED, __HIP_MEMORY_SCOPE_AGENT);
    bool q_same = false, x_same = false;
    unsigned* const xw = F.ctl + CW_XLOC + 32 * (F.vcu >> 5);
    const bool xloc = (MK_N_LAUNCHES == 1) && (F.G == 256);
    if (xloc && F.tid == 0) (void)__hip_atomic_fetch_or(xw + 16, 1u << xb_xcc_id(), __ATOMIC_RELAXED, __HIP_MEMORY_SCOPE_AGENT);
#define QUAD_BAR(n) do { if (MK_N_LAUNCHES == 1) quad_barrier(qw, 4u * (n), q_same, F.ctl + CW_BAR); } while (0)
#define GRID_BAR() do { if (MK_N_LAUNCHES == 1) xcd_barrier(bar); } while (0)
    const int lo = args.ph_lo, hi = args.ph_hi;
#ifndef PH_MASK
#define PH_MASK 0x1ff
#endif
#define IN(k) (((PH_MASK >> (k)) & 1) && lo <= (k) && (k) < hi)
#define BOTH(k) (IN(k) && IN((k) + 1))
#define LOCAL_SEAM() do { asm volatile("s_waitcnt vmcnt(0)" ::: "memory"); __syncthreads(); } while (0)
    LAS unsigned char* ring = F.lds + RING_OFF; const LAS unsigned char* gtab = F.lds + TAB_GATHER;

    if (IN(0)) { p0_prologue(F); if (BOTH(0)) GRID_BAR(); }

    if (IN(1)) {
        { pg8::DenseOrder S; S.init(FWS(bf16, WS_XN), FWS(bf16, WS_WIN), T_, 1024, D_, F.G, (int)blockIdx.x);
          pg8::EpiInProj E{FWS(bf16, WS_Q), FWS(bf16, WS_K), FWS(bf16, WS_V), FWS(bf16, WS_Z), FWS(float, WS_ROPE), 3};
          pg8::gemm_phase<pg8::EpiInProj, pg8::DenseOrder, true, false>(ring, D_, S, E, gtab); }
        { pg8::DenseOrder S; S.init(FWS(unsigned char, WS_XN8), FWS(unsigned char, WS_WIN8Q), T_, 768 + 2048, D_ / 2, F.G, (int)blockIdx.x, true);
          { LAS unsigned* tab = (LAS unsigned*)(F.lds + TAB_GATHER);
            for (int idx = F.tid; idx < MAX_UNITS * 256; idx += 512) { pg8::Unit u; if (S.next(idx >> 8, u)) tab[idx] = (unsigned)(u.pm * 256 + (idx & 255)) * 1024u; }
            __syncthreads(); }
          pg8::EpiInProj8 E{pg8::EpiInProj{FWS(bf16, WS_Q), FWS(bf16, WS_K), FWS(bf16, WS_V), FWS(bf16, WS_Z), FWS(float, WS_ROPE), 0}, pg8::EpiGates{FWS(bf16, WS_SGA), FWS(bf16, WS_SGG)}};
          pg8::gemm_phase<pg8::EpiInProj8, pg8::DenseOrder, true, true, 122, 127>(ring, D_ / 2, S, E, gtab); }
        if (BOTH(1)) {
            if (xloc) { if (F.tid == 0) MISC[13] = (__builtin_popcount(xb_ld(xw + 16)) == 1) ? 1u : 0u; __syncthreads(); x_same = MISC[13] != 0u; quad_barrier(xw, 32u, x_same, F.ctl + CW_BAR); }
            else GRID_BAR();
        }
    }
    if (IN(2)) {
        if (MK_N_LAUNCHES == 1) { if (F.tid == 0) MISC[12] = (__builtin_popcount(xb_ld(qw + 16)) == 1) ? 1u : 0u; __syncthreads(); q_same = MISC[12] != 0u; }
#ifndef P2_SKIP_ATTN
        attn_phase(F);
#endif
#ifndef P2_SKIP_GMLP
        for (int pm = F.vcu; pm < T_ / 256; pm += F.G) gmlp_pair(F, 2 * pm);
#endif
        if (BOTH(2)) QUAD_BAR(1);
    }
    if (IN(3)) {
        pg8::DualOrder S; S.init(FWS(bf16, WS_AO), FWS(bf16, WS_WA), FWS(bf16, WS_GO), FWS(bf16, WS_WG), T_, D_, 512, F.G, F.vcu);
        pg8::EpiMixFused E{FWS(bf16, WS_MIX), FWS(bf16, WS_SGA), FWS(bf16, WS_SGG)};
        pg8::gemm_phase<pg8::EpiMixFused, pg8::DualOrder, true, false>(ring, 512, S, E, gtab);
        if (BOTH(3)) QUAD_BAR(2);
    }
    if (IN(4)) {
        pg8::DenseOrder S; S.init(FWS(bf16, WS_MIX), FWS(bf16, WS_WOUT), T_, D_, D_, F.G, F.vcu, false, true); pg8::EpiResid E{FIN(0), FWS(bf16, WS_X1)};
        pg8::gemm_phase<pg8::EpiResid, pg8::DenseOrder, true, false>(ring, D_, S, E, gtab);
        if (BOTH(4)) QUAD_BAR(3);
    }
    if (IN(5)) { router_phase(F); conv_expert_items(F, 0, (NEXP * 768 + F.G * 8 - 1) / (F.G * 8));       if (BOTH(5)) GRID_BAR(); }
    if (IN(6)) {
        const int nu = moe_tables(F, 1) & 255;
        pg8::MoeOrder S{(const LAS int*)(F.lds + TAB_ULIST), nu, (const char*)FWS(unsigned char, WS_H2), 0, (const char*)FWS(unsigned char, WS_WGU), (size_t)D_ * D_, (size_t)256 * D_, 0};
        pg8::EpiGateUp E{FWS(unsigned char, WS_HID)};
        pg8::gemm_phase<pg8::EpiGateUp, pg8::MoeOrder, true, true, 122, 127>(ring, D_ / 2, S, E, gtab);
        if (BOTH(6)) { if (MK_N_LAUNCHES == 1) quad_barrier(qw, 16u, x_same, F.ctl + CW_BAR); }
    }
    if (IN(7)) {
        const int pk = moe_tables(F, 2, MK_N_LAUNCHES == 1 && lo <= 6), nu = pk & 255, n_main = (pk >> 8) & 255, prodq = pk >> 16;
        pg8::EpiDown E{FWS(unsigned char, WS_Y)};
#pragma unroll 1
        for (int pass = 0; pass < 2; ++pass) {
            const int u0 = pass ? n_main : 0, n = pass ? nu - n_main : n_main;
            if (pass && n > 0 && MK_N_LAUNCHES == 1) {
                if (F.tid == 0) { unsigned* pc = F.ctl + CW_QUAD + 32 * prodq; XB_SPIN(xb_ld(pc) < 16u, F.ctl + CW_BAR); __builtin_amdgcn_fence(__ATOMIC_ACQUIRE, "agent"); asm volatile("s_waitcnt vmcnt(0)" ::: "memory"); }
                __syncthreads(); }
            pg8::MoeOrder S{(const LAS int*)(F.lds + TAB_ULIST) + u0, n, (const char*)FWS(unsigned char, WS_HID), 0, (const char*)FWS(unsigned char, WS_WD), (size_t)D_ * DEXP, (size_t)256 * DEXP, u0};
            pg8::gemm_phase<pg8::EpiDown, pg8::MoeOrder, true, true, 123, 124>(ring, DEXP / 2 + (F.G >> 20), S, E, gtab);
        }
        if (BOTH(7)) GRID_BAR();
    }
    if (IN(8)) final_phase(F, !(MK_N_LAUNCHES == 1 && lo <= 6));
#undef IN
#undef BOTH
}

extern "C" void kernel_launch(void* const* d_in, const int* in_sizes, int n_in, void* d_out, int out_size, void* d_ws, size_t ws_size, hipStream_t stream) {
    static int grid = 0;
    if (grid == 0) {
        if (n_in != 20 || in_sizes[0] != T_ * D_ || out_size != T_ * D_ || ws_size < WS_END) { fprintf(stderr, "kernel_launch: unexpected shapes (n_in %d, in0 %d, out %d, ws %zu)\n", n_in, n_in > 0 ? in_sizes[0] : -1, out_size, ws_size); grid = -1; return; }
        int dev = 0, cus = 0, per_cu = 0;
        if (hipGetDevice(&dev) != hipSuccess || hipDeviceGetAttribute(&cus, hipDeviceAttributeMultiprocessorCount, dev) != hipSuccess) { grid = -1; return; }
        if (hipFuncSetAttribute((const void*)mk_fwd, hipFuncAttributeMaxDynamicSharedMemorySize, LDS_BYTES) != hipSuccess) { fprintf(stderr, "kernel_launch: hipFuncSetAttribute failed\n"); grid = -1; return; }
        if (hipOccupancyMaxActiveBlocksPerMultiprocessor(&per_cu, (const void*)mk_fwd, 512, LDS_BYTES) != hipSuccess || per_cu < 1) fprintf(stderr, "kernel_launch: occupancy query reports %d\n", per_cu);
        (void)hipGetLastError();
        grid = cus - cus % 4;
    }
    if (grid < 0) return;
    if (hipMemsetAsync((char*)d_ws + WS_CTL, 0, CTL_ZERO_BYTES, stream) != hipSuccess) return;
    Args a{};
    for (int i = 0; i < 20; ++i) a.in[i] = (const float*)d_in[i];
    a.out = (float*)d_out; a.ws = (unsigned char*)d_ws;
    if (MK_N_LAUNCHES == 1) { a.ph_lo = 0; a.ph_hi = N_PHASES; a.li = 0; hipLaunchKernelGGL(mk_fwd, dim3(grid), dim3(512), LDS_BYTES, stream, a); }
    else for (int li = 0; li < N_PHASES; ++li) { a.ph_lo = li; a.ph_hi = li + 1; a.li = li; hipLaunchKernelGGL(mk_fwd, dim3(grid), dim3(512), LDS_BYTES, stream, a); }
}
```

```cpp
#include <hip/hip_runtime.h>
#include <cstdio>
#include <cstdint>

#ifndef MK_N_LAUNCHES
#define MK_N_LAUNCHES 1
#endif

#define GAS __attribute__((address_space(1)))
#define LAS __attribute__((address_space(3)))
typedef unsigned short bf16;
typedef unsigned v4u __attribute__((ext_vector_type(4)));
typedef unsigned v2u __attribute__((ext_vector_type(2)));
typedef float f32x4 __attribute__((ext_vector_type(4)));
typedef float f32x2 __attribute__((ext_vector_type(2)));
typedef short bf16x8 __attribute__((ext_vector_type(8)));
typedef short s16x4 __attribute__((ext_vector_type(4)));
typedef int v8i __attribute__((ext_vector_type(8)));
typedef int v4i __attribute__((ext_vector_type(4)));

constexpr int T_ = 65536, D_ = 1024, SEQ_ = 2048, INC_ = 3840;
constexpr int NEXP = 32, DEXP = 512;
constexpr float EPS_ = 1e-5f;
constexpr float LOG2E = 1.4426950408889634f;
constexpr float QSCALE = 0.125f * LOG2E;

constexpr size_t MiB = 1u << 20;
constexpr size_t WS_CTL = 0, CTL_ZERO_BYTES = 1 * MiB;
constexpr size_t WS_WIN = 2 * MiB;
constexpr size_t WS_WIN8Q = 6 * MiB;
constexpr size_t WS_WIN8 = 6 * MiB + 768 * 1024;
constexpr size_t WS_WA = 10 * MiB, WS_WG = 11 * MiB, WS_WOUT = 12 * MiB;
constexpr size_t WS_WR = 14 * MiB;
constexpr size_t WS_WM = 14 * MiB + 256 * 1024;
constexpr size_t WS_ROPE = 14 * MiB + 512 * 1024;
constexpr size_t WS_WGU = 16 * MiB;
constexpr size_t WS_WD = 80 * MiB;
constexpr size_t WS_LIST = 112 * MiB;
constexpr size_t WS_TOKE = 120 * MiB, WS_TOKW = 121 * MiB, WS_TOKP = 122 * MiB;
constexpr size_t WS_XN = 128 * MiB;
constexpr size_t WS_Q = 256 * MiB, WS_K = 320 * MiB, WS_V = 336 * MiB, WS_AO = 352 * MiB, WS_GO = 416 * MiB;
constexpr size_t WS_Z = 480 * MiB, WS_SGA = 608 * MiB, WS_SGG = 736 * MiB, WS_MIX = 864 * MiB;
constexpr size_t WS_XN8 = 352 * MiB;
constexpr size_t WS_X1 = 128 * MiB;
constexpr size_t WS_H2 = 352 * MiB;
constexpr size_t WS_HID = 480 * MiB;
constexpr size_t WS_Y = 616 * MiB;
constexpr size_t WS_END = 992 * MiB;
constexpr int CW_BAR = 4096;
constexpr int CW_CNT = 16384;
constexpr int CW_QUAD = 32768;
constexpr int CW_XLOC = 40960;

constexpr int RING_OFF = 0, RING_BYTES = 131072;
constexpr int LDSCTL_OFF = RING_BYTES, MISC_OFF = LDSCTL_OFF + 320;
constexpr int TAB_OFF = RING_BYTES + 512;
constexpr int TAB_CNT = TAB_OFF, TAB_TPRE = TAB_OFF + 128, TAB_ULIST = TAB_OFF + 384, TAB_GATHER = TAB_OFF + 512;
constexpr int MAX_UNITS = 12;
constexpr int LDS_BYTES = 163840;
static_assert(TAB_GATHER + MAX_UNITS * 1024 <= LDS_BYTES, "LDS map");

#define RLX_AGENT __ATOMIC_RELAXED, __HIP_MEMORY_SCOPE_AGENT
#define LDS_WAIT() asm volatile("s_waitcnt lgkmcnt(0)" ::: "memory")
#define VM_WAIT() asm volatile("s_waitcnt vmcnt(0)" ::: "memory")
__device__ __forceinline__ unsigned cvt_pk_bf16(float lo, float hi) { unsigned r; asm volatile("v_cvt_pk_bf16_f32 %0, %1, %2" : "=v"(r) : "v"(lo), "v"(hi)); return r; }
__device__ __forceinline__ float bf_lo(unsigned w) { return __uint_as_float(w << 16); }
__device__ __forceinline__ float bf_hi(unsigned w) { return __uint_as_float(w & 0xffff0000u); }
__device__ __forceinline__ float fast_exp2(float x) { return __builtin_amdgcn_exp2f(x); }
__device__ __forceinline__ float fast_rcp(float x) { return __builtin_amdgcn_rcpf(x); }
__device__ __forceinline__ float gelu_tanh(float x) { const float u = x + 0.044715f * x * x * x; return x * fast_rcp(1.0f + fast_exp2(-2.302208198f * u)); }
__device__ __forceinline__ float sigmoidf_(float x) { return fast_rcp(1.0f + fast_exp2(-LOG2E * x)); }
__device__ __forceinline__ float sat448(float v) { return __builtin_amdgcn_fmed3f(v, -448.0f, 448.0f); }
__device__ __forceinline__ unsigned pk4_fp8(float a, float b, float c, float d) { int w = 0; w = __builtin_amdgcn_cvt_pk_fp8_f32(a, b, w, false); w = __builtin_amdgcn_cvt_pk_fp8_f32(c, d, w, true); return (unsigned)w; }
__device__ __forceinline__ void unpack8_fp8(const v2u w, f32x4& v0, f32x4& v1) {
    const f32x2 a = __builtin_amdgcn_cvt_pk_f32_fp8((int)w.x, false), b = __builtin_amdgcn_cvt_pk_f32_fp8((int)w.x, true), c = __builtin_amdgcn_cvt_pk_f32_fp8((int)w.y, false), d = __builtin_amdgcn_cvt_pk_f32_fp8((int)w.y, true);
    v0 = (f32x4){a.x, a.y, b.x, b.y}; v1 = (f32x4){c.x, c.y, d.x, d.y};
}
template <int CTRL> __device__ __forceinline__ float dpp_f(float v) { return __builtin_bit_cast(float, __builtin_amdgcn_update_dpp(0, __builtin_bit_cast(int, v), CTRL, 0xF, 0xF, true)); }
__device__ __forceinline__ float wave_sum(float v) {
    v += dpp_f<0xB1>(v); v += dpp_f<0x4E>(v); v += dpp_f<0x141>(v); v += dpp_f<0x140>(v);
    { const auto rr = __builtin_amdgcn_permlane16_swap(__float_as_uint(v), __float_as_uint(v), false, false); v = __uint_as_float(rr[0]) + __uint_as_float(rr[1]); }
    { const auto rr = __builtin_amdgcn_permlane32_swap(__float_as_uint(v), __float_as_uint(v), false, false); v = __uint_as_float(rr[0]) + __uint_as_float(rr[1]); }
    return v;
}
__device__ __forceinline__ f32x4 mfma16(bf16x8 a, bf16x8 b, f32x4 c) { return __builtin_amdgcn_mfma_f32_16x16x32_bf16(a, b, c, 0, 0, 0); }
typedef short v4i16_t __attribute__((ext_vector_type(4)));
__device__ __forceinline__ s16x4 vtr(LAS const unsigned char* p) { return __builtin_bit_cast(s16x4, __builtin_amdgcn_ds_read_tr16_b64_v4i16((LAS v4i16_t*)p)); }

namespace pg8 {
#define PG8_LAS __attribute__((address_space(3)))
typedef unsigned short bf16_t;
typedef unsigned u32x4 __attribute__((ext_vector_type(4)));
constexpr int BM = 256, BK = 64, HALF = 128, HTB = HALF * BK * 2, STAGE_BYTES = 8 * HTB, NXCD = 8, WGM = 8;
__host__ __device__ __forceinline__ int lds_byte(int r, int c) { const int st = (r >> 4) * 2 + (c >> 5), rr = r & 15, cc = c & 31, ob = rr * 64 + cc * 2; return st * 1024 + (ob ^ (((ob >> 9) & 1) << 5)); }
__host__ __device__ __forceinline__ void stage_rc(int b, int& R, int& C) { const int st = b / 1024, sb = b % 1024, swz = sb ^ (((sb >> 9) & 1) << 5); R = (st >> 1) * 16 + swz / 64; C = (st & 1) * 32 + (swz % 64) / 2; }
__host__ __device__ __forceinline__ int perm32(int rho) { const int n = rho >> 4, i = rho & 15; return 8 * (i >> 2) + 4 * n + (i & 3); }

template <int OFF> __device__ __forceinline__ void glds16s(const char* sbase, unsigned voff, unsigned lds_base) {
    unsigned keep;
    asm volatile("s_mov_b32 %0, m0\n\ts_add_u32 m0, %3, %4\n\ts_nop 2\n\tglobal_load_lds_dwordx4 %2, %1\n\ts_mov_b32 m0, %0" : "=&s"(keep) : "s"(sbase), "v"(voff), "s"(lds_base), "n"(OFF) : "memory", "scc");
}
struct Unit { int pm, pn; const char* a; const char* b; int aux; };

struct DenseOrder {
    const char* A; const char* Bt; int K, nM, nN, nwg, G, c; bool idg, panel;
    __device__ void init(const void* A_, const void* Bt_, int M, int N, int K_, int G_, int c_, bool idg_ = false, bool panel_ = false) { A = (const char*)A_; Bt = (const char*)Bt_; K = K_; nM = M / BM; nN = N / BM; nwg = nM * nN; G = G_; c = c_; idg = idg_; panel = panel_; }
    __device__ bool next(int i, Unit& u) const {
        if (panel) { u.pn = c & 3; u.pm = (c & ~3) + (i & 3) + (i >> 2) * G; if (u.pm >= nM) return false; }
        else {
        const long L = (long)i * G + c; if (L >= nwg) return false;
        int wgid = (int)L; { const int q = nwg / NXCD, r = nwg % NXCD, xcd = wgid % NXCD, off = wgid / NXCD; wgid = (xcd < r ? xcd * (q + 1) : r * (q + 1) + (xcd - r) * q) + off; }
        const int nig = WGM * nN, gid = wgid / nig, fm = gid * WGM, gsz = (nM - fm) < WGM ? (nM - fm) : WGM;
        u.pm = fm + ((wgid % nig) % gsz); u.pn = (wgid % nig) / gsz; }
        u.a = idg ? A : A + (size_t)u.pm * BM * K * 2; u.b = Bt + (size_t)u.pn * BM * K * 2; u.aux = idg ? i : 0; return true;
    }
};
struct DualOrder {
    const char* A[2]; const char* Bt[2]; int K, nM, nN, nwg, G, c;
    __device__ void init(const void* A0, const void* B0, const void* A1, const void* B1, int M, int N, int K_, int G_, int c_) { A[0] = (const char*)A0; Bt[0] = (const char*)B0; A[1] = (const char*)A1; Bt[1] = (const char*)B1; K = K_; nM = M / BM; nN = N / BM; nwg = nM * nN; G = G_; c = c_; }
    __device__ bool next(int i, Unit& u) const {
        const int seg = i & 1, t = i >> 1; u.pn = c & 3; u.pm = (c & ~3) + (t & 3) + (t >> 2) * G; if (u.pm >= nM) return false;
        u.a = (seg ? A[1] : A[0]) + (size_t)u.pm * BM * K * 2; u.b = (seg ? Bt[1] : Bt[0]) + (size_t)u.pn * BM * K * 2; u.aux = seg; return true;
    }
};
struct MoeOrder {
    const PG8_LAS int* ulist; int nu; const char* Abase; size_t a_tile; const char* Bbase; size_t b_exp, b_pn; int aux0;
    __device__ bool next(int i, Unit& u) const {
        if (i >= nu) return false;
        const int w = __builtin_amdgcn_readfirstlane(ulist[i]); const int e = w >> 16, ti = (w >> 2) & 0x3fff, pn = w & 3;
        u.pm = ti; u.pn = pn; u.a = Abase + (size_t)ti * a_tile; u.b = Bbase + (size_t)e * b_exp + (size_t)pn * b_pn; u.aux = i + aux0; return true;
    }
};

template <class Epi, class Sched, bool ALIGN_EPI, bool GATHER, int SA8 = 0, int SB8 = 0>
__device__ __forceinline__ void gemm_phase(PG8_LAS unsigned char* lds, const int K, const Sched& S, const Epi& E, const PG8_LAS unsigned char* gtab) {
    const int tid = threadIdx.x, wid = __builtin_amdgcn_readfirstlane(tid >> 6), lane = tid & 63, wr = wid >> 2, wc = wid & 3, fr = lane & 15, fq = lane >> 4;
    const int nt = K / BK;
    unsigned voffA[2], voffB[2]; int gRow[2]; unsigned gCol[2];
#pragma unroll
    for (int i = 0; i < 2; ++i) { int R, C; stage_rc(tid * 16 + i * 8192, R, C); const int Rb = (R & ~31) + perm32(R & 31);
        voffA[i] = (unsigned)(R * K + C) * 2u; voffB[i] = (unsigned)(Rb * K + C) * 2u; gRow[i] = R; gCol[i] = (unsigned)C * 2u; }
    const size_t kstep = (size_t)(BK * 2);
    const size_t hstep = (size_t)HALF * K * 2;
    const unsigned ldsw = (unsigned)wid * 1024u;
    const unsigned ldsb = (unsigned)(size_t)lds + ldsw;
    const int aoff = lds_byte(wr * 64 + fr, fq * 8), boff = lds_byte(wc * 32 + fr, fq * 8);
    unsigned gC[2][2], gN[2][2];
#define PG8_SA(b, h) (((b) * 2 + (h)) * HTB)
#define PG8_SB(b, h) ((4 + (b) * 2 + (h)) * HTB)
#define PG8_STAGE(bufoff, gbase, voff) do { glds16s<(bufoff)>((const char*)(gbase), (voff)[0], ldsb); glds16s<(bufoff) + 8192>((const char*)(gbase), (voff)[1], ldsb); } while (0)
#define PG8_STAGE_A(bufoff, kptr, h) PG8_STAGE(bufoff, kptr, gC[h])
#define PG8_GLOAD(dst, unit) do { _Pragma("unroll") for (int _h = 0; _h < 2; ++_h) _Pragma("unroll") for (int _i = 0; _i < 2; ++_i) \
        dst[_h][_i] = *(const PG8_LAS unsigned*)(gtab + (unit) * 1024 + (gRow[_i] + _h * HALF) * 4) + gCol[_i]; } while (0)
#define PG8_LDA(dst, b, h) do { _Pragma("unroll") for (int m = 0; m < 4; ++m) _Pragma("unroll") for (int k = 0; k < 2; ++k) dst[m][k] = *(const PG8_LAS bf16x8*)(lds + PG8_SA(b, h) + aoff + m * 2048 + k * 1024); } while (0)
#define PG8_LDB(dst, b, h) do { _Pragma("unroll") for (int n = 0; n < 2; ++n) _Pragma("unroll") for (int k = 0; k < 2; ++k) dst[n][k] = *(const PG8_LAS bf16x8*)(lds + PG8_SB(b, h) + boff + n * 2048 + k * 1024); } while (0)
#define PG8_CAT8(x0, x1) __builtin_shufflevector(__builtin_bit_cast(v4i, x0), __builtin_bit_cast(v4i, x1), 0, 1, 2, 3, 4, 5, 6, 7)
#define PG8_MMA(ai, bj, At, Bt) do { __builtin_amdgcn_s_setprio(1); _Pragma("unroll") for (int m = 0; m < 4; ++m) _Pragma("unroll") for (int n = 0; n < 2; ++n) { \
        if constexpr (SA8 != 0) { acc[ai][bj][m][n] = __builtin_amdgcn_mfma_scale_f32_16x16x128_f8f6f4(PG8_CAT8(Bt[n][0], Bt[n][1]), PG8_CAT8(At[m][0], At[m][1]), acc[ai][bj][m][n], 0, 0, 0, SA8 * 0x01010101, 0, SB8 * 0x01010101); } \
        else { _Pragma("unroll") for (int k = 0; k < 2; ++k) acc[ai][bj][m][n] = __builtin_amdgcn_mfma_f32_16x16x32_bf16(Bt[n][k], At[m][k], acc[ai][bj][m][n], 0, 0, 0); } } \
        __builtin_amdgcn_s_setprio(0); } while (0)
#define PG8_WAIT_V(n) asm volatile("s_waitcnt vmcnt(" #n ")" ::: "memory")
#define PG8_WAIT_L(n) asm volatile("s_waitcnt lgkmcnt(" #n ")" ::: "memory")
#define PG8_BAR __builtin_amdgcn_s_barrier()
#define PG8_SCHED __builtin_amdgcn_sched_barrier(0)
    Unit cur, nxt; int ui = 0;
    if (!S.next(0, cur)) return;
    f32x4 acc[2][2][4][2];
#pragma unroll
    for (int a = 0; a < 2; ++a)
#pragma unroll
        for (int b = 0; b < 2; ++b)
#pragma unroll
            for (int m = 0; m < 4; ++m)
#pragma unroll
                for (int n = 0; n < 2; ++n) acc[a][b][m][n] = (f32x4){0.f, 0.f, 0.f, 0.f};
    bf16x8 At[4][2], B0[2][2], B1[2][2];
    const char* cA = cur.a; const char* cB = cur.b;
    if constexpr (GATHER) { PG8_GLOAD(gC, cur.aux); PG8_WAIT_L(0); }
    else {
#pragma unroll
        for (int h = 0; h < 2; ++h)
#pragma unroll
            for (int i = 0; i < 2; ++i) gC[h][i] = voffA[i] + (unsigned)h * (unsigned)hstep; }
    PG8_STAGE(PG8_SB(0, 0), cB, voffB); PG8_STAGE(PG8_SB(0, 1), cB + hstep, voffB); PG8_STAGE_A(PG8_SA(0, 0), cA, 0); PG8_STAGE_A(PG8_SA(0, 1), cA, 1);
    if (wr == 1) PG8_BAR;
    PG8_WAIT_V(2); PG8_BAR;
    PG8_STAGE(PG8_SB(1, 0), cB + kstep, voffB); PG8_STAGE_A(PG8_SA(1, 0), cA + kstep, 0); PG8_STAGE(PG8_SB(1, 1), cB + hstep + kstep, voffB);
    PG8_WAIT_V(6); PG8_BAR;
    for (;;) {
        const bool has_next = S.next(ui + 1, nxt);
        const char* nA = has_next ? nxt.a : cA; const char* nB = has_next ? nxt.b : cB;
        if constexpr (GATHER) { if (has_next) { PG8_GLOAD(gN, nxt.aux); } else {
#pragma unroll
            for (int h = 0; h < 2; ++h)
#pragma unroll
                for (int i = 0; i < 2; ++i) gN[h][i] = gC[h][i]; } }
#pragma unroll 1
        for (int t = 0; t < nt; t += 2) {
            const bool last = (t == nt - 2);
            const char* a1 = cA + (size_t)(t + 1) * kstep;
            const char* a2 = last ? nA : cA + (size_t)(t + 2) * kstep; const char* b2 = last ? nB : cB + (size_t)(t + 2) * kstep;
            const char* a3 = a2 + kstep; const char* b3 = b2 + kstep;
            PG8_LDB(B0, 0, 0); PG8_LDB(B1, 0, 1); PG8_SCHED; PG8_LDA(At, 0, 0); PG8_STAGE_A(PG8_SA(1, 1), a1, 1);
            if constexpr (GATHER) { if (last) {
#pragma unroll
                for (int h = 0; h < 2; ++h)
#pragma unroll
                    for (int i = 0; i < 2; ++i) gC[h][i] = gN[h][i]; } }
            PG8_WAIT_V(8); PG8_WAIT_L(0); PG8_BAR; PG8_MMA(0, 0, At, B0); PG8_MMA(0, 1, At, B1); PG8_BAR; PG8_SCHED;
            PG8_LDA(At, 0, 1); PG8_STAGE(PG8_SB(0, 0), b2, voffB); PG8_STAGE(PG8_SB(0, 1), b2 + hstep, voffB); PG8_STAGE_A(PG8_SA(0, 0), a2, 0);
            PG8_WAIT_V(8); PG8_WAIT_L(0); PG8_BAR; PG8_MMA(1, 0, At, B0); PG8_MMA(1, 1, At, B1); PG8_BAR; PG8_SCHED;
            PG8_LDB(B0, 1, 0); PG8_LDB(B1, 1, 1); PG8_SCHED; PG8_LDA(At, 1, 0); PG8_STAGE_A(PG8_SA(0, 1), a2, 1);
            PG8_WAIT_V(8); PG8_WAIT_L(0); PG8_BAR; PG8_MMA(0, 0, At, B0); PG8_MMA(0, 1, At, B1); PG8_BAR; PG8_SCHED;
            PG8_LDA(At, 1, 1); PG8_STAGE(PG8_SB(1, 0), b3, voffB); PG8_STAGE(PG8_SB(1, 1), b3 + hstep, voffB); PG8_STAGE_A(PG8_SA(1, 0), a3, 0);
            PG8_WAIT_V(8); PG8_WAIT_L(0); PG8_BAR; PG8_MMA(1, 0, At, B0); PG8_MMA(1, 1, At, B1); PG8_BAR; PG8_SCHED;
        }
        if constexpr (ALIGN_EPI) { if (wr == 0) PG8_BAR; }
        E(acc, cur, wr, wc, fr, fq);
        if (!has_next) break;
        if (!(Epi::SEG && cur.aux == 0))
#pragma unroll
        for (int a = 0; a < 2; ++a)
#pragma unroll
            for (int b = 0; b < 2; ++b)
#pragma unroll
                for (int m = 0; m < 4; ++m)
#pragma unroll
                    for (int n = 0; n < 2; ++n) acc[a][b][m][n] = (f32x4){0.f, 0.f, 0.f, 0.f};
        cur = nxt; cA = nA; cB = nB; ++ui;
        if constexpr (ALIGN_EPI) { if (wr == 1) PG8_BAR; }
    }
    PG8_WAIT_V(0);
    if constexpr (!ALIGN_EPI) { if (wr == 0) PG8_BAR; }
    PG8_BAR;
#undef PG8_SA
#undef PG8_SB
#undef PG8_STAGE
#undef PG8_STAGE_A
#undef PG8_GLOAD
#undef PG8_LDA
#undef PG8_LDB
#undef PG8_MMA
#undef PG8_CAT8
#undef PG8_WAIT_V
#undef PG8_WAIT_L
#undef PG8_BAR
#undef PG8_SCHED
}

__device__ __forceinline__ u32x4 pack8(const f32x4 v0, const f32x4 v1) { u32x4 w; w.x = cvt_pk_bf16(v0[0], v0[1]); w.y = cvt_pk_bf16(v0[2], v0[3]); w.z = cvt_pk_bf16(v1[0], v1[1]); w.w = cvt_pk_bf16(v1[2], v1[3]); return w; }
__device__ __forceinline__ void unpack8(const u32x4 w, f32x4& v0, f32x4& v1) { v0 = (f32x4){bf_lo(w.x), bf_hi(w.x), bf_lo(w.y), bf_hi(w.y)}; v1 = (f32x4){bf_lo(w.z), bf_hi(w.z), bf_lo(w.w), bf_hi(w.w)}; }

struct EpiInProj {
    static constexpr bool SEG = false;
    bf16_t *Q, *Kb, *Vb, *Z; const float* rope; int pn0;
    __device__ __forceinline__ void operator()(const f32x4 (&acc)[2][2][4][2], const Unit& u, int wr, int wc, int fr, int fq) const {
        const int row0 = u.pm * BM + wr * 64 + fr, c8 = wc * 32 + 8 * fq, pn = u.pn + pn0;
        if (pn <= 2) {
            const bool rot_lane = ((wc & 1) == 0) && (fq < 2);
            const float sgn = (fq == 0) ? -1.f : 1.f;
#pragma unroll
            for (int ai = 0; ai < 2; ++ai)
#pragma unroll
                for (int m = 0; m < 4; ++m) {
                    const int row = row0 + ai * HALF + m * 16, pos = row & (SEQ_ - 1);
                    const f32x4 cs0 = *(const f32x4*)(rope + pos * 16), cs1 = *(const f32x4*)(rope + pos * 16 + 4), sn0 = *(const f32x4*)(rope + pos * 16 + 8), sn1 = *(const f32x4*)(rope + pos * 16 + 12);
#pragma unroll
                    for (int bj = 0; bj < 2; ++bj) {
                        f32x4 v0 = acc[ai][bj][m][0], v1 = acc[ai][bj][m][1];
                        const bool isv = (pn == 2) && (bj == 1);
                        if (!isv) {
                            f32x4 o0, o1;
#pragma unroll
                            for (int j = 0; j < 4; ++j) { o0[j] = __shfl_xor(v0[j], 16); o1[j] = __shfl_xor(v1[j], 16); }
                            if (rot_lane) { v0 = v0 * cs0 + sgn * (o0 * sn0); v1 = v1 * cs1 + sgn * (o1 * sn1); }
                        }
                        bf16_t* dst;
                        if (pn < 2) { v0 = v0 * QSCALE; v1 = v1 * QSCALE; dst = Q + (size_t)row * 512 + pn * 256 + bj * HALF + c8; }
                        else dst = (bj == 0 ? Kb : Vb) + (size_t)row * 128 + c8;
                        *(u32x4*)dst = pack8(v0, v1);
                    }
                }
        } else if (pn <= 6) {
#pragma unroll
            for (int ai = 0; ai < 2; ++ai)
#pragma unroll
                for (int m = 0; m < 4; ++m) {
                    bf16_t* rowp = Z + (size_t)(row0 + ai * HALF + m * 16) * 1024 + (pn - 3) * 256 + c8;
#pragma unroll
                    for (int bj = 0; bj < 2; ++bj) { f32x4 v0 = acc[ai][bj][m][0], v1 = acc[ai][bj][m][1];
#pragma unroll
                        for (int j = 0; j < 4; ++j) { v0[j] = gelu_tanh(v0[j]); v1[j] = gelu_tanh(v1[j]); }
                        *(u32x4*)(rowp + bj * HALF) = pack8(v0, v1); }
                }
        }
    }
};
struct EpiGates {
    static constexpr bool SEG = false;
    bf16_t *R, *S;
    __device__ __forceinline__ void operator()(const f32x4 (&acc)[2][2][4][2], const Unit& u, int wr, int wc, int fr, int fq) const {
        const int row0 = u.pm * BM + wr * 64 + fr, col0 = u.pn * HALF + wc * 32 + 8 * fq;
#pragma unroll
        for (int ai = 0; ai < 2; ++ai)
#pragma unroll
            for (int m = 0; m < 4; ++m) { f32x4 r0, r1, s0, s1;
#pragma unroll
                for (int j = 0; j < 4; ++j) { const float ea0 = fast_exp2(-LOG2E * acc[ai][0][m][0][j]), ea1 = fast_exp2(-LOG2E * acc[ai][0][m][1][j]), eg0 = fast_exp2(-LOG2E * acc[ai][1][m][0][j]), eg1 = fast_exp2(-LOG2E * acc[ai][1][m][1][j]);
                    r0[j] = (1.0f + eg0) * fast_rcp(1.0f + ea0); r1[j] = (1.0f + eg1) * fast_rcp(1.0f + ea1); s0[j] = fast_rcp(1.0f + eg0); s1[j] = fast_rcp(1.0f + eg1); }
                const size_t off = (size_t)(row0 + ai * HALF + m * 16) * 1024 + col0;
                *(u32x4*)(R + off) = pack8(r0, r1); *(u32x4*)(S + off) = pack8(s0, s1); }
    }
};
struct EpiInProj8 {
    static constexpr bool SEG = false;
    EpiInProj qkv; EpiGates gates;
    __device__ __forceinline__ void operator()(const f32x4 (&acc)[2][2][4][2], const Unit& u, int wr, int wc, int fr, int fq) const {
        if (u.pn < 3) qkv(acc, u, wr, wc, fr, fq); else { Unit v = u; v.pn = u.pn - 3; gates(acc, v, wr, wc, fr, fq); }
    }
};
struct EpiMixFused {
    static constexpr bool SEG = true;
    bf16_t* MIX; const bf16_t *SGA, *SGG;
    __device__ __forceinline__ void operator()(f32x4 (&acc)[2][2][4][2], const Unit& u, int wr, int wc, int fr, int fq) const {
        const int row0 = u.pm * BM + wr * 64 + fr, col0 = u.pn * BM + wc * 32 + 8 * fq;
        if (u.aux == 0) {
#pragma unroll
            for (int ai = 0; ai < 2; ++ai)
#pragma unroll
                for (int m = 0; m < 4; ++m) { const size_t off = (size_t)(row0 + ai * HALF + m * 16) * 1024 + col0;
#pragma unroll
                    for (int bj = 0; bj < 2; ++bj) { f32x4 a0, a1; unpack8(*(const u32x4*)(SGA + off + bj * HALF), a0, a1);
                        acc[ai][bj][m][0] = acc[ai][bj][m][0] * a0; acc[ai][bj][m][1] = acc[ai][bj][m][1] * a1; } }
        } else {
#pragma unroll
            for (int ai = 0; ai < 2; ++ai)
#pragma unroll
                for (int m = 0; m < 4; ++m) { const size_t off = (size_t)(row0 + ai * HALF + m * 16) * 1024 + col0;
#pragma unroll
                    for (int bj = 0; bj < 2; ++bj) { f32x4 g0, g1; unpack8(*(const u32x4*)(SGG + off + bj * HALF), g0, g1);
                        *(u32x4*)(MIX + off + bj * HALF) = pack8(acc[ai][bj][m][0] * g0, acc[ai][bj][m][1] * g1); } }
        }
    }
};
struct EpiResid {
    static constexpr bool SEG = false;
    const float* X; bf16_t* X1;
    __device__ __forceinline__ void operator()(const f32x4 (&acc)[2][2][4][2], const Unit& u, int wr, int wc, int fr, int fq) const {
        const int row0 = u.pm * BM + wr * 64 + fr, col0 = u.pn * BM + wc * 32 + 8 * fq;
#pragma unroll
        for (int ai = 0; ai < 2; ++ai)
#pragma unroll
            for (int m = 0; m < 4; ++m) { const size_t off = (size_t)(row0 + ai * HALF + m * 16) * 1024 + col0;
#pragma unroll
                for (int bj = 0; bj < 2; ++bj) { const f32x4 x0 = *(const f32x4*)(X + off + bj * HALF), x1 = *(const f32x4*)(X + off + bj * HALF + 4);
                    *(u32x4*)(X1 + off + bj * HALF) = pack8(acc[ai][bj][m][0] + x0, acc[ai][bj][m][1] + x1); } }
    }
};
struct EpiGateUp {
    static constexpr bool SEG = false;
    unsigned char* HID;
    __device__ __forceinline__ void operator()(const f32x4 (&acc)[2][2][4][2], const Unit& u, int wr, int wc, int fr, int fq) const {
        const int row0 = u.pm * BM + wr * 64 + fr, col0 = u.pn * HALF + wc * 32 + 8 * fq;
#pragma unroll
        for (int ai = 0; ai < 2; ++ai)
#pragma unroll
            for (int m = 0; m < 4; ++m) { f32x4 v0, v1;
#pragma unroll
                for (int j = 0; j < 4; ++j) { const float g0 = acc[ai][0][m][0][j], g1 = acc[ai][0][m][1][j];
                    v0[j] = 8.0f * g0 * sigmoidf_(g0) * acc[ai][1][m][0][j]; v1[j] = 8.0f * g1 * sigmoidf_(g1) * acc[ai][1][m][1][j]; }
                v2u o; o.x = pk4_fp8(sat448(v0[0]), sat448(v0[1]), sat448(v0[2]), sat448(v0[3])); o.y = pk4_fp8(sat448(v1[0]), sat448(v1[1]), sat448(v1[2]), sat448(v1[3]));
                *(v2u*)(HID + (size_t)(row0 + ai * HALF + m * 16) * DEXP + col0) = o; }
    }
};
struct EpiDown {
    static constexpr bool SEG = false;
    unsigned char* Y;
    __device__ __forceinline__ void operator()(const f32x4 (&acc)[2][2][4][2], const Unit& u, int wr, int wc, int fr, int fq) const {
        const int row0 = u.pm * BM + wr * 64 + fr, col0 = u.pn * BM + wc * 32 + 8 * fq;
#pragma unroll
        for (int ai = 0; ai < 2; ++ai)
#pragma unroll
            for (int m = 0; m < 4; ++m) { unsigned char* rowp = Y + (size_t)(row0 + ai * HALF + m * 16) * 1024 + col0;
#pragma unroll
                for (int bj = 0; bj < 2; ++bj) { const f32x4 v0 = acc[ai][bj][m][0] * 16.0f, v1 = acc[ai][bj][m][1] * 16.0f;
                    v2u o; o.x = pk4_fp8(sat448(v0[0]), sat448(v0[1]), sat448(v0[2]), sat448(v0[3])); o.y = pk4_fp8(sat448(v1[0]), sat448(v1[1]), sat448(v1[2]), sat448(v1[3])); *(v2u*)(rowp + bj * HALF) = o; } }
    }
};
}

#define XB_TMO      128
#define XB_XCNT(j)  (256  + 64 * (j))
#define XB_XSUB(j)  (1280 + 64 * (j))
#define XB_XGEN(j)  (2304 + 64 * (j))
#define XB_TOP      3328
#define XB_TOPGEN   3392
#define XCD_BAR_WORDS 3456
#define XB_SPIN_CAP (1u << 18)
__device__ __forceinline__ unsigned xb_ld(unsigned* p)              { return __hip_atomic_load(p, __ATOMIC_RELAXED, __HIP_MEMORY_SCOPE_AGENT); }
__device__ __forceinline__ unsigned xb_add(unsigned* p, unsigned v) { return __hip_atomic_fetch_add(p, v, __ATOMIC_RELAXED, __HIP_MEMORY_SCOPE_AGENT); }
__device__ __forceinline__ unsigned xb_xcc_id() { return (unsigned)__builtin_amdgcn_s_getreg((3 << 11) | 20) & 0xFu; }
#define XB_SPIN(cond, bar) do { unsigned _sp = 0; while (cond) { __builtin_amdgcn_s_sleep(1); \
    if ((++_sp & 255u) == 0u) { if (xb_ld(&(bar)[XB_TMO])) break; if (_sp > XB_SPIN_CAP) { atomicAdd(&(bar)[XB_TMO], 1u); break; } } } } while (0)
struct XcdBarrier { unsigned* bar; unsigned x; volatile LAS unsigned* st; };
__device__ __forceinline__ XcdBarrier xcd_barrier_post(unsigned* bar, volatile LAS unsigned* st) {
    XcdBarrier b; b.bar = bar; b.x = xb_xcc_id(); b.st = st;
    if (threadIdx.x == 0) (void)xb_add(&bar[XB_XCNT(b.x)], 1u);
    return b;
}
__device__ __forceinline__ void xcd_barrier_complete(unsigned* bar, unsigned x, unsigned& nloc, unsigned& nx) {
    const unsigned G = gridDim.x * gridDim.y * gridDim.z;
    unsigned sum, cnt, mine, sp = 0u;
    for (;;) {
        sum = 0u; cnt = 0u; mine = 0u;
#pragma unroll
        for (unsigned j = 0; j < 16; ++j) { const unsigned c = xb_ld(&bar[XB_XCNT(j)]); sum += c; cnt += (c > 0u) ? 1u : 0u; mine = (j == x) ? c : mine; }
        if (sum == G) break;
        __builtin_amdgcn_s_sleep(1);
        if ((++sp & 255u) == 0u) { if (xb_ld(&bar[XB_TMO])) break; if (sp > XB_SPIN_CAP) { atomicAdd(&bar[XB_TMO], 1u); break; } }
    }
    nloc = mine > 0u ? mine : 1u; nx = cnt > 0u ? cnt : 1u;
}
__device__ __forceinline__ void xcd_barrier(const XcdBarrier& b) {
    asm volatile("s_waitcnt vmcnt(0)" ::: "memory");
    __syncthreads();
    if (threadIdx.x == 0) {
        unsigned* bar = b.bar;
        __builtin_amdgcn_s_waitcnt(0);
        unsigned nloc = b.st[0], nx = b.st[1];
        if (nloc == 0u) { xcd_barrier_complete(bar, b.x, nloc, nx); b.st[0] = nloc; b.st[1] = nx; }
        const unsigned old = xb_add(&bar[XB_XSUB(b.x)], 1u);
        const unsigned gen = old / nloc;
        if (old + 1u == (gen + 1u) * nloc) {
            __builtin_amdgcn_fence(__ATOMIC_RELEASE, "agent");
            asm volatile("s_waitcnt vmcnt(0)" ::: "memory");
            const unsigned og = xb_add(&bar[XB_TOP], 1u);
            const unsigned tg = og / nx;
            if (og + 1u == (tg + 1u) * nx) xb_add(&bar[XB_TOPGEN], 1u);
            else XB_SPIN(xb_ld(&bar[XB_TOPGEN]) == tg, bar);
            __builtin_amdgcn_fence(__ATOMIC_ACQUIRE, "agent");
            xb_add(&bar[XB_XGEN(b.x)], 1u);
            asm volatile("s_waitcnt vmcnt(0)" ::: "memory");
        } else {
            XB_SPIN(xb_ld(&bar[XB_XGEN(b.x)]) == gen, bar);
            __builtin_amdgcn_fence(__ATOMIC_ACQUIRE, "agent");
            asm volatile("s_waitcnt vmcnt(0)" ::: "memory");
        }
    }
    __syncthreads();
}

__device__ __forceinline__ void quad_barrier(unsigned* cnt, unsigned target, bool same_xcd, unsigned* bar) {
    asm volatile("s_waitcnt vmcnt(0)" ::: "memory");
    __syncthreads();
    if (threadIdx.x == 0) {
        if (!same_xcd) { __builtin_amdgcn_fence(__ATOMIC_RELEASE, "agent"); asm volatile("s_waitcnt vmcnt(0)" ::: "memory"); }
        (void)xb_add(cnt, 1u);
        XB_SPIN(xb_ld(cnt) < target, bar);
        __builtin_amdgcn_fence(__ATOMIC_ACQUIRE, "agent");
        asm volatile("s_waitcnt vmcnt(0)" ::: "memory");
    }
    __syncthreads();
}

struct Frame {
    LAS unsigned char* lds;
    unsigned* ctl;
    int tid, lane, wave, vcu, G;
    unsigned char* wsp; const float* const* in; float* out;
};
#define FIN(k) (F.in[k])
#define FWS(T, off) ((T*)(F.wsp + (off)))

__device__ __forceinline__ void p0_transpose_item(const float* W, int K, int N, int ldw, bf16* WT, int mode, LAS float* scr, int item, int lane) {
    const int nblk = N / 32, kb = item / nblk, nb = item % nblk, k0 = 64 * kb, n0 = 32 * nb;
    float tv[32];
#pragma unroll
    for (int i = 0; i < 32; ++i) { const int kk = 2 * i + (lane >> 5); tv[i] = __builtin_nontemporal_load(W + (size_t)(k0 + kk) * ldw + n0 + (lane & 31)); }
#pragma unroll
    for (int i = 0; i < 32; ++i) { const int kk = 2 * i + (lane >> 5); scr[kk * 33 + (lane & 31)] = tv[i]; }
    LDS_WAIT(); asm volatile("" ::: "memory");
    const int c = lane & 7;
    const int rowbase = (mode == 0) ? n0 : ((n0 >> 7) * 256 + (n0 & 127) + (mode == 2 ? 128 : 0));
#pragma unroll
    for (int j = 0; j < 4; ++j) { const int n = (lane >> 3) + 8 * j; const LAS float* s = scr + (8 * c) * 33 + n;
        v4u o; o.x = cvt_pk_bf16(s[0 * 33], s[1 * 33]); o.y = cvt_pk_bf16(s[2 * 33], s[3 * 33]); o.z = cvt_pk_bf16(s[4 * 33], s[5 * 33]); o.w = cvt_pk_bf16(s[6 * 33], s[7 * 33]);
        *(GAS v4u*)(WT + (size_t)(rowbase + n) * K + k0 + 8 * c) = o; }
    LDS_WAIT(); asm volatile("" ::: "memory");
}
__device__ __forceinline__ void p0_transpose_item8(const float* W, int K, int N, int ldw, unsigned char* WT, int mode, float scale, LAS float* scr, int item, int lane) {
    const int nblk = N / 32, kb = item / nblk, nb = item % nblk, k0 = 64 * kb, n0 = 32 * nb;
    float tv[32];
#pragma unroll
    for (int i = 0; i < 32; ++i) { const int kk = 2 * i + (lane >> 5); tv[i] = __builtin_nontemporal_load(W + (size_t)(k0 + kk) * ldw + n0 + (lane & 31)); }
#pragma unroll
    for (int i = 0; i < 32; ++i) { const int kk = 2 * i + (lane >> 5); scr[kk * 33 + (lane & 31)] = tv[i] * scale; }
    LDS_WAIT(); asm volatile("" ::: "memory");
    const int c = lane & 3;
    const int rowbase = (mode == 0) ? n0 : ((n0 >> 7) * 256 + (n0 & 127) + (mode == 2 ? 128 : 0));
#pragma unroll
    for (int j = 0; j < 2; ++j) { const int n = (lane >> 2) + 16 * j; const LAS float* sp = scr + (16 * c) * 33 + n;
        v4u o; o.x = pk4_fp8(sp[0 * 33], sp[1 * 33], sp[2 * 33], sp[3 * 33]); o.y = pk4_fp8(sp[4 * 33], sp[5 * 33], sp[6 * 33], sp[7 * 33]);
        o.z = pk4_fp8(sp[8 * 33], sp[9 * 33], sp[10 * 33], sp[11 * 33]); o.w = pk4_fp8(sp[12 * 33], sp[13 * 33], sp[14 * 33], sp[15 * 33]);
        *(GAS v4u*)(WT + (size_t)(rowbase + n) * K + k0 + 16 * c) = o; }
    LDS_WAIT(); asm volatile("" ::: "memory");
}
template <int NR> __device__ __forceinline__ void rms_rows_to_bf16(int lane, const float* xrow0, size_t rstride, const float* gain, bf16* orow0, unsigned char* o8row0) {
    f32x4 v[NR][4]; float rstd[NR];
#pragma unroll
    for (int r = 0; r < NR; ++r) { const GAS f32x4* xr = (const GAS f32x4*)(xrow0 + r * rstride) + lane;
#pragma unroll
        for (int j = 0; j < 4; ++j) v[r][j] = __builtin_nontemporal_load(xr + 64 * j); }
    const GAS f32x4* gr = (const GAS f32x4*)gain + lane; f32x4 g[4];
#pragma unroll
    for (int j = 0; j < 4; ++j) g[j] = gr[64 * j];
#pragma unroll
    for (int r = 0; r < NR; ++r) { float s = 0.f;
#pragma unroll
        for (int j = 0; j < 4; ++j) s += (v[r][j].x * v[r][j].x + v[r][j].y * v[r][j].y) + (v[r][j].z * v[r][j].z + v[r][j].w * v[r][j].w);
        rstd[r] = rsqrtf(wave_sum(s) * (1.f / D_) + EPS_); }
#pragma unroll
    for (int r = 0; r < NR; ++r) { GAS v2u* o8 = (GAS v2u*)(orow0 + r * rstride) + lane;
#pragma unroll
        for (int j = 0; j < 4; ++j) { const f32x4 h = v[r][j] * rstd[r] * g[j]; v2u o; o.x = cvt_pk_bf16(h.x, h.y); o.y = cvt_pk_bf16(h.z, h.w); o8[64 * j] = o;
            ((GAS unsigned*)(o8row0 + r * rstride))[lane + 64 * j] = pk4_fp8(h.x, h.y, h.z, h.w); } }
}
__device__ __forceinline__ void p0_prologue(Frame& F) {
    LAS float* scr = (LAS float*)(F.lds + RING_OFF + F.wave * 16384);
    const int gw = F.vcu * 8 + F.wave, NGW = F.G * 8;
    constexpr int I_IN = 16 * 32, I_QKV = 16 * 24, I_GA = 16 * 32, I_A = 8 * 32, I_O = 16 * 32, I_DENSE = I_IN + I_QKV + 2 * I_GA + 2 * I_A + I_O;
    for (int it = gw; it < I_DENSE; it += NGW) {
        int r = it;
        if (r < I_IN) { p0_transpose_item(FIN(2) + 768, D_, 1024, INC_, FWS(bf16, WS_WIN), 0, scr, r, F.lane); continue; } r -= I_IN;
        if (r < I_QKV) { p0_transpose_item8(FIN(2), D_, 768, INC_, FWS(unsigned char, WS_WIN8Q), 0, 32.0f, scr, r, F.lane); continue; } r -= I_QKV;
        if (r < I_GA) { p0_transpose_item8(FIN(2) + 1792, D_, 1024, INC_, FWS(unsigned char, WS_WIN8), 1, 32.0f, scr, r, F.lane); continue; } r -= I_GA;
        if (r < I_GA) { p0_transpose_item8(FIN(2) + 2816, D_, 1024, INC_, FWS(unsigned char, WS_WIN8), 2, 32.0f, scr, r, F.lane); continue; } r -= I_GA;
        if (r < I_A) { p0_transpose_item(FIN(8), 512, D_, D_, FWS(bf16, WS_WA), 0, scr, r, F.lane); continue; } r -= I_A;
        if (r < I_A) { p0_transpose_item(FIN(9), 512, D_, D_, FWS(bf16, WS_WG), 0, scr, r, F.lane); continue; } r -= I_A;
        p0_transpose_item(FIN(10), D_, D_, D_, FWS(bf16, WS_WOUT), 0, scr, r, F.lane);
    }
    const int gt = F.vcu * 512 + F.tid, NGT = F.G * 512;
    for (int i = gt; i < 48 * 1024; i += NGT) { const int o = i >> 10, k = i & 1023; float v = 0.f; if (o < 4) v = FIN(12)[k * 4 + o]; else if (o < 36) v = FIN(14)[k * 32 + (o - 4)];
        FWS(bf16, WS_WR)[i] = (bf16)(cvt_pk_bf16(v, 0.f) & 0xffffu); }
    for (int i = gt; i < 8 * 128 * 128; i += NGT) { const int p = i & 127, q = (i >> 7) & 127; const float v = (p <= q) ? FIN(6)[i] : 0.f; FWS(bf16, WS_WM)[i] = (bf16)(cvt_pk_bf16(v, 0.f) & 0xffffu); }
    for (int i = gt; i < SEQ_ * 8; i += NGT) { const int pos = i >> 3, j = i & 7; const float inv = powf(500000.0f, -(float)(2 * j) / 16.0f); const float ang = (float)pos * inv;
        FWS(float, WS_ROPE)[pos * 16 + j] = cosf(ang); FWS(float, WS_ROPE)[pos * 16 + 8 + j] = sinf(ang); }
    for (int m = 4 * gw; m < T_; m += 4 * NGW) rms_rows_to_bf16<4>(F.lane, FIN(0) + (size_t)m * D_, (size_t)D_, FIN(1), FWS(bf16, WS_XN) + (size_t)m * D_, FWS(unsigned char, WS_XN8) + (size_t)m * D_);
}

__device__ __forceinline__ void attn_load(Frame& F, int au, v4u (&kv)[4], v4u (&vv)[4], bf16x8 (&qf)[2][2][2]) {
    const int tid = F.tid, lane = F.lane, w = F.wave;
    const int hk = au & 1, n = (au >> 1) & 15, b = au >> 5;
#pragma unroll
    for (int it = 0; it < 4; ++it) { const int q = it * 512 + tid, kr = q >> 3, c16 = q & 7;
        int rel = 128 * (n - 1) + kr; if (rel < 0) rel = 0;
        const size_t trow = (size_t)(b * SEQ_ + rel);
        kv[it] = *(const GAS v4u*)(FWS(bf16, WS_K) + trow * 128 + hk * 64 + c16 * 8);
        vv[it] = *(const GAS v4u*)(FWS(bf16, WS_V) + trow * 128 + hk * 64 + c16 * 8); }
    const int hq = 4 * hk + (w >> 1), qh = w & 1, c = lane & 15, g = lane >> 4, tok0 = b * SEQ_ + 128 * n;
#pragma unroll
    for (int gi = 0; gi < 2; ++gi)
#pragma unroll
        for (int qt = 0; qt < 2; ++qt)
#pragma unroll
            for (int sx = 0; sx < 2; ++sx) qf[gi][qt][sx] = *(const GAS bf16x8*)(FWS(bf16, WS_Q) + (size_t)(tok0 + 64 * qh + 32 * gi + 16 * qt + c) * 512 + hq * 64 + 32 * sx + 8 * g);
}
template <bool FIRST>
__device__ __forceinline__ void attn_unit(Frame& F, int au, const bf16x8 (&qc)[2][2][2]) {
    const int lane = F.lane, w = F.wave;
    const int hk = au & 1, n = (au >> 1) & 15, b = au >> 5;
    const int tok0 = b * SEQ_ + 128 * n;
    LAS unsigned char* Kl = F.lds;
    LAS unsigned char* Vl = F.lds + 36864;
    const int hq = 4 * hk + (w >> 1), qh = w & 1, c = lane & 15, g = lane >> 4, qq = c >> 2, pp = c & 3;
    const float sink2 = FIN(3)[hq] * LOG2E;
#pragma unroll 1
    for (int gi = 0; gi < 2; ++gi) {
        const int q0 = 64 * qh + 32 * gi;
        bf16x8 qf[2][2];
#pragma unroll
        for (int qt = 0; qt < 2; ++qt)
#pragma unroll
            for (int s = 0; s < 2; ++s) qf[qt][s] = gi ? qc[1][qt][s] : qc[0][qt][s];
        f32x4 S[10][2];
#pragma unroll
        for (int kt = 0; kt < 10; ++kt) { S[kt][0] = (f32x4){0.f, 0.f, 0.f, 0.f}; S[kt][1] = (f32x4){0.f, 0.f, 0.f, 0.f}; }
#pragma unroll
        for (int kt = 0; kt < 10; ++kt)
#pragma unroll
            for (int s = 0; s < 2; ++s) { const bf16x8 kf = *(const LAS bf16x8*)(Kl + (q0 + 16 * kt + c) * 144 + 64 * s + 16 * g);
                S[kt][0] = mfma16(kf, qf[0][s], S[kt][0]); S[kt][1] = mfma16(kf, qf[1][s], S[kt][1]); }
        float inv[2];
#pragma unroll
        for (int qt = 0; qt < 2; ++qt) {
            float m = sink2;
#pragma unroll
            for (int kt = 0; kt < 10; ++kt) {
                const int d = kt - qt;
                if (d < 0 || d > 8) continue;
#pragma unroll
                for (int i = 0; i < 4; ++i) { bool valid = true;
                    if (d == 0 || d == 8) { const int relp = 16 * d + 4 * g + i - c; valid = (relp >= 1) && (relp <= 128); }
                    if (FIRST) valid = valid && (q0 + 16 * kt + 4 * g + i >= 128);
                    const float s = valid ? S[kt][qt][i] : -1e30f; S[kt][qt][i] = s; m = fmaxf(m, s); } }
            m = fmaxf(m, __shfl_xor(m, 16)); m = fmaxf(m, __shfl_xor(m, 32));
            float sum = 0.f;
#pragma unroll
            for (int kt = 0; kt < 10; ++kt) { const int d = kt - qt;
#pragma unroll
                for (int i = 0; i < 4; ++i) { const float p = (d < 0 || d > 8) ? 0.f : fast_exp2(S[kt][qt][i] - m); S[kt][qt][i] = p; sum += p; } }
            sum += __shfl_xor(sum, 16); sum += __shfl_xor(sum, 32);
            inv[qt] = 1.0f / (sum + fast_exp2(sink2 - m));
        }
        f32x4 O[4][2];
#pragma unroll
        for (int dt = 0; dt < 4; ++dt) { O[dt][0] = (f32x4){0.f, 0.f, 0.f, 0.f}; O[dt][1] = (f32x4){0.f, 0.f, 0.f, 0.f}; }
#pragma unroll
        for (int ks = 0; ks < 5; ++ks) {
            bf16x8 pf[2];
#pragma unroll
            for (int qt = 0; qt < 2; ++qt) { const v4u pw = {cvt_pk_bf16(S[2 * ks][qt][0], S[2 * ks][qt][1]), cvt_pk_bf16(S[2 * ks][qt][2], S[2 * ks][qt][3]),
                                                              cvt_pk_bf16(S[2 * ks + 1][qt][0], S[2 * ks + 1][qt][1]), cvt_pk_bf16(S[2 * ks + 1][qt][2], S[2 * ks + 1][qt][3])};
                pf[qt] = __builtin_bit_cast(bf16x8, pw); }
            const int r1 = q0 + 32 * ks + 4 * g + qq, r2 = r1 + 16;
#pragma unroll
            for (int dt = 0; dt < 4; ++dt) {
                const s16x4 lo = vtr(Vl + r1 * 128 + ((dt ^ ((r1 >> 1) & 3)) * 32) + pp * 8);
                const s16x4 hi = vtr(Vl + r2 * 128 + ((dt ^ ((r2 >> 1) & 3)) * 32) + pp * 8);
                const bf16x8 af = (bf16x8){lo[0], lo[1], lo[2], lo[3], hi[0], hi[1], hi[2], hi[3]};
                O[dt][0] = mfma16(af, pf[0], O[dt][0]); O[dt][1] = mfma16(af, pf[1], O[dt][1]); }
        }
#pragma unroll
        for (int qt = 0; qt < 2; ++qt) { bf16* orow = FWS(bf16, WS_AO) + (size_t)(tok0 + q0 + 16 * qt + c) * 512 + hq * 64 + 4 * g;
#pragma unroll
            for (int dt = 0; dt < 4; ++dt) { const f32x4 o = O[dt][qt] * inv[qt]; v2u wv; wv.x = cvt_pk_bf16(o[0], o[1]); wv.y = cvt_pk_bf16(o[2], o[3]); *(GAS v2u*)(orow + 16 * dt) = wv; } }
    }
}
__device__ __forceinline__ int attn_unit_id(const Frame& F, int q) {
    const int pm = F.vcu + (q >> 2) * F.G, j = q & 3; if (pm >= T_ / 256) return -1;
    return ((pm >> 3) << 5) | ((2 * (pm & 7) + (j >> 1)) << 1) | (j & 1);
}
__device__ __forceinline__ void attn_phase(Frame& F) {
    int q = 0, a = attn_unit_id(F, 0); if (a < 0) return;
    LAS unsigned char* Kl = F.lds; LAS unsigned char* Vl = F.lds + 36864;
    v4u kv[4], vv[4]; bf16x8 qf[2][2][2];
    attn_load(F, a, kv, vv, qf);
    for (;;) {
#pragma unroll
        for (int it = 0; it < 4; ++it) { const int qi = it * 512 + F.tid, kr = qi >> 3, c16 = qi & 7;
            *(LAS v4u*)(Kl + kr * 144 + c16 * 16) = kv[it];
            *(LAS v4u*)(Vl + kr * 128 + (((c16 >> 1) ^ ((kr >> 1) & 3)) * 32) + (c16 & 1) * 16) = vv[it]; }
        bf16x8 qc[2][2][2];
#pragma unroll
        for (int gi = 0; gi < 2; ++gi)
#pragma unroll
            for (int qt = 0; qt < 2; ++qt)
#pragma unroll
                for (int sx = 0; sx < 2; ++sx) qc[gi][qt][sx] = qf[gi][qt][sx];
        __syncthreads();
        const int an = attn_unit_id(F, q + 1); const bool has_next = an >= 0;
        if (has_next) attn_load(F, an, kv, vv, qf);
        if (((a >> 1) & 15) == 0) attn_unit<true>(F, a, qc); else attn_unit<false>(F, a, qc);
        __syncthreads();
        if (!has_next) break;
        a = an; ++q;
    }
}
template <int H> __device__ __forceinline__ void gmlp_half(Frame& F, LAS unsigned char* tile, int tb, int w, int lane) {
    const int c = lane & 15, g = lane >> 4, qq = c >> 2, pp = c & 3;
    f32x4 acc[4][4];
#pragma unroll
    for (int dt = 0; dt < 4; ++dt)
#pragma unroll
        for (int q4 = 0; q4 < 4; ++q4) acc[dt][q4] = (f32x4){0.f, 0.f, 0.f, 0.f};
    const bf16* Wg = FWS(bf16, WS_WM) + (size_t)w * 128 * 128;
    v2u uw[4][4];
#pragma unroll
    for (int q4 = 0; q4 < 4; ++q4)
#pragma unroll
        for (int dt = 0; dt < 4; ++dt) uw[q4][dt] = *(const GAS v2u*)(FWS(bf16, WS_Z) + (size_t)(tb + 16 * (4 * H + q4) + c) * 1024 + 64 * w + 4 * g + 16 * dt);
#pragma unroll
    for (int ks = 0; ks < 2 + 2 * H; ++ks) {
        bf16x8 af[4];
        const int r1 = 32 * ks + 4 * g + qq, r2 = r1 + 16;
#pragma unroll
        for (int dt = 0; dt < 4; ++dt) { const s16x4 lo = vtr(tile + r1 * 128 + ((dt ^ ((r1 >> 1) & 3)) * 32) + pp * 8), hi = vtr(tile + r2 * 128 + ((dt ^ ((r2 >> 1) & 3)) * 32) + pp * 8);
            af[dt] = (bf16x8){lo[0], lo[1], lo[2], lo[3], hi[0], hi[1], hi[2], hi[3]}; }
#pragma unroll
        for (int q4 = 0; q4 < 4; ++q4) { const int qt = 4 * H + q4;
            if (2 * ks <= qt) {
                const v2u b0 = *(const GAS v2u*)(Wg + (size_t)(16 * qt + c) * 128 + 32 * ks + 4 * g), b1 = *(const GAS v2u*)(Wg + (size_t)(16 * qt + c) * 128 + 32 * ks + 16 + 4 * g);
                const v4u bw = {b0.x, b0.y, b1.x, b1.y}; const bf16x8 bf = __builtin_bit_cast(bf16x8, bw);
#pragma unroll
                for (int dt = 0; dt < 4; ++dt) acc[dt][q4] = mfma16(af[dt], bf, acc[dt][q4]);
            } }
    }
#pragma unroll
    for (int q4 = 0; q4 < 4; ++q4) { const int q = 16 * (4 * H + q4) + c; const float bias = FIN(7)[w * 128 + q];
        const size_t off = (size_t)(tb + q) * 1024 + 64 * w + 4 * g; bf16* go = FWS(bf16, WS_GO) + (size_t)(tb + q) * 512 + 64 * w + 4 * g;
#pragma unroll
        for (int dt = 0; dt < 4; ++dt) { const v2u uq = uw[q4][dt];
            const f32x4 mx = acc[dt][q4] + bias; v2u o; o.x = cvt_pk_bf16(bf_lo(uq.x) * mx[0], bf_hi(uq.x) * mx[1]); o.y = cvt_pk_bf16(bf_lo(uq.y) * mx[2], bf_hi(uq.y) * mx[3]);
            *(GAS v2u*)(go + 16 * dt) = o; } }
}
__device__ __forceinline__ void gmlp_load(Frame& F, int cu, v4u (&sl)[16]) {
    const int lane = F.lane, w = F.wave, c16 = lane & 7, ch0 = 64 * w + 8 * c16, p0 = lane >> 3;
    const GAS char* zb = (const GAS char*)(FWS(bf16, WS_Z) + (size_t)cu * 128 * 1024 + 512);
    const unsigned lo_s = (unsigned)(p0 * 2048 + ch0 * 2);
#pragma unroll
    for (int it = 0; it < 16; ++it) sl[it] = *(const GAS v4u*)(zb + it * 16384 + (size_t)lo_s);
}
__device__ __forceinline__ void gmlp_front(Frame& F, v4u (&sl)[16]) {
    const int lane = F.lane, w = F.wave, c16 = lane & 7, ch0 = 64 * w + 8 * c16, p0 = lane >> 3;
    LAS f32x2* stats = (LAS f32x2*)(F.lds + TAB_GATHER);
    LAS f32x2* part = stats + 128;
    LAS unsigned char* tile = F.lds + w * 16384;
    LAS f32x2* pw = part + w * 128 + p0;
#pragma unroll
    for (int it = 0; it < 16; ++it) { f32x4 a, bq; pg8::unpack8(sl[it], a, bq);
        float sm = ((a[0] + a[1]) + (a[2] + a[3])) + ((bq[0] + bq[1]) + (bq[2] + bq[3]));
        float sq = ((a[0] * a[0] + a[1] * a[1]) + (a[2] * a[2] + a[3] * a[3])) + ((bq[0] * bq[0] + bq[1] * bq[1]) + (bq[2] * bq[2] + bq[3] * bq[3]));
        sm += dpp_f<0xB1>(sm); sq += dpp_f<0xB1>(sq); sm += dpp_f<0x4E>(sm); sq += dpp_f<0x4E>(sq); sm += dpp_f<0x141>(sm); sq += dpp_f<0x141>(sq);
        if (c16 == 0) pw[8 * it] = (f32x2){sm, sq}; }
#pragma unroll
    for (int it = 0; it < 16; ++it) asm volatile("" : "+v"(sl[it]));
    __syncthreads();
    {   const int r = 16 * w + (lane >> 2), j = lane & 3;
        const f32x2 pa = part[j * 128 + r], pb = part[(j + 4) * 128 + r];
        float sm = pa.x + pb.x, sq = pa.y + pb.y;
        sm += dpp_f<0xB1>(sm); sq += dpp_f<0xB1>(sq); sm += dpp_f<0x4E>(sm); sq += dpp_f<0x4E>(sq);
        const float mean = sm * (1.f / 512.f), var = fmaxf(sq * (1.f / 512.f) - mean * mean, 0.f);
        if (j == 0) stats[r] = (f32x2){mean, rsqrtf(var + EPS_)}; }
    __syncthreads();
    const f32x4 lg0 = *(const f32x4*)(FIN(4) + ch0), lg1 = *(const f32x4*)(FIN(4) + ch0 + 4), lb0 = *(const f32x4*)(FIN(5) + ch0), lb1 = *(const f32x4*)(FIN(5) + ch0 + 4);
    const LAS f32x2* sp = stats + p0;
    LAS unsigned char* tp = tile + p0 * 128 + (((c16 >> 1) ^ ((p0 >> 1) & 3)) * 32) + (c16 & 1) * 16;
#pragma unroll
    for (int it = 0; it < 16; ++it) {
        f32x4 a, bq; pg8::unpack8(sl[it], a, bq); const f32x2 st = sp[8 * it];
        a = (a - st.x) * st.y * lg0 + lb0; bq = (bq - st.x) * st.y * lg1 + lb1;
        *(LAS v4u*)(tp + 1024 * it) = pg8::pack8(a, bq); }
    LDS_WAIT(); asm volatile("" ::: "memory");
}
__device__ __forceinline__ void gmlp_back(Frame& F, int cu) {
    LAS unsigned char* tile = F.lds + F.wave * 16384;
    gmlp_half<0>(F, tile, cu * 128, F.wave, F.lane);
    gmlp_half<1>(F, tile, cu * 128, F.wave, F.lane);
}
__device__ __forceinline__ void gmlp_pair(Frame& F, int cu) {
    v4u sa[16], sb[16];
    gmlp_load(F, cu, sa);
    gmlp_front(F, sa);
    gmlp_back(F, cu);
    __syncthreads();
    gmlp_load(F, cu + 1, sb);
    gmlp_front(F, sb);
    gmlp_back(F, cu + 1);
    __syncthreads();
}

__device__ __forceinline__ void router_phase(Frame& F) {
    const int tid = F.tid, lane = F.lane, w = F.wave;
    LAS unsigned char* wrl = F.lds;
    LAS float* g2l = (LAS float*)(F.lds + 99328);
    LAS float* lgw = (LAS float*)(F.lds + 103424) + w * 800;
    LAS unsigned* lcnt = (LAS unsigned*)(F.lds + 129024);
    LAS unsigned* lbase = (LAS unsigned*)(F.lds + 129024 + 128);
    for (int i = tid; i < 48 * 128; i += 512) { const int row = i >> 7, ch = i & 127;
        *(LAS v4u*)(wrl + row * 2064 + ch * 16) = *(const GAS v4u*)(FWS(bf16, WS_WR) + (size_t)row * 1024 + ch * 8); }
    for (int i = tid; i < 1024; i += 512) g2l[i] = FIN(11)[i];
    if (tid < 32) lcnt[tid] = 0u;
    __syncthreads();
    const int c = lane & 15, g = lane >> 4;
    for (int bq = w; bq < 16 * ((T_ / 256 - F.vcu + F.G - 1) / F.G); bq += 8) { const int bi = 16 * (F.vcu + (bq >> 4) * F.G) + (bq & 15);
        const int t0 = bi * 16;
        const GAS v4u* xrow = (const GAS v4u*)(FWS(bf16, WS_X1) + (size_t)(t0 + c) * 1024) + g;
        GAS v2u* hrow = (GAS v2u*)(FWS(unsigned char, WS_H2) + (size_t)(t0 + c) * 1024) + g;
        v4u xr[32]; float ss = 0.f;
#pragma unroll
        for (int s = 0; s < 32; ++s) xr[s] = xrow[4 * s];
#pragma unroll
        for (int s = 0; s < 32; ++s) { f32x4 a, bq; pg8::unpack8(xr[s], a, bq); ss += (a[0] * a[0] + a[1] * a[1]) + (a[2] * a[2] + a[3] * a[3]) + (bq[0] * bq[0] + bq[1] * bq[1]) + (bq[2] * bq[2] + bq[3] * bq[3]); }
#pragma unroll
        for (int s = 0; s < 32; ++s) asm volatile("" : "+v"(xr[s]));
        ss += __shfl_xor(ss, 16); ss += __shfl_xor(ss, 32);
        const float rstd = rsqrtf(ss * (1.f / D_) + EPS_);
        f32x4 acc[3] = {(f32x4){0.f, 0.f, 0.f, 0.f}, (f32x4){0.f, 0.f, 0.f, 0.f}, (f32x4){0.f, 0.f, 0.f, 0.f}};
        const LAS unsigned char* wl = wrl + c * 2064 + g * 16; const LAS unsigned char* wl2 = wl + 2 * 16 * 2064;
#pragma unroll
        for (int s = 0; s < 32; ++s) {
            f32x4 a, bq; pg8::unpack8(xr[s], a, bq);
            const f32x4 ga = *(const LAS f32x4*)(g2l + 32 * s + 8 * g), gb = *(const LAS f32x4*)(g2l + 32 * s + 8 * g + 4);
            const f32x4 ha = a * rstd * ga, hb = bq * rstd * gb;
            const v4u hw = pg8::pack8(ha, hb);
            { v2u h8; h8.x = pk4_fp8(ha[0], ha[1], ha[2], ha[3]); h8.y = pk4_fp8(hb[0], hb[1], hb[2], hb[3]); hrow[4 * s] = h8; }
            const bf16x8 af = __builtin_bit_cast(bf16x8, hw);
#pragma unroll
            for (int ot = 0; ot < 3; ++ot) { const bf16x8 bfr = *(const LAS bf16x8*)((ot == 2 ? wl2 : wl + ot * 16 * 2064) + 64 * s); acc[ot] = mfma16(af, bfr, acc[ot]); }
            if ((s & 1) == 1) asm volatile("" ::: "memory");
        }
#pragma unroll
        for (int ot = 0; ot < 3; ++ot)
#pragma unroll
            for (int i = 0; i < 4; ++i) lgw[(4 * g + i) * 49 + 16 * ot + c] = acc[ot][i];
        LDS_WAIT(); asm volatile("" ::: "memory");
        {
            const LAS float* lg = lgw + c * 49;
            float gl[4]; int gsel = 0; float gmax;
#pragma unroll
            for (int j = 0; j < 4; ++j) gl[j] = lg[j] + FIN(13)[j];
            gmax = gl[0];
#pragma unroll
            for (int j = 1; j < 4; ++j) if (gl[j] > gmax) { gmax = gl[j]; gsel = j; }
            float den = 0.f;
#pragma unroll
            for (int j = 0; j < 4; ++j) den += expf(gl[j] - gmax);
            const float gwt = 1.0f / den;
            float el[8];
#pragma unroll
            for (int j = 0; j < 8; ++j) el[j] = lg[4 + 8 * gsel + j] + FIN(15)[8 * gsel + j];
            int i1 = 0; float l1 = el[0];
#pragma unroll
            for (int j = 1; j < 8; ++j) if (el[j] > l1) { l1 = el[j]; i1 = j; }
            int i2 = -1; float l2 = -3.0e38f;
#pragma unroll
            for (int j = 0; j < 8; ++j) if (j != i1 && el[j] > l2) { l2 = el[j]; i2 = j; }
            const float e21 = expf(l2 - l1); const float w0 = gwt / (1.0f + e21), w1 = gwt * e21 / (1.0f + e21);
            if (lane < 16) {
                const int t = t0 + lane, e0 = 8 * gsel + i1, e1 = 8 * gsel + i2;
                const unsigned p0 = __hip_atomic_fetch_add(lcnt + e0, 1u, __ATOMIC_RELAXED, __HIP_MEMORY_SCOPE_WORKGROUP);
                const unsigned p1 = __hip_atomic_fetch_add(lcnt + e1, 1u, __ATOMIC_RELAXED, __HIP_MEMORY_SCOPE_WORKGROUP);
                FWS(int, WS_TOKE)[2 * t] = e0; FWS(int, WS_TOKE)[2 * t + 1] = e1; FWS(float, WS_TOKW)[2 * t] = w0; FWS(float, WS_TOKW)[2 * t + 1] = w1; FWS(int, WS_TOKP)[2 * t] = (int)p0; FWS(int, WS_TOKP)[2 * t + 1] = (int)p1;
            }
        }
        LDS_WAIT(); asm volatile("" ::: "memory");
    }
    __syncthreads();
    if (tid < 32) lbase[tid] = __hip_atomic_fetch_add(F.ctl + CW_CNT + tid, lcnt[tid], RLX_AGENT);
    __syncthreads();
    for (int bq = w; bq < 16 * ((T_ / 256 - F.vcu + F.G - 1) / F.G); bq += 8) { const int bi = 16 * (F.vcu + (bq >> 4) * F.G) + (bq & 15);
        if (lane < 16) { const int t = bi * 16 + lane;
#pragma unroll
            for (int k = 0; k < 2; ++k) { const int e = FWS(int, WS_TOKE)[2 * t + k]; const int pos = (int)lbase[e] + FWS(int, WS_TOKP)[2 * t + k]; FWS(int, WS_TOKP)[2 * t + k] = pos; FWS(int, WS_LIST)[(size_t)e * T_ + pos] = t; } }
    }
}

__device__ __forceinline__ int moe_tables(Frame& F, int gather, bool reuse = false) {
    LAS int* s_cnt = (LAS int*)(F.lds + TAB_CNT); LAS int* s_tpre = (LAS int*)(F.lds + TAB_TPRE); LAS int* s_ul = (LAS int*)(F.lds + TAB_ULIST); LAS unsigned* s_tab = (LAS unsigned*)(F.lds + TAB_GATHER);
    __syncthreads();
    if (!reuse) {
        if (F.tid < 32) s_cnt[F.tid] = (int)__hip_atomic_load(F.ctl + CW_CNT + F.tid, RLX_AGENT);
        __syncthreads();
        if (F.tid == 0) { int a = 0; for (int e = 0; e < 32; ++e) { s_tpre[e] = a; a += (s_cnt[e] + 255) >> 8; } s_tpre[32] = a; }
        __syncthreads();
    }
    const int NT = s_tpre[32];
    const int tot = 4 * NT, R = tot / F.G, rem = tot - R * F.G;
    int ex = -1, prodq = F.vcu >> 2;
    if (F.G == 256) { const int x = F.vcu >> 5, a = (F.vcu >> 2) & 7, as = (gather == 2) ? ((a + 4) & 7) : a, e4 = 4 * (8 * as + x) + (F.vcu & 3); if (e4 < rem) { ex = e4; prodq = 8 * x + as; } }
    else if (F.vcu < rem) ex = F.vcu;
    const int n_main = R < MAX_UNITS - 1 ? R : MAX_UNITS - 1, nu = n_main + (ex >= 0 ? 1 : 0);
    if (F.tid < nu) { const int L = (F.tid < n_main) ? ((gather == 2) ? n_main - 1 - F.tid : F.tid) * F.G + F.vcu : R * F.G + ex, ti = L >> 2, pn = L & 3;       int e = 0; for (int j = 1; j < 32; ++j) if (s_tpre[j] <= ti) e = j; s_ul[F.tid] = (e << 16) | (ti << 2) | pn; }
    __syncthreads();
    if (gather == 2) {
        for (int idx = F.tid; idx < nu * 256; idx += 512) { const int wd = s_ul[idx >> 8]; s_tab[idx] = (unsigned)(256 * ((wd >> 2) & 0x3fff) + (idx & 255)) * 512u; }
        __syncthreads();
    } else if (gather == 1) {
        for (int idx = F.tid; idx < nu * 256; idx += 512) { const int i = idx >> 8, r = idx & 255; const int wd = s_ul[i]; const int e = wd >> 16, ti = (wd >> 2) & 0x3fff;
            int rr = 256 * (ti - s_tpre[e]) + r; if (rr >= s_cnt[e]) rr = s_cnt[e] - 1;
            s_tab[idx] = (unsigned)FWS(int, WS_LIST)[(size_t)e * T_ + rr] * 1024u; }
        __syncthreads();
    }
    return nu | (n_main << 8) | (prodq << 16);
}

__device__ __forceinline__ void final_phase(Frame& F, bool fresh) {
    LAS int* s_tpre = (LAS int*)(F.lds + TAB_TPRE);
    if (fresh) (void)moe_tables(F, 0);
    const int gw = F.vcu * 8 + F.wave, NGW = F.G * 8, lane = F.lane;
    f32x4 gfv[4];
#pragma unroll
    for (int q = 0; q < 4; ++q) gfv[q] = *((const GAS f32x4*)FIN(19) + lane + 64 * q);
    constexpr int NR = 4;
    for (int tb = NR * gw; tb < T_; tb += NR * NGW) {
        v2u ev[NR], pv[NR]; f32x2 wv[NR];
#pragma unroll
        for (int r = 0; r < NR; ++r) { ev[r] = *(const GAS v2u*)(FWS(int, WS_TOKE) + 2 * (tb + r)); pv[r] = *(const GAS v2u*)(FWS(int, WS_TOKP) + 2 * (tb + r)); wv[r] = *(const GAS f32x2*)(FWS(float, WS_TOKW) + 2 * (tb + r)); }
        v2u xr[NR][4]; unsigned ya[NR][4], yb[NR][4];
#pragma unroll
        for (int r = 0; r < NR; ++r) {
            const size_t r0 = (size_t)(256 * s_tpre[ev[r].x] + (int)pv[r].x), r1 = (size_t)(256 * s_tpre[ev[r].y] + (int)pv[r].y);
            const GAS v2u* xp = (const GAS v2u*)(FWS(bf16, WS_X1) + (size_t)(tb + r) * 1024) + lane; const GAS unsigned* y0 = (const GAS unsigned*)(FWS(unsigned char, WS_Y) + r0 * 1024) + lane; const GAS unsigned* y1 = (const GAS unsigned*)(FWS(unsigned char, WS_Y) + r1 * 1024) + lane;
#pragma unroll
            for (int q = 0; q < 4; ++q) { xr[r][q] = __builtin_nontemporal_load(xp + 64 * q); ya[r][q] = y0[64 * q]; yb[r][q] = y1[64 * q]; } }
#pragma unroll
        for (int r = 0; r < NR; ++r) {
            f32x4 v[4]; float ss = 0.f; const float w0 = wv[r].x * (1.0f / 16.0f), w1 = wv[r].y * (1.0f / 16.0f);
#pragma unroll
            for (int q = 0; q < 4; ++q) {
                const f32x4 xa = (f32x4){bf_lo(xr[r][q].x), bf_hi(xr[r][q].x), bf_lo(xr[r][q].y), bf_hi(xr[r][q].y)};
                const f32x2 a0 = __builtin_amdgcn_cvt_pk_f32_fp8((int)ya[r][q], false), a1 = __builtin_amdgcn_cvt_pk_f32_fp8((int)ya[r][q], true), b0 = __builtin_amdgcn_cvt_pk_f32_fp8((int)yb[r][q], false), b1 = __builtin_amdgcn_cvt_pk_f32_fp8((int)yb[r][q], true);
                v[q] = xa + w0 * (f32x4){a0.x, a0.y, a1.x, a1.y} + w1 * (f32x4){b0.x, b0.y, b1.x, b1.y};
                ss += (v[q][0] * v[q][0] + v[q][1] * v[q][1]) + (v[q][2] * v[q][2] + v[q][3] * v[q][3]); }
            const float rstd = rsqrtf(wave_sum(ss) * (1.f / D_) + EPS_);
            GAS f32x4* op = (GAS f32x4*)(F.out + (size_t)(tb + r) * 1024) + lane;
#pragma unroll
            for (int q = 0; q < 4; ++q) __builtin_nontemporal_store(v[q] * rstd * gfv[q], op + 64 * q);
        }
    }
}

struct ExpItem { const float* W; unsigned char* WT; int K, N, mode, item; float scale; };
__device__ __forceinline__ ExpItem exp_item(Frame& F, int it) {
    const int e = it / 768, q = it % 768;
    if (q < 256) return ExpItem{FIN(16) + (size_t)e * D_ * DEXP, FWS(unsigned char, WS_WGU) + (size_t)e * D_ * D_, D_, DEXP, 1, q, 32.0f};
    if (q < 512) return ExpItem{FIN(17) + (size_t)e * D_ * DEXP, FWS(unsigned char, WS_WGU) + (size_t)e * D_ * D_, D_, DEXP, 2, q - 256, 32.0f};
    return ExpItem{FIN(18) + (size_t)e * DEXP * D_, FWS(unsigned char, WS_WD) + (size_t)e * D_ * DEXP, DEXP, D_, 0, q - 512, 16.0f};
}
__device__ __forceinline__ void exp_item_load(const ExpItem& d, int lane, float (&tv)[32]) {
    const int nblk = d.N / 32, kb = d.item / nblk, nb = d.item % nblk;
    const float* wp = d.W + (size_t)(64 * kb) * d.N + 32 * nb + (size_t)(lane >> 5) * d.N + (lane & 31);
#pragma unroll
    for (int i = 0; i < 32; ++i) tv[i] = __builtin_nontemporal_load(wp + (size_t)(2 * i) * d.N);
}
__device__ __forceinline__ void exp_item_finish(const ExpItem& d, int lane, LAS float* scr, const float (&tv)[32]) {
    const int nblk = d.N / 32, kb = d.item / nblk, nb = d.item % nblk, k0 = 64 * kb, n0 = 32 * nb;
#pragma unroll
    for (int i = 0; i < 32; ++i) { const int kk = 2 * i + (lane >> 5); scr[kk * 33 + (lane & 31)] = tv[i] * d.scale; }
    LDS_WAIT(); asm volatile("" ::: "memory");
    const int c = lane & 3, rowbase = (d.mode == 0) ? n0 : ((n0 >> 7) * 256 + (n0 & 127) + (d.mode == 2 ? 128 : 0));
#pragma unroll
    for (int j = 0; j < 2; ++j) { const int n = (lane >> 2) + 16 * j; const LAS float* sp = scr + (16 * c) * 33 + n;
        v4u o; o.x = pk4_fp8(sp[0 * 33], sp[1 * 33], sp[2 * 33], sp[3 * 33]); o.y = pk4_fp8(sp[4 * 33], sp[5 * 33], sp[6 * 33], sp[7 * 33]);
        o.z = pk4_fp8(sp[8 * 33], sp[9 * 33], sp[10 * 33], sp[11 * 33]); o.w = pk4_fp8(sp[12 * 33], sp[13 * 33], sp[14 * 33], sp[15 * 33]);
        *(GAS v4u*)(d.WT + (size_t)(rowbase + n) * d.K + k0 + 16 * c) = o; }
    LDS_WAIT(); asm volatile("" ::: "memory");
}
__device__ __forceinline__ void conv_expert_items(Frame& F, int j0, int cnt) {
    LAS float* scr = (LAS float*)(F.lds + RING_OFF + F.wave * 16384);
    const int gw = F.vcu * 8 + F.wave, NGW = F.G * 8, NIT = NEXP * 768;
    __syncthreads();
    int j = j0; const int jend = j0 + cnt;
    if (j < jend && gw + j * NGW < NIT) {
        ExpItem cur = exp_item(F, gw + j * NGW); float tv[32]; exp_item_load(cur, F.lane, tv);
        for (;;) {
            const int jn = j + 1; const bool hn = (jn < jend) && (gw + jn * NGW < NIT); ExpItem nd = cur; float tn[32];
            if (hn) { nd = exp_item(F, gw + jn * NGW); exp_item_load(nd, F.lane, tn); }
            exp_item_finish(cur, F.lane, scr, tv);
            if (!hn) break;
            cur = nd; j = jn;
#pragma unroll
            for (int i = 0; i < 32; ++i) tv[i] = tn[i];
        }
    }
    __syncthreads();
}
constexpr int N_PHASES = 9;

struct Args { const float* in[20]; float* out; unsigned char* ws; int ph_lo, ph_hi, li, pad; };
__global__ void __launch_bounds__(512, 2) mk_fwd(Args args) {
    extern __shared__ __attribute__((aligned(16))) unsigned char lds[];
    Frame F;
    F.lds = (LAS unsigned char*)lds;
    F.tid = threadIdx.x; F.lane = F.tid & 63; F.wave = __builtin_amdgcn_readfirstlane(F.tid >> 6);
    F.G = gridDim.x; { const int bx = blockIdx.x; F.vcu = (F.G % 8 == 0) ? (bx % 8) * (F.G / 8) + bx / 8 : bx; }
    unsigned char* ws = args.ws;
    F.ctl = (unsigned*)(ws + WS_CTL);
    F.wsp = ws; F.in = args.in; F.out = args.out;
    for (int u = F.tid; u < 128; u += 512) ((LAS unsigned*)(F.lds + LDSCTL_OFF))[u] = 0u;
    __syncthreads();
    volatile LAS unsigned* MISC = (volatile LAS unsigned*)(F.lds + MISC_OFF);
    XcdBarrier bar; bar.bar = F.ctl + CW_BAR; bar.x = 0; bar.st = nullptr;
    if (MK_N_LAUNCHES == 1) bar = xcd_barrier_post(F.ctl + CW_BAR, MISC + 8);
    unsigned* const qw = F.ctl + CW_QUAD + 32 * (F.vcu >> 2);
    if (MK_N_LAUNCHES == 1 && F.tid == 0) (void)__hip_atomic_fetch_or(qw + 16, 1u << xb_xcc_id(), __ATOMIC_RELAXED, __HIP_MEMORY_SCOPE_AGENT);
    bool q_same = false, x_same = false;
    unsigned* const xw = F.ctl + CW_XLOC + 32 * (F.vcu >> 5);
    const bool xloc = (MK_N_LAUNCHES == 1) && (F.G == 256);
    if (xloc && F.tid == 0) (void)__hip_atomic_fetch_or(xw + 16, 1u << xb_xcc_id(), __ATOMIC_RELAXED, __HIP_MEMORY_SCOPE_AGENT);
#define QUAD_BAR(n) do { if (MK_N_LAUNCHES == 1) quad_barrier(qw, 4u * (n), q_same, F.ctl + CW_BAR); } while (0)
#define GRID_BAR() do { if (MK_N_LAUNCHES == 1) xcd_barrier(bar); } while (0)
    const int lo = args.ph_lo, hi = args.ph_hi;
#ifndef PH_MASK
#define PH_MASK 0x1ff
#endif
#define IN(k) (((PH_MASK >> (k)) & 1) && lo <= (k) && (k) < hi)
#define BOTH(k) (IN(k) && IN((k) + 1))
#define LOCAL_SEAM() do { asm volatile("s_waitcnt vmcnt(0)" ::: "memory"); __syncthreads(); } while (0)
    LAS unsigned char* ring = F.lds + RING_OFF; const LAS unsigned char* gtab = F.lds + TAB_GATHER;

    if (IN(0)) { p0_prologue(F); if (BOTH(0)) GRID_BAR(); }

    if (IN(1)) {
        { pg8::DenseOrder S; S.init(FWS(bf16, WS_XN), FWS(bf16, WS_WIN), T_, 1024, D_, F.G, (int)blockIdx.x);
          pg8::EpiInProj E{FWS(bf16, WS_Q), FWS(bf16, WS_K), FWS(bf16, WS_V), FWS(bf16, WS_Z), FWS(float, WS_ROPE), 3};
          pg8::gemm_phase<pg8::EpiInProj, pg8::DenseOrder, true, false>(ring, D_, S, E, gtab); }
        { pg8::DenseOrder S; S.init(FWS(unsigned char, WS_XN8), FWS(unsigned char, WS_WIN8Q), T_, 768 + 2048, D_ / 2, F.G, (int)blockIdx.x, true);
          { LAS unsigned* tab = (LAS unsigned*)(F.lds + TAB_GATHER);
            for (int idx = F.tid; idx < MAX_UNITS * 256; idx += 512) { pg8::Unit u; if (S.next(idx >> 8, u)) tab[idx] = (unsigned)(u.pm * 256 + (idx & 255)) * 1024u; }
            __syncthreads(); }
          pg8::EpiInProj8 E{pg8::EpiInProj{FWS(bf16, WS_Q), FWS(bf16, WS_K), FWS(bf16, WS_V), FWS(bf16, WS_Z), FWS(float, WS_ROPE), 0}, pg8::EpiGates{FWS(bf16, WS_SGA), FWS(bf16, WS_SGG)}};
          pg8::gemm_phase<pg8::EpiInProj8, pg8::DenseOrder, true, true, 122, 127>(ring, D_ / 2, S, E, gtab); }
        if (BOTH(1)) {
            if (xloc) { if (F.tid == 0) MISC[13] = (__builtin_popcount(xb_ld(xw + 16)) == 1) ? 1u : 0u; __syncthreads(); x_same = MISC[13] != 0u; quad_barrier(xw, 32u, x_same, F.ctl + CW_BAR); }
            else GRID_BAR();
        }
    }
    if (IN(2)) {
        if (MK_N_LAUNCHES == 1) { if (F.tid == 0) MISC[12] = (__builtin_popcount(xb_ld(qw + 16)) == 1) ? 1u : 0u; __syncthreads(); q_same = MISC[12] != 0u; }
#ifndef P2_SKIP_ATTN
        attn_phase(F);
#endif
#ifndef P2_SKIP_GMLP
        for (int pm = F.vcu; pm < T_ / 256; pm += F.G) gmlp_pair(F, 2 * pm);
#endif
        if (BOTH(2)) QUAD_BAR(1);
    }
    if (IN(3)) {
        pg8::DualOrder S; S.init(FWS(bf16, WS_AO), FWS(bf16, WS_WA), FWS(bf16, WS_GO), FWS(bf16, WS_WG), T_, D_, 512, F.G, F.vcu);
        pg8::EpiMixFused E{FWS(bf16, WS_MIX), FWS(bf16, WS_SGA), FWS(bf16, WS_SGG)};
        pg8::gemm_phase<pg8::EpiMixFused, pg8::DualOrder, true, false>(ring, 512, S, E, gtab);
        if (BOTH(3)) QUAD_BAR(2);
    }
    if (IN(4)) {
        pg8::DenseOrder S; S.init(FWS(bf16, WS_MIX), FWS(bf16, WS_WOUT), T_, D_, D_, F.G, F.vcu, false, true); pg8::EpiResid E{FIN(0), FWS(bf16, WS_X1)};
        pg8::gemm_phase<pg8::EpiResid, pg8::DenseOrder, true, false>(ring, D_, S, E, gtab);
        if (BOTH(4)) QUAD_BAR(3);
    }
    if (IN(5)) { router_phase(F); conv_expert_items(F, 0, (NEXP * 768 + F.G * 8 - 1) / (F.G * 8));       if (BOTH(5)) GRID_BAR(); }
    if (IN(6)) {
        const int nu = moe_tables(F, 1) & 255;
        pg8::MoeOrder S{(const LAS int*)(F.lds + TAB_ULIST), nu, (const char*)FWS(unsigned char, WS_H2), 0, (const char*)FWS(unsigned char, WS_WGU), (size_t)D_ * D_, (size_t)256 * D_, 0};
        pg8::EpiGateUp E{FWS(unsigned char, WS_HID)};
        pg8::gemm_phase<pg8::EpiGateUp, pg8::MoeOrder, true, true, 122, 127>(ring, D_ / 2, S, E, gtab);
        if (BOTH(6)) { if (MK_N_LAUNCHES == 1) quad_barrier(qw, 16u, x_same, F.ctl + CW_BAR); }
    }
    if (IN(7)) {
        const int pk = moe_tables(F, 2, MK_N_LAUNCHES == 1 && lo <= 6), nu = pk & 255, n_main = (pk >> 8) & 255, prodq = pk >> 16;
        pg8::EpiDown E{FWS(unsigned char, WS_Y)};
#pragma unroll 1
        for (int pass = 0; pass < 2; ++pass) {
            const int u0 = pass ? n_main : 0, n = pass ? nu - n_main : n_main;
            if (pass && n > 0 && MK_N_LAUNCHES == 1) {
                if (F.tid == 0) { unsigned* pc = F.ctl + CW_QUAD + 32 * prodq; XB_SPIN(xb_ld(pc) < 16u, F.ctl + CW_BAR); __builtin_amdgcn_fence(__ATOMIC_ACQUIRE, "agent"); asm volatile("s_waitcnt vmcnt(0)" ::: "memory"); }
                __syncthreads(); }
            pg8::MoeOrder S{(const LAS int*)(F.lds + TAB_ULIST) + u0, n, (const char*)FWS(unsigned char, WS_HID), 0, (const char*)FWS(unsigned char, WS_WD), (size_t)D_ * DEXP, (size_t)256 * DEXP, u0};
            pg8::gemm_phase<pg8::EpiDown, pg8::MoeOrder, true, true, 123, 124>(ring, DEXP / 2 + (F.G >> 20), S, E, gtab);
        }
        if (BOTH(7)) GRID_BAR();
    }
    if (IN(8)) final_phase(F, !(MK_N_LAUNCHES == 1 && lo <= 6));
#undef IN
#undef BOTH
}

extern "C" void kernel_launch(void* const* d_in, const int* in_sizes, int n_in, void* d_out, int out_size, void* d_ws, size_t ws_size, hipStream_t stream) {
    static int grid = 0;
    if (grid == 0) {
        if (n_in != 20 || in_sizes[0] != T_ * D_ || out_size != T_ * D_ || ws_size < WS_END) { fprintf(stderr, "kernel_launch: unexpected shapes (n_in %d, in0 %d, out %d, ws %zu)\n", n_in, n_in > 0 ? in_sizes[0] : -1, out_size, ws_size); grid = -1; return; }
        int dev = 0, cus = 0, per_cu = 0;
        if (hipGetDevice(&dev) != hipSuccess || hipDeviceGetAttribute(&cus, hipDeviceAttributeMultiprocessorCount, dev) != hipSuccess) { grid = -1; return; }
        if (hipFuncSetAttribute((const void*)mk_fwd, hipFuncAttributeMaxDynamicSharedMemorySize, LDS_BYTES) != hipSuccess) { fprintf(stderr, "kernel_launch: hipFuncSetAttribute failed\n"); grid = -1; return; }
        if (hipOccupancyMaxActiveBlocksPerMultiprocessor(&per_cu, (const void*)mk_fwd, 512, LDS_BYTES) != hipSuccess || per_cu < 1) fprintf(stderr, "kernel_launch: occupancy query reports %d\n", per_cu);
        (void)hipGetLastError();
        grid = cus - cus % 4;
    }
    if (grid < 0) return;
    if (hipMemsetAsync((char*)d_ws + WS_CTL, 0, CTL_ZERO_BYTES, stream) != hipSuccess) return;
    Args a{};
    for (int i = 0; i < 20; ++i) a.in[i] = (const float*)d_in[i];
    a.out = (float*)d_out; a.ws = (unsigned char*)d_ws;
    if (MK_N_LAUNCHES == 1) { a.ph_lo = 0; a.ph_hi = N_PHASES; a.li = 0; hipLaunchKernelGGL(mk_fwd, dim3(grid), dim3(512), LDS_BYTES, stream, a); }
    else for (int li = 0; li < N_PHASES; ++li) { a.ph_lo = li; a.ph_hi = li + 1; a.li = li; hipLaunchKernelGGL(mk_fwd, dim3(grid), dim3(512), LDS_BYTES, stream, a); }
}
```

```cpp
#include <hip/hip_runtime.h>
#include <cstdio>
#include <cstdint>

#ifndef MK_N_LAUNCHES
#define MK_N_LAUNCHES 1
#endif

#define GAS __attribute__((address_space(1)))
#define LAS __attribute__((address_space(3)))
typedef unsigned short bf16;
typedef unsigned v4u __attribute__((ext_vector_type(4)));
typedef unsigned v2u __attribute__((ext_vector_type(2)));
typedef float f32x4 __attribute__((ext_vector_type(4)));
typedef float f32x2 __attribute__((ext_vector_type(2)));
typedef short bf16x8 __attribute__((ext_vector_type(8)));
typedef short s16x4 __attribute__((ext_vector_type(4)));
typedef int v8i __attribute__((ext_vector_type(8)));
typedef int v4i __attribute__((ext_vector_type(4)));

constexpr int T_ = 65536, D_ = 1024, SEQ_ = 2048, INC_ = 3840;
constexpr int NEXP = 32, DEXP = 512;
constexpr float EPS_ = 1e-5f;
constexpr float LOG2E = 1.4426950408889634f;
constexpr float QSCALE = 0.125f * LOG2E;

constexpr size_t MiB = 1u << 20;
constexpr size_t WS_CTL = 0, CTL_ZERO_BYTES = 1 * MiB;
constexpr size_t WS_WIN = 2 * MiB;
constexpr size_t WS_WIN8Q = 6 * MiB;
constexpr size_t WS_WIN8 = 6 * MiB + 768 * 1024;
constexpr size_t WS_WA = 10 * MiB, WS_WG = 11 * MiB, WS_WOUT = 12 * MiB;
constexpr size_t WS_WR = 14 * MiB;
constexpr size_t WS_WM = 14 * MiB + 256 * 1024;
constexpr size_t WS_ROPE = 14 * MiB + 512 * 1024;
constexpr size_t WS_WGU = 16 * MiB;
constexpr size_t WS_WD = 80 * MiB;
constexpr size_t WS_LIST = 112 * MiB;
constexpr size_t WS_TOKE = 120 * MiB, WS_TOKW = 121 * MiB, WS_TOKP = 122 * MiB;
constexpr size_t WS_XN = 128 * MiB;
constexpr size_t WS_Q = 256 * MiB, WS_K = 320 * MiB, WS_V = 336 * MiB, WS_AO = 352 * MiB, WS_GO = 416 * MiB;
constexpr size_t WS_Z = 480 * MiB, WS_SGA = 608 * MiB, WS_SGG = 736 * MiB, WS_MIX = 864 * MiB;
constexpr size_t WS_XN8 = 352 * MiB;
constexpr size_t WS_X1 = 128 * MiB;
constexpr size_t WS_H2 = 352 * MiB;
constexpr size_t WS_HID = 480 * MiB;
constexpr size_t WS_Y = 616 * MiB;
constexpr size_t WS_END = 992 * MiB;
constexpr int CW_BAR = 4096;
constexpr int CW_CNT = 16384;
constexpr int CW_QUAD = 32768;
constexpr int CW_XLOC = 40960;

constexpr int RING_OFF = 0, RING_BYTES = 131072;
constexpr int LDSCTL_OFF = RING_BYTES, MISC_OFF = LDSCTL_OFF + 320;
constexpr int TAB_OFF = RING_BYTES + 512;
constexpr int TAB_CNT = TAB_OFF, TAB_TPRE = TAB_OFF + 128, TAB_ULIST = TAB_OFF + 384, TAB_GATHER = TAB_OFF + 512;
constexpr int MAX_UNITS = 12;
constexpr int LDS_BYTES = 163840;
static_assert(TAB_GATHER + MAX_UNITS * 1024 <= LDS_BYTES, "LDS map");

#define RLX_AGENT __ATOMIC_RELAXED, __HIP_MEMORY_SCOPE_AGENT
#define LDS_WAIT() asm volatile("s_waitcnt lgkmcnt(0)" ::: "memory")
#define VM_WAIT() asm volatile("s_waitcnt vmcnt(0)" ::: "memory")
__device__ __forceinline__ unsigned cvt_pk_bf16(float lo, float hi) { unsigned r; asm volatile("v_cvt_pk_bf16_f32 %0, %1, %2" : "=v"(r) : "v"(lo), "v"(hi)); return r; }
__device__ __forceinline__ float bf_lo(unsigned w) { return __uint_as_float(w << 16); }
__device__ __forceinline__ float bf_hi(unsigned w) { return __uint_as_float(w & 0xffff0000u); }
__device__ __forceinline__ float fast_exp2(float x) { return __builtin_amdgcn_exp2f(x); }
__device__ __forceinline__ float fast_rcp(float x) { return __builtin_amdgcn_rcpf(x); }
__device__ __forceinline__ float gelu_tanh(float x) { const float u = x + 0.044715f * x * x * x; return x * fast_rcp(1.0f + fast_exp2(-2.302208198f * u)); }
__device__ __forceinline__ float sigmoidf_(float x) { return fast_rcp(1.0f + fast_exp2(-LOG2E * x)); }
__device__ __forceinline__ float sat448(float v) { return __builtin_amdgcn_fmed3f(v, -448.0f, 448.0f); }
__device__ __forceinline__ unsigned pk4_fp8(float a, float b, float c, float d) { int w = 0; w = __builtin_amdgcn_cvt_pk_fp8_f32(a, b, w, false); w = __builtin_amdgcn_cvt_pk_fp8_f32(c, d, w, true); return (unsigned)w; }
__device__ __forceinline__ void unpack8_fp8(const v2u w, f32x4& v0, f32x4& v1) {
    const f32x2 a = __builtin_amdgcn_cvt_pk_f32_fp8((int)w.x, false), b = __builtin_amdgcn_cvt_pk_f32_fp8((int)w.x, true), c = __builtin_amdgcn_cvt_pk_f32_fp8((int)w.y, false), d = __builtin_amdgcn_cvt_pk_f32_fp8((int)w.y, true);
    v0 = (f32x4){a.x, a.y, b.x, b.y}; v1 = (f32x4){c.x, c.y, d.x, d.y};
}
template <int CTRL> __device__ __forceinline__ float dpp_f(float v) { return __builtin_bit_cast(float, __builtin_amdgcn_update_dpp(0, __builtin_bit_cast(int, v), CTRL, 0xF, 0xF, true)); }
__device__ __forceinline__ float wave_sum(float v) {
    v += dpp_f<0xB1>(v); v += dpp_f<0x4E>(v); v += dpp_f<0x141>(v); v += dpp_f<0x140>(v);
    { const auto rr = __builtin_amdgcn_permlane16_swap(__float_as_uint(v), __float_as_uint(v), false, false); v = __uint_as_float(rr[0]) + __uint_as_float(rr[1]); }
    { const auto rr = __builtin_amdgcn_permlane32_swap(__float_as_uint(v), __float_as_uint(v), false, false); v = __uint_as_float(rr[0]) + __uint_as_float(rr[1]); }
    return v;
}
__device__ __forceinline__ f32x4 mfma16(bf16x8 a, bf16x8 b, f32x4 c) { return __builtin_amdgcn_mfma_f32_16x16x32_bf16(a, b, c, 0, 0, 0); }
typedef short v4i16_t __attribute__((ext_vector_type(4)));
__device__ __forceinline__ s16x4 vtr(LAS const unsigned char* p) { return __builtin_bit_cast(s16x4, __builtin_amdgcn_ds_read_tr16_b64_v4i16((LAS v4i16_t*)p)); }

namespace pg8 {
#define PG8_LAS __attribute__((address_space(3)))
typedef unsigned short bf16_t;
typedef unsigned u32x4 __attribute__((ext_vector_type(4)));
constexpr int BM = 256, BK = 64, HALF = 128, HTB = HALF * BK * 2, STAGE_BYTES = 8 * HTB, NXCD = 8, WGM = 8;
__host__ __device__ __forceinline__ int lds_byte(int r, int c) { const int st = (r >> 4) * 2 + (c >> 5), rr = r & 15, cc = c & 31, ob = rr * 64 + cc * 2; return st * 1024 + (ob ^ (((ob >> 9) & 1) << 5)); }
__host__ __device__ __forceinline__ void stage_rc(int b, int& R, int& C) { const int st = b / 1024, sb = b % 1024, swz = sb ^ (((sb >> 9) & 1) << 5); R = (st >> 1) * 16 + swz / 64; C = (st & 1) * 32 + (swz % 64) / 2; }
__host__ __device__ __forceinline__ int perm32(int rho) { const int n = rho >> 4, i = rho & 15; return 8 * (i >> 2) + 4 * n + (i & 3); }

template <int OFF> __device__ __forceinline__ void glds16s(const char* sbase, unsigned voff, unsigned lds_base) {
    unsigned keep;
    asm volatile("s_mov_b32 %0, m0\n\ts_add_u32 m0, %3, %4\n\ts_nop 2\n\tglobal_load_lds_dwordx4 %2, %1\n\ts_mov_b32 m0, %0" : "=&s"(keep) : "s"(sbase), "v"(voff), "s"(lds_base), "n"(OFF) : "memory", "scc");
}
struct Unit { int pm, pn; const char* a; const char* b; int aux; };

struct DenseOrder {
    const char* A; const char* Bt; int K, nM, nN, nwg, G, c; bool idg, panel;
    __device__ void init(const void* A_, const void* Bt_, int M, int N, int K_, int G_, int c_, bool idg_ = false, bool panel_ = false) { A = (const char*)A_; Bt = (const char*)Bt_; K = K_; nM = M / BM; nN = N / BM; nwg = nM * nN; G = G_; c = c_; idg = idg_; panel = panel_; }
    __device__ bool next(int i, Unit& u) const {
        if (panel) { u.pn = c & 3; u.pm = (c & ~3) + (i & 3) + (i >> 2) * G; if (u.pm >= nM) return false; }
        else {
        const long L = (long)i * G + c; if (L >= nwg) return false;
        int wgid = (int)L; { const int q = nwg / NXCD, r = nwg % NXCD, xcd = wgid % NXCD, off = wgid / NXCD; wgid = (xcd < r ? xcd * (q + 1) : r * (q + 1) + (xcd - r) * q) + off; }
        const int nig = WGM * nN, gid = wgid / nig, fm = gid * WGM, gsz = (nM - fm) < WGM ? (nM - fm) : WGM;
        u.pm = fm + ((wgid % nig) % gsz); u.pn = (wgid % nig) / gsz; }
        u.a = idg ? A : A + (size_t)u.pm * BM * K * 2; u.b = Bt + (size_t)u.pn * BM * K * 2; u.aux = idg ? i : 0; return true;
    }
};
struct DualOrder {
    const char* A[2]; const char* Bt[2]; int K, nM, nN, nwg, G, c;
    __device__ void init(const void* A0, const void* B0, const void* A1, const void* B1, int M, int N, int K_, int G_, int c_) { A[0] = (const char*)A0; Bt[0] = (const char*)B0; A[1] = (const char*)A1; Bt[1] = (const char*)B1; K = K_; nM = M / BM; nN = N / BM; nwg = nM * nN; G = G_; c = c_; }
    __device__ bool next(int i, Unit& u) const {
        const int seg = i & 1, t = i >> 1; u.pn = c & 3; u.pm = (c & ~3) + (t & 3) + (t >> 2) * G; if (u.pm >= nM) return false;
        u.a = (seg ? A[1] : A[0]) + (size_t)u.pm * BM * K * 2; u.b = (seg ? Bt[1] : Bt[0]) + (size_t)u.pn * BM * K * 2; u.aux = seg; return true;
    }
};
struct MoeOrder {
    const PG8_LAS int* ulist; int nu; const char* Abase; size_t a_tile; const char* Bbase; size_t b_exp, b_pn; int aux0;
    __device__ bool next(int i, Unit& u) const {
        if (i >= nu) return false;
        const int w = __builtin_amdgcn_readfirstlane(ulist[i]); const int e = w >> 16, ti = (w >> 2) & 0x3fff, pn = w & 3;
        u.pm = ti; u.pn = pn; u.a = Abase + (size_t)ti * a_tile; u.b = Bbase + (size_t)e * b_exp + (size_t)pn * b_pn; u.aux = i + aux0; return true;
    }
};

template <class Epi, class Sched, bool ALIGN_EPI, bool GATHER, int SA8 = 0, int SB8 = 0>
__device__ __forceinline__ void gemm_phase(PG8_LAS unsigned char* lds, const int K, const Sched& S, const Epi& E, const PG8_LAS unsigned char* gtab) {
    const int tid = threadIdx.x, wid = __builtin_amdgcn_readfirstlane(tid >> 6), lane = tid & 63, wr = wid >> 2, wc = wid & 3, fr = lane & 15, fq = lane >> 4;
    const int nt = K / BK;
    unsigned voffA[2], voffB[2]; int gRow[2]; unsigned gCol[2];
#pragma unroll
    for (int i = 0; i < 2; ++i) { int R, C; stage_rc(tid * 16 + i * 8192, R, C); const int Rb = (R & ~31) + perm32(R & 31);
        voffA[i] = (unsigned)(R * K + C) * 2u; voffB[i] = (unsigned)(Rb * K + C) * 2u; gRow[i] = R; gCol[i] = (unsigned)C * 2u; }
    const size_t kstep = (size_t)(BK * 2);
    const size_t hstep = (size_t)HALF * K * 2;
    const unsigned ldsw = (unsigned)wid * 1024u;
    const unsigned ldsb = (unsigned)(size_t)lds + ldsw;
    const int aoff = lds_byte(wr * 64 + fr, fq * 8), boff = lds_byte(wc * 32 + fr, fq * 8);
    unsigned gC[2][2], gN[2][2];
#define PG8_SA(b, h) (((b) * 2 + (h)) * HTB)
#define PG8_SB(b, h) ((4 + (b) * 2 + (h)) * HTB)
#define PG8_STAGE(bufoff, gbase, voff) do { glds16s<(bufoff)>((const char*)(gbase), (voff)[0], ldsb); glds16s<(bufoff) + 8192>((const char*)(gbase), (voff)[1], ldsb); } while (0)
#define PG8_STAGE_A(bufoff, kptr, h) PG8_STAGE(bufoff, kptr, gC[h])
#define PG8_GLOAD(dst, unit) do { _Pragma("unroll") for (int _h = 0; _h < 2; ++_h) _Pragma("unroll") for (int _i = 0; _i < 2; ++_i) \
        dst[_h][_i] = *(const PG8_LAS unsigned*)(gtab + (unit) * 1024 + (gRow[_i] + _h * HALF) * 4) + gCol[_i]; } while (0)
#define PG8_LDA(dst, b, h) do { _Pragma("unroll") for (int m = 0; m < 4; ++m) _Pragma("unroll") for (int k = 0; k < 2; ++k) dst[m][k] = *(const PG8_LAS bf16x8*)(lds + PG8_SA(b, h) + aoff + m * 2048 + k * 1024); } while (0)
#define PG8_LDB(dst, b, h) do { _Pragma("unroll") for (int n = 0; n < 2; ++n) _Pragma("unroll") for (int k = 0; k < 2; ++k) dst[n][k] = *(const PG8_LAS bf16x8*)(lds + PG8_SB(b, h) + boff + n * 2048 + k * 1024); } while (0)
#define PG8_CAT8(x0, x1) __builtin_shufflevector(__builtin_bit_cast(v4i, x0), __builtin_bit_cast(v4i, x1), 0, 1, 2, 3, 4, 5, 6, 7)
#define PG8_MMA(ai, bj, At, Bt) do { __builtin_amdgcn_s_setprio(1); _Pragma("unroll") for (int m = 0; m < 4; ++m) _Pragma("unroll") for (int n = 0; n < 2; ++n) { \
        if constexpr (SA8 != 0) { acc[ai][bj][m][n] = __builtin_amdgcn_mfma_scale_f32_16x16x128_f8f6f4(PG8_CAT8(Bt[n][0], Bt[n][1]), PG8_CAT8(At[m][0], At[m][1]), acc[ai][bj][m][n], 0, 0, 0, SA8 * 0x01010101, 0, SB8 * 0x01010101); } \
        else { _Pragma("unroll") for (int k = 0; k < 2; ++k) acc[ai][bj][m][n] = __builtin_amdgcn_mfma_f32_16x16x32_bf16(Bt[n][k], At[m][k], acc[ai][bj][m][n], 0, 0, 0); } } \
        __builtin_amdgcn_s_setprio(0); } while (0)
#define PG8_WAIT_V(n) asm volatile("s_waitcnt vmcnt(" #n ")" ::: "memory")
#define PG8_WAIT_L(n) asm volatile("s_waitcnt lgkmcnt(" #n ")" ::: "memory")
#define PG8_BAR __builtin_amdgcn_s_barrier()
#define PG8_SCHED __builtin_amdgcn_sched_barrier(0)
    Unit cur, nxt; int ui = 0;
    if (!S.next(0, cur)) return;
    f32x4 acc[2][2][4][2];
#pragma unroll
    for (int a = 0; a < 2; ++a)
#pragma unroll
        for (int b = 0; b < 2; ++b)
#pragma unroll
            for (int m = 0; m < 4; ++m)
#pragma unroll
                for (int n = 0; n < 2; ++n) acc[a][b][m][n] = (f32x4){0.f, 0.f, 0.f, 0.f};
    bf16x8 At[4][2], B0[2][2], B1[2][2];
    const char* cA = cur.a; const char* cB = cur.b;
    if constexpr (GATHER) { PG8_GLOAD(gC, cur.aux); PG8_WAIT_L(0); }
    else {
#pragma unroll
        for (int h = 0; h < 2; ++h)
#pragma unroll
            for (int i = 0; i < 2; ++i) gC[h][i] = voffA[i] + (unsigned)h * (unsigned)hstep; }
    PG8_STAGE(PG8_SB(0, 0), cB, voffB); PG8_STAGE(PG8_SB(0, 1), cB + hstep, voffB); PG8_STAGE_A(PG8_SA(0, 0), cA, 0); PG8_STAGE_A(PG8_SA(0, 1), cA, 1);
    if (wr == 1) PG8_BAR;
    PG8_WAIT_V(2); PG8_BAR;
    PG8_STAGE(PG8_SB(1, 0), cB + kstep, voffB); PG8_STAGE_A(PG8_SA(1, 0), cA + kstep, 0); PG8_STAGE(PG8_SB(1, 1), cB + hstep + kstep, voffB);
    PG8_WAIT_V(6); PG8_BAR;
    for (;;) {
        const bool has_next = S.next(ui + 1, nxt);
        const char* nA = has_next ? nxt.a : cA; const char* nB = has_next ? nxt.b : cB;
        if constexpr (GATHER) { if (has_next) { PG8_GLOAD(gN, nxt.aux); } else {
#pragma unroll
            for (int h = 0; h < 2; ++h)
#pragma unroll
                for (int i = 0; i < 2; ++i) gN[h][i] = gC[h][i]; } }
#pragma unroll 1
        for (int t = 0; t < nt; t += 2) {
            const bool last = (t == nt - 2);
            const char* a1 = cA + (size_t)(t + 1) * kstep;
            const char* a2 = last ? nA : cA + (size_t)(t + 2) * kstep; const char* b2 = last ? nB : cB + (size_t)(t + 2) * kstep;
            const char* a3 = a2 + kstep; const char* b3 = b2 + kstep;
            PG8_LDB(B0, 0, 0); PG8_LDB(B1, 0, 1); PG8_SCHED; PG8_LDA(At, 0, 0); PG8_STAGE_A(PG8_SA(1, 1), a1, 1);
            if constexpr (GATHER) { if (last) {
#pragma unroll
                for (int h = 0; h < 2; ++h)
#pragma unroll
                    for (int i = 0; i < 2; ++i) gC[h][i] = gN[h][i]; } }
            PG8_WAIT_V(8); PG8_WAIT_L(0); PG8_BAR; PG8_MMA(0, 0, At, B0); PG8_MMA(0, 1, At, B1); PG8_BAR; PG8_SCHED;
            PG8_LDA(At, 0, 1); PG8_STAGE(PG8_SB(0, 0), b2, voffB); PG8_STAGE(PG8_SB(0, 1), b2 + hstep, voffB); PG8_STAGE_A(PG8_SA(0, 0), a2, 0);
            PG8_WAIT_V(8); PG8_WAIT_L(0); PG8_BAR; PG8_MMA(1, 0, At, B0); PG8_MMA(1, 1, At, B1); PG8_BAR; PG8_SCHED;
            PG8_LDB(B0, 1, 0); PG8_LDB(B1, 1, 1); PG8_SCHED; PG8_LDA(At, 1, 0); PG8_STAGE_A(PG8_SA(0, 1), a2, 1);
            PG8_WAIT_V(8); PG8_WAIT_L(0); PG8_BAR; PG8_MMA(0, 0, At, B0); PG8_MMA(0, 1, At, B1); PG8_BAR; PG8_SCHED;
            PG8_LDA(At, 1, 1); PG8_STAGE(PG8_SB(1, 0), b3, voffB); PG8_STAGE(PG8_SB(1, 1), b3 + hstep, voffB); PG8_STAGE_A(PG8_SA(1, 0), a3, 0);
            PG8_WAIT_V(8); PG8_WAIT_L(0); PG8_BAR; PG8_MMA(1, 0, At, B0); PG8_MMA(1, 1, At, B1); PG8_BAR; PG8_SCHED;
        }
        if constexpr (ALIGN_EPI) { if (wr == 0) PG8_BAR; }
        E(acc, cur, wr, wc, fr, fq);
        if (!has_next) break;
        if (!(Epi::SEG && cur.aux == 0))
#pragma unroll
        for (int a = 0; a < 2; ++a)
#pragma unroll
            for (int b = 0; b < 2; ++b)
#pragma unroll
                for (int m = 0; m < 4; ++m)
#pragma unroll
                    for (int n = 0; n < 2; ++n) acc[a][b][m][n] = (f32x4){0.f, 0.f, 0.f, 0.f};
        cur = nxt; cA = nA; cB = nB; ++ui;
        if constexpr (ALIGN_EPI) { if (wr == 1) PG8_BAR; }
    }
    PG8_WAIT_V(0);
    if constexpr (!ALIGN_EPI) { if (wr == 0) PG8_BAR; }
    PG8_BAR;
#undef PG8_SA
#undef PG8_SB
#undef PG8_STAGE
#undef PG8_STAGE_A
#undef PG8_GLOAD
#undef PG8_LDA
#undef PG8_LDB
#undef PG8_MMA
#undef PG8_CAT8
#undef PG8_WAIT_V
#undef PG8_WAIT_L
#undef PG8_BAR
#undef PG8_SCHED
}

__device__ __forceinline__ u32x4 pack8(const f32x4 v0, const f32x4 v1) { u32x4 w; w.x = cvt_pk_bf16(v0[0], v0[1]); w.y = cvt_pk_bf16(v0[2], v0[3]); w.z = cvt_pk_bf16(v1[0], v1[1]); w.w = cvt_pk_bf16(v1[2], v1[3]); return w; }
__device__ __forceinline__ void unpack8(const u32x4 w, f32x4& v0, f32x4& v1) { v0 = (f32x4){bf_lo(w.x), bf_hi(w.x), bf_lo(w.y), bf_hi(w.y)}; v1 = (f32x4){bf_lo(w.z), bf_hi(w.z), bf_lo(w.w), bf_hi(w.w)}; }

struct EpiInProj {
    static constexpr bool SEG = false;
    bf16_t *Q, *Kb, *Vb, *Z; const float* rope; int pn0;
    __device__ __forceinline__ void operator()(const f32x4 (&acc)[2][2][4][2], const Unit& u, int wr, int wc, int fr, int fq) const {
        const int row0 = u.pm * BM + wr * 64 + fr, c8 = wc * 32 + 8 * fq, pn = u.pn + pn0;
        if (pn <= 2) {
            const bool rot_lane = ((wc & 1) == 0) && (fq < 2);
            const float sgn = (fq == 0) ? -1.f : 1.f;
#pragma unroll
            for (int ai = 0; ai < 2; ++ai)
#pragma unroll
                for (int m = 0; m < 4; ++m) {
                    const int row = row0 + ai * HALF + m * 16, pos = row & (SEQ_ - 1);
                    const f32x4 cs0 = *(const f32x4*)(rope + pos * 16), cs1 = *(const f32x4*)(rope + pos * 16 + 4), sn0 = *(const f32x4*)(rope + pos * 16 + 8), sn1 = *(const f32x4*)(rope + pos * 16 + 12);
#pragma unroll
                    for (int bj = 0; bj < 2; ++bj) {
                        f32x4 v0 = acc[ai][bj][m][0], v1 = acc[ai][bj][m][1];
                        const bool isv = (pn == 2) && (bj == 1);
                        if (!isv) {
                            f32x4 o0, o1;
#pragma unroll
                            for (int j = 0; j < 4; ++j) { o0[j] = __shfl_xor(v0[j], 16); o1[j] = __shfl_xor(v1[j], 16); }
                            if (rot_lane) { v0 = v0 * cs0 + sgn * (o0 * sn0); v1 = v1 * cs1 + sgn * (o1 * sn1); }
                        }
                        bf16_t* dst;
                        if (pn < 2) { v0 = v0 * QSCALE; v1 = v1 * QSCALE; dst = Q + (size_t)row * 512 + pn * 256 + bj * HALF + c8; }
                        else dst = (bj == 0 ? Kb : Vb) + (size_t)row * 128 + c8;
                        *(u32x4*)dst = pack8(v0, v1);
                    }
                }
        } else if (pn <= 6) {
#pragma unroll
            for (int ai = 0; ai < 2; ++ai)
#pragma unroll
                for (int m = 0; m < 4; ++m) {
                    bf16_t* rowp = Z + (size_t)(row0 + ai * HALF + m * 16) * 1024 + (pn - 3) * 256 + c8;
#pragma unroll
                    for (int bj = 0; bj < 2; ++bj) { f32x4 v0 = acc[ai][bj][m][0], v1 = acc[ai][bj][m][1];
#pragma unroll
                        for (int j = 0; j < 4; ++j) { v0[j] = gelu_tanh(v0[j]); v1[j] = gelu_tanh(v1[j]); }
                        *(u32x4*)(rowp + bj * HALF) = pack8(v0, v1); }
                }
        }
    }
};
struct EpiGates {
    static constexpr bool SEG = false;
    bf16_t *R, *S;
    __device__ __forceinline__ void operator()(const f32x4 (&acc)[2][2][4][2], const Unit& u, int wr, int wc, int fr, int fq) const {
        const int row0 = u.pm * BM + wr * 64 + fr, col0 = u.pn * HALF + wc * 32 + 8 * fq;
#pragma unroll
        for (int ai = 0; ai < 2; ++ai)
#pragma unroll
            for (int m = 0; m < 4; ++m) { f32x4 r0, r1, s0, s1;
#pragma unroll
                for (int j = 0; j < 4; ++j) { const float ea0 = fast_exp2(-LOG2E * acc[ai][0][m][0][j]), ea1 = fast_exp2(-LOG2E * acc[ai][0][m][1][j]), eg0 = fast_exp2(-LOG2E * acc[ai][1][m][0][j]), eg1 = fast_exp2(-LOG2E * acc[ai][1][m][1][j]);
                    r0[j] = (1.0f + eg0) * fast_rcp(1.0f + ea0); r1[j] = (1.0f + eg1) * fast_rcp(1.0f + ea1); s0[j] = fast_rcp(1.0f + eg0); s1[j] = fast_rcp(1.0f + eg1); }
                const size_t off = (size_t)(row0 + ai * HALF + m * 16) * 1024 + col0;
                *(u32x4*)(R + off) = pack8(r0, r1); *(u32x4*)(S + off) = pack8(s0, s1); }
    }
};
struct EpiInProj8 {
    static constexpr bool SEG = false;
    EpiInProj qkv; EpiGates gates;
    __device__ __forceinline__ void operator()(const f32x4 (&acc)[2][2][4][2], const Unit& u, int wr, int wc, int fr, int fq) const {
        if (u.pn < 3) qkv(acc, u, wr, wc, fr, fq); else { Unit v = u; v.pn = u.pn - 3; gates(acc, v, wr, wc, fr, fq); }
    }
};
struct EpiMixFused {
    static constexpr bool SEG = true;
    bf16_t* MIX; const bf16_t *SGA, *SGG;
    __device__ __forceinline__ void operator()(f32x4 (&acc)[2][2][4][2], const Unit& u, int wr, int wc, int fr, int fq) const {
        const int row0 = u.pm * BM + wr * 64 + fr, col0 = u.pn * BM + wc * 32 + 8 * fq;
        if (u.aux == 0) {
#pragma unroll
            for (int ai = 0; ai < 2; ++ai)
#pragma unroll
                for (int m = 0; m < 4; ++m) { const size_t off = (size_t)(row0 + ai * HALF + m * 16) * 1024 + col0;
#pragma unroll
                    for (int bj = 0; bj < 2; ++bj) { f32x4 a0, a1; unpack8(*(const u32x4*)(SGA + off + bj * HALF), a0, a1);
                        acc[ai][bj][m][0] = acc[ai][bj][m][0] * a0; acc[ai][bj][m][1] = acc[ai][bj][m][1] * a1; } }
        } else {
#pragma unroll
            for (int ai = 0; ai < 2; ++ai)
#pragma unroll
                for (int m = 0; m < 4; ++m) { const size_t off = (size_t)(row0 + ai * HALF + m * 16) * 1024 + col0;
#pragma unroll
                    for (int bj = 0; bj < 2; ++bj) { f32x4 g0, g1; unpack8(*(const u32x4*)(SGG + off + bj * HALF), g0, g1);
                        *(u32x4*)(MIX + off + bj * HALF) = pack8(acc[ai][bj][m][0] * g0, acc[ai][bj][m][1] * g1); } }
        }
    }
};
struct EpiResid {
    static constexpr bool SEG = false;
    const float* X; bf16_t* X1;
    __device__ __forceinline__ void operator()(const f32x4 (&acc)[2][2][4][2], const Unit& u, int wr, int wc, int fr, int fq) const {
        const int row0 = u.pm * BM + wr * 64 + fr, col0 = u.pn * BM + wc * 32 + 8 * fq;
#pragma unroll
        for (int ai = 0; ai < 2; ++ai)
#pragma unroll
            for (int m = 0; m < 4; ++m) { const size_t off = (size_t)(row0 + ai * HALF + m * 16) * 1024 + col0;
#pragma unroll
                for (int bj = 0; bj < 2; ++bj) { const f32x4 x0 = *(const f32x4*)(X + off + bj * HALF), x1 = *(const f32x4*)(X + off + bj * HALF + 4);
                    *(u32x4*)(X1 + off + bj * HALF) = pack8(acc[ai][bj][m][0] + x0, acc[ai][bj][m][1] + x1); } }
    }
};
struct EpiGateUp {
    static constexpr bool SEG = false;
    unsigned char* HID;
    __device__ __forceinline__ void operator()(const f32x4 (&acc)[2][2][4][2], const Unit& u, int wr, int wc, int fr, int fq) const {
        const int row0 = u.pm * BM + wr * 64 + fr, col0 = u.pn * HALF + wc * 32 + 8 * fq;
#pragma unroll
        for (int ai = 0; ai < 2; ++ai)
#pragma unroll
            for (int m = 0; m < 4; ++m) { f32x4 v0, v1;
#pragma unroll
                for (int j = 0; j < 4; ++j) { const float g0 = acc[ai][0][m][0][j], g1 = acc[ai][0][m][1][j];
                    v0[j] = 8.0f * g0 * sigmoidf_(g0) * acc[ai][1][m][0][j]; v1[j] = 8.0f * g1 * sigmoidf_(g1) * acc[ai][1][m][1][j]; }
                v2u o; o.x = pk4_fp8(sat448(v0[0]), sat448(v0[1]), sat448(v0[2]), sat448(v0[3])); o.y = pk4_fp8(sat448(v1[0]), sat448(v1[1]), sat448(v1[2]), sat448(v1[3]));
                *(v2u*)(HID + (size_t)(row0 + ai * HALF + m * 16) * DEXP + col0) = o; }
    }
};
struct EpiDown {
    static constexpr bool SEG = false;
    unsigned char* Y;
    __device__ __forceinline__ void operator()(const f32x4 (&acc)[2][2][4][2], const Unit& u, int wr, int wc, int fr, int fq) const {
        const int row0 = u.pm * BM + wr * 64 + fr, col0 = u.pn * BM + wc * 32 + 8 * fq;
#pragma unroll
        for (int ai = 0; ai < 2; ++ai)
#pragma unroll
            for (int m = 0; m < 4; ++m) { unsigned char* rowp = Y + (size_t)(row0 + ai * HALF + m * 16) * 1024 + col0;
#pragma unroll
                for (int bj = 0; bj < 2; ++bj) { const f32x4 v0 = acc[ai][bj][m][0] * 16.0f, v1 = acc[ai][bj][m][1] * 16.0f;
                    v2u o; o.x = pk4_fp8(sat448(v0[0]), sat448(v0[1]), sat448(v0[2]), sat448(v0[3])); o.y = pk4_fp8(sat448(v1[0]), sat448(v1[1]), sat448(v1[2]), sat448(v1[3])); *(v2u*)(rowp + bj * HALF) = o; } }
    }
};
}

#define XB_TMO      128
#define XB_XCNT(j)  (256  + 64 * (j))
#define XB_XSUB(j)  (1280 + 64 * (j))
#define XB_XGEN(j)  (2304 + 64 * (j))
#define XB_TOP      3328
#define XB_TOPGEN   3392
#define XCD_BAR_WORDS 3456
#define XB_SPIN_CAP (1u << 18)
__device__ __forceinline__ unsigned xb_ld(unsigned* p)              { return __hip_atomic_load(p, __ATOMIC_RELAXED, __HIP_MEMORY_SCOPE_AGENT); }
__device__ __forceinline__ unsigned xb_add(unsigned* p, unsigned v) { return __hip_atomic_fetch_add(p, v, __ATOMIC_RELAXED, __HIP_MEMORY_SCOPE_AGENT); }
__device__ __forceinline__ unsigned xb_xcc_id() { return (unsigned)__builtin_amdgcn_s_getreg((3 << 11) | 20) & 0xFu; }
#define XB_SPIN(cond, bar) do { unsigned _sp = 0; while (cond) { __builtin_amdgcn_s_sleep(1); \
    if ((++_sp & 255u) == 0u) { if (xb_ld(&(bar)[XB_TMO])) break; if (_sp > XB_SPIN_CAP) { atomicAdd(&(bar)[XB_TMO], 1u); break; } } } } while (0)
struct XcdBarrier { unsigned* bar; unsigned x; volatile LAS unsigned* st; };
__device__ __forceinline__ XcdBarrier xcd_barrier_post(unsigned* bar, volatile LAS unsigned* st) {
    XcdBarrier b; b.bar = bar; b.x = xb_xcc_id(); b.st = st;
    if (threadIdx.x == 0) (void)xb_add(&bar[XB_XCNT(b.x)], 1u);
    return b;
}
__device__ __forceinline__ void xcd_barrier_complete(unsigned* bar, unsigned x, unsigned& nloc, unsigned& nx) {
    const unsigned G = gridDim.x * gridDim.y * gridDim.z;
    unsigned sum, cnt, mine, sp = 0u;
    for (;;) {
        sum = 0u; cnt = 0u; mine = 0u;
#pragma unroll
        for (unsigned j = 0; j < 16; ++j) { const unsigned c = xb_ld(&bar[XB_XCNT(j)]); sum += c; cnt += (c > 0u) ? 1u : 0u; mine = (j == x) ? c : mine; }
        if (sum == G) break;
        __builtin_amdgcn_s_sleep(1);
        if ((++sp & 255u) == 0u) { if (xb_ld(&bar[XB_TMO])) break; if (sp > XB_SPIN_CAP) { atomicAdd(&bar[XB_TMO], 1u); break; } }
    }
    nloc = mine > 0u ? mine : 1u; nx = cnt > 0u ? cnt : 1u;
}
__device__ __forceinline__ void xcd_barrier(const XcdBarrier& b) {
    asm volatile("s_waitcnt vmcnt(0)" ::: "memory");
    __syncthreads();
    if (threadIdx.x == 0) {
        unsigned* bar = b.bar;
        __builtin_amdgcn_s_waitcnt(0);
        unsigned nloc = b.st[0], nx = b.st[1];
        if (nloc == 0u) { xcd_barrier_complete(bar, b.x, nloc, nx); b.st[0] = nloc; b.st[1] = nx; }
        const unsigned old = xb_add(&bar[XB_XSUB(b.x)], 1u);
        const unsigned gen = old / nloc;
        if (old + 1u == (gen + 1u) * nloc) {
            __builtin_amdgcn_fence(__ATOMIC_RELEASE, "agent");
            asm volatile("s_waitcnt vmcnt(0)" ::: "memory");
            const unsigned og = xb_add(&bar[XB_TOP], 1u);
            const unsigned tg = og / nx;
            if (og + 1u == (tg + 1u) * nx) xb_add(&bar[XB_TOPGEN], 1u);
            else XB_SPIN(xb_ld(&bar[XB_TOPGEN]) == tg, bar);
            __builtin_amdgcn_fence(__ATOMIC_ACQUIRE, "agent");
            xb_add(&bar[XB_XGEN(b.x)], 1u);
            asm volatile("s_waitcnt vmcnt(0)" ::: "memory");
        } else {
            XB_SPIN(xb_ld(&bar[XB_XGEN(b.x)]) == gen, bar);
            __builtin_amdgcn_fence(__ATOMIC_ACQUIRE, "agent");
            asm volatile("s_waitcnt vmcnt(0)" ::: "memory");
        }
    }
    __syncthreads();
}

__device__ __forceinline__ void quad_barrier(unsigned* cnt, unsigned target, bool same_xcd, unsigned* bar) {
    asm volatile("s_waitcnt vmcnt(0)" ::: "memory");
    __syncthreads();
    if (threadIdx.x == 0) {
        if (!same_xcd) { __builtin_amdgcn_fence(__ATOMIC_RELEASE, "agent"); asm volatile("s_waitcnt vmcnt(0)" ::: "memory"); }
        (void)xb_add(cnt, 1u);
        XB_SPIN(xb_ld(cnt) < target, bar);
        __builtin_amdgcn_fence(__ATOMIC_ACQUIRE, "agent");
        asm volatile("s_waitcnt vmcnt(0)" ::: "memory");
    }
    __syncthreads();
}

struct Frame {
    LAS unsigned char* lds;
    unsigned* ctl;
    int tid, lane, wave, vcu, G;
    unsigned char* wsp; const float* const* in; float* out;
};
#define FIN(k) (F.in[k])
#define FWS(T, off) ((T*)(F.wsp + (off)))

__device__ __forceinline__ void p0_transpose_item(const float* W, int K, int N, int ldw, bf16* WT, int mode, LAS float* scr, int item, int lane) {
    const int nblk = N / 32, kb = item / nblk, nb = item % nblk, k0 = 64 * kb, n0 = 32 * nb;
    float tv[32];
#pragma unroll
    for (int i = 0; i < 32; ++i) { const int kk = 2 * i + (lane >> 5); tv[i] = __builtin_nontemporal_load(W + (size_t)(k0 + kk) * ldw + n0 + (lane & 31)); }
#pragma unroll
    for (int i = 0; i < 32; ++i) { const int kk = 2 * i + (lane >> 5); scr[kk * 33 + (lane & 31)] = tv[i]; }
    LDS_WAIT(); asm volatile("" ::: "memory");
    const int c = lane & 7;
    const int rowbase = (mode == 0) ? n0 : ((n0 >> 7) * 256 + (n0 & 127) + (mode == 2 ? 128 : 0));
#pragma unroll
    for (int j = 0; j < 4; ++j) { const int n = (lane >> 3) + 8 * j; const LAS float* s = scr + (8 * c) * 33 + n;
        v4u o; o.x = cvt_pk_bf16(s[0 * 33], s[1 * 33]); o.y = cvt_pk_bf16(s[2 * 33], s[3 * 33]); o.z = cvt_pk_bf16(s[4 * 33], s[5 * 33]); o.w = cvt_pk_bf16(s[6 * 33], s[7 * 33]);
        *(GAS v4u*)(WT + (size_t)(rowbase + n) * K + k0 + 8 * c) = o; }
    LDS_WAIT(); asm volatile("" ::: "memory");
}
__device__ __forceinline__ void p0_transpose_item8(const float* W, int K, int N, int ldw, unsigned char* WT, int mode, float scale, LAS float* scr, int item, int lane) {
    const int nblk = N / 32, kb = item / nblk, nb = item % nblk, k0 = 64 * kb, n0 = 32 * nb;
    float tv[32];
#pragma unroll
    for (int i = 0; i < 32; ++i) { const int kk = 2 * i + (lane >> 5); tv[i] = __builtin_nontemporal_load(W + (size_t)(k0 + kk) * ldw + n0 + (lane & 31)); }
#pragma unroll
    for (int i = 0; i < 32; ++i) { const int kk = 2 * i + (lane >> 5); scr[kk * 33 + (lane & 31)] = tv[i] * scale; }
    LDS_WAIT(); asm volatile("" ::: "memory");
    const int c = lane & 3;
    const int rowbase = (mode == 0) ? n0 : ((n0 >> 7) * 256 + (n0 & 127) + (mode == 2 ? 128 : 0));
#pragma unroll
    for (int j = 0; j < 2; ++j) { const int n = (lane >> 2) + 16 * j; const LAS float* sp = scr + (16 * c) * 33 + n;
        v4u o; o.x = pk4_fp8(sp[0 * 33], sp[1 * 33], sp[2 * 33], sp[3 * 33]); o.y = pk4_fp8(sp[4 * 33], sp[5 * 33], sp[6 * 33], sp[7 * 33]);
        o.z = pk4_fp8(sp[8 * 33], sp[9 * 33], sp[10 * 33], sp[11 * 33]); o.w = pk4_fp8(sp[12 * 33], sp[13 * 33], sp[14 * 33], sp[15 * 33]);
        *(GAS v4u*)(WT + (size_t)(rowbase + n) * K + k0 + 16 * c) = o; }
    LDS_WAIT(); asm volatile("" ::: "memory");
}
template <int NR> __device__ __forceinline__ void rms_rows_to_bf16(int lane, const float* xrow0, size_t rstride, const float* gain, bf16* orow0, unsigned char* o8row0) {
    f32x4 v[NR][4]; float rstd[NR];
#pragma unroll
    for (int r = 0; r < NR; ++r) { const GAS f32x4* xr = (const GAS f32x4*)(xrow0 + r * rstride) + lane;
#pragma unroll
        for (int j = 0; j < 4; ++j) v[r][j] = __builtin_nontemporal_load(xr + 64 * j); }
    const GAS f32x4* gr = (const GAS f32x4*)gain + lane; f32x4 g[4];
#pragma unroll
    for (int j = 0; j < 4; ++j) g[j] = gr[64 * j];
#pragma unroll
    for (int r = 0; r < NR; ++r) { float s = 0.f;
#pragma unroll
        for (int j = 0; j < 4; ++j) s += (v[r][j].x * v[r][j].x + v[r][j].y * v[r][j].y) + (v[r][j].z * v[r][j].z + v[r][j].w * v[r][j].w);
        rstd[r] = rsqrtf(wave_sum(s) * (1.f / D_) + EPS_); }
#pragma unroll
    for (int r = 0; r < NR; ++r) { GAS v2u* o8 = (GAS v2u*)(orow0 + r * rstride) + lane;
#pragma unroll
        for (int j = 0; j < 4; ++j) { const f32x4 h = v[r][j] * rstd[r] * g[j]; v2u o; o.x = cvt_pk_bf16(h.x, h.y); o.y = cvt_pk_bf16(h.z, h.w); o8[64 * j] = o;
            ((GAS unsigned*)(o8row0 + r * rstride))[lane + 64 * j] = pk4_fp8(h.x, h.y, h.z, h.w); } }
}
__device__ __forceinline__ void p0_prologue(Frame& F) {
    LAS float* scr = (LAS float*)(F.lds + RING_OFF + F.wave * 16384);
    const int gw = F.vcu * 8 + F.wave, NGW = F.G * 8;
    constexpr int I_IN = 16 * 32, I_QKV = 16 * 24, I_GA = 16 * 32, I_A = 8 * 32, I_O = 16 * 32, I_DENSE = I_IN + I_QKV + 2 * I_GA + 2 * I_A + I_O;
    for (int it = gw; it < I_DENSE; it += NGW) {
        int r = it;
        if (r < I_IN) { p0_transpose_item(FIN(2) + 768, D_, 1024, INC_, FWS(bf16, WS_WIN), 0, scr, r, F.lane); continue; } r -= I_IN;
        if (r < I_QKV) { p0_transpose_item8(FIN(2), D_, 768, INC_, FWS(unsigned char, WS_WIN8Q), 0, 32.0f, scr, r, F.lane); continue; } r -= I_QKV;
        if (r < I_GA) { p0_transpose_item8(FIN(2) + 1792, D_, 1024, INC_, FWS(unsigned char, WS_WIN8), 1, 32.0f, scr, r, F.lane); continue; } r -= I_GA;
        if (r < I_GA) { p0_transpose_item8(FIN(2) + 2816, D_, 1024, INC_, FWS(unsigned char, WS_WIN8), 2, 32.0f, scr, r, F.lane); continue; } r -= I_GA;
        if (r < I_A) { p0_transpose_item(FIN(8), 512, D_, D_, FWS(bf16, WS_WA), 0, scr, r, F.lane); continue; } r -= I_A;
        if (r < I_A) { p0_transpose_item(FIN(9), 512, D_, D_, FWS(bf16, WS_WG), 0, scr, r, F.lane); continue; } r -= I_A;
        p0_transpose_item(FIN(10), D_, D_, D_, FWS(bf16, WS_WOUT), 0, scr, r, F.lane);
    }
    const int gt = F.vcu * 512 + F.tid, NGT = F.G * 512;
    for (int i = gt; i < 48 * 1024; i += NGT) { const int o = i >> 10, k = i & 1023; float v = 0.f; if (o < 4) v = FIN(12)[k * 4 + o]; else if (o < 36) v = FIN(14)[k * 32 + (o - 4)];
        FWS(bf16, WS_WR)[i] = (bf16)(cvt_pk_bf16(v, 0.f) & 0xffffu); }
    for (int i = gt; i < 8 * 128 * 128; i += NGT) { const int p = i & 127, q = (i >> 7) & 127; const float v = (p <= q) ? FIN(6)[i] : 0.f; FWS(bf16, WS_WM)[i] = (bf16)(cvt_pk_bf16(v, 0.f) & 0xffffu); }
    for (int i = gt; i < SEQ_ * 8; i += NGT) { const int pos = i >> 3, j = i & 7; const float inv = powf(500000.0f, -(float)(2 * j) / 16.0f); const float ang = (float)pos * inv;
        FWS(float, WS_ROPE)[pos * 16 + j] = cosf(ang); FWS(float, WS_ROPE)[pos * 16 + 8 + j] = sinf(ang); }
    for (int m = 4 * gw; m < T_; m += 4 * NGW) rms_rows_to_bf16<4>(F.lane, FIN(0) + (size_t)m * D_, (size_t)D_, FIN(1), FWS(bf16, WS_XN) + (size_t)m * D_, FWS(unsigned char, WS_XN8) + (size_t)m * D_);
}

__device__ __forceinline__ void attn_load(Frame& F, int au, v4u (&kv)[4], v4u (&vv)[4], bf16x8 (&qf)[2][2][2]) {
    const int tid = F.tid, lane = F.lane, w = F.wave;
    const int hk = au & 1, n = (au >> 1) & 15, b = au >> 5;
#pragma unroll
    for (int it = 0; it < 4; ++it) { const int q = it * 512 + tid, kr = q >> 3, c16 = q & 7;
        int rel = 128 * (n - 1) + kr; if (rel < 0) rel = 0;
        const size_t trow = (size_t)(b * SEQ_ + rel);
        kv[it] = *(const GAS v4u*)(FWS(bf16, WS_K) + trow * 128 + hk * 64 + c16 * 8);
        vv[it] = *(const GAS v4u*)(FWS(bf16, WS_V) + trow * 128 + hk * 64 + c16 * 8); }
    const int hq = 4 * hk + (w >> 1), qh = w & 1, c = lane & 15, g = lane >> 4, tok0 = b * SEQ_ + 128 * n;
#pragma unroll
    for (int gi = 0; gi < 2; ++gi)
#pragma unroll
        for (int qt = 0; qt < 2; ++qt)
#pragma unroll
            for (int sx = 0; sx < 2; ++sx) qf[gi][qt][sx] = *(const GAS bf16x8*)(FWS(bf16, WS_Q) + (size_t)(tok0 + 64 * qh + 32 * gi + 16 * qt + c) * 512 + hq * 64 + 32 * sx + 8 * g);
}
template <bool FIRST>
__device__ __forceinline__ void attn_unit(Frame& F, int au, const bf16x8 (&qc)[2][2][2]) {
    const int lane = F.lane, w = F.wave;
    const int hk = au & 1, n = (au >> 1) & 15, b = au >> 5;
    const int tok0 = b * SEQ_ + 128 * n;
    LAS unsigned char* Kl = F.lds;
    LAS unsigned char* Vl = F.lds + 36864;
    const int hq = 4 * hk + (w >> 1), qh = w & 1, c = lane & 15, g = lane >> 4, qq = c >> 2, pp = c & 3;
    const float sink2 = FIN(3)[hq] * LOG2E;
#pragma unroll 1
    for (int gi = 0; gi < 2; ++gi) {
        const int q0 = 64 * qh + 32 * gi;
        bf16x8 qf[2][2];
#pragma unroll
        for (int qt = 0; qt < 2; ++qt)
#pragma unroll
            for (int s = 0; s < 2; ++s) qf[qt][s] = gi ? qc[1][qt][s] : qc[0][qt][s];
        f32x4 S[10][2];
#pragma unroll
        for (int kt = 0; kt < 10; ++kt) { S[kt][0] = (f32x4){0.f, 0.f, 0.f, 0.f}; S[kt][1] = (f32x4){0.f, 0.f, 0.f, 0.f}; }
#pragma unroll
        for (int kt = 0; kt < 10; ++kt)
#pragma unroll
            for (int s = 0; s < 2; ++s) { const bf16x8 kf = *(const LAS bf16x8*)(Kl + (q0 + 16 * kt + c) * 144 + 64 * s + 16 * g);
                S[kt][0] = mfma16(kf, qf[0][s], S[kt][0]); S[kt][1] = mfma16(kf, qf[1][s], S[kt][1]); }
        float inv[2];
#pragma unroll
        for (int qt = 0; qt < 2; ++qt) {
            float m = sink2;
#pragma unroll
            for (int kt = 0; kt < 10; ++kt) {
                const int d = kt - qt;
                if (d < 0 || d > 8) continue;
#pragma unroll
                for (int i = 0; i < 4; ++i) { bool valid = true;
                    if (d == 0 || d == 8) { const int relp = 16 * d + 4 * g + i - c; valid = (relp >= 1) && (relp <= 128); }
                    if (FIRST) valid = valid && (q0 + 16 * kt + 4 * g + i >= 128);
                    const float s = valid ? S[kt][qt][i] : -1e30f; S[kt][qt][i] = s; m = fmaxf(m, s); } }
            m = fmaxf(m, __shfl_xor(m, 16)); m = fmaxf(m, __shfl_xor(m, 32));
            float sum = 0.f;
#pragma unroll
            for (int kt = 0; kt < 10; ++kt) { const int d = kt - qt;
#pragma unroll
                for (int i = 0; i < 4; ++i) { const float p = (d < 0 || d > 8) ? 0.f : fast_exp2(S[kt][qt][i] - m); S[kt][qt][i] = p; sum += p; } }
            sum += __shfl_xor(sum, 16); sum += __shfl_xor(sum, 32);
            inv[qt] = 1.0f / (sum + fast_exp2(sink2 - m));
        }
        f32x4 O[4][2];
#pragma unroll
        for (int dt = 0; dt < 4; ++dt) { O[dt][0] = (f32x4){0.f, 0.f, 0.f, 0.f}; O[dt][1] = (f32x4){0.f, 0.f, 0.f, 0.f}; }
#pragma unroll
        for (int ks = 0; ks < 5; ++ks) {
            bf16x8 pf[2];
#pragma unroll
            for (int qt = 0; qt < 2; ++qt) { const v4u pw = {cvt_pk_bf16(S[2 * ks][qt][0], S[2 * ks][qt][1]), cvt_pk_bf16(S[2 * ks][qt][2], S[2 * ks][qt][3]),
                                                              cvt_pk_bf16(S[2 * ks + 1][qt][0], S[2 * ks + 1][qt][1]), cvt_pk_bf16(S[2 * ks + 1][qt][2], S[2 * ks + 1][qt][3])};
                pf[qt] = __builtin_bit_cast(bf16x8, pw); }
            const int r1 = q0 + 32 * ks + 4 * g + qq, r2 = r1 + 16;
#pragma unroll
            for (int dt = 0; dt < 4; ++dt) {
                const s16x4 lo = vtr(Vl + r1 * 128 + ((dt ^ ((r1 >> 1) & 3)) * 32) + pp * 8);
                const s16x4 hi = vtr(Vl + r2 * 128 + ((dt ^ ((r2 >> 1) & 3)) * 32) + pp * 8);
                const bf16x8 af = (bf16x8){lo[0], lo[1], lo[2], lo[3], hi[0], hi[1], hi[2], hi[3]};
                O[dt][0] = mfma16(af, pf[0], O[dt][0]); O[dt][1] = mfma16(af, pf[1], O[dt][1]); }
        }
#pragma unroll
        for (int qt = 0; qt < 2; ++qt) { bf16* orow = FWS(bf16, WS_AO) + (size_t)(tok0 + q0 + 16 * qt + c) * 512 + hq * 64 + 4 * g;
#pragma unroll
            for (int dt = 0; dt < 4; ++dt) { const f32x4 o = O[dt][qt] * inv[qt]; v2u wv; wv.x = cvt_pk_bf16(o[0], o[1]); wv.y = cvt_pk_bf16(o[2], o[3]); *(GAS v2u*)(orow + 16 * dt) = wv; } }
    }
}
__device__ __forceinline__ int attn_unit_id(const Frame& F, int q) {
    const int pm = F.vcu + (q >> 2) * F.G, j = q & 3; if (pm >= T_ / 256) return -1;
    return ((pm >> 3) << 5) | ((2 * (pm & 7) + (j >> 1)) << 1) | (j & 1);
}
__device__ __forceinline__ void attn_phase(Frame& F) {
    int q = 0, a = attn_unit_id(F, 0); if (a < 0) return;
    LAS unsigned char* Kl = F.lds; LAS unsigned char* Vl = F.lds + 36864;
    v4u kv[4], vv[4]; bf16x8 qf[2][2][2];
    attn_load(F, a, kv, vv, qf);
    for (;;) {
#pragma unroll
        for (int it = 0; it < 4; ++it) { const int qi = it * 512 + F.tid, kr = qi >> 3, c16 = qi & 7;
            *(LAS v4u*)(Kl + kr * 144 + c16 * 16) = kv[it];
            *(LAS v4u*)(Vl + kr * 128 + (((c16 >> 1) ^ ((kr >> 1) & 3)) * 32) + (c16 & 1) * 16) = vv[it]; }
        bf16x8 qc[2][2][2];
#pragma unroll
        for (int gi = 0; gi < 2; ++gi)
#pragma unroll
            for (int qt = 0; qt < 2; ++qt)
#pragma unroll
                for (int sx = 0; sx < 2; ++sx) qc[gi][qt][sx] = qf[gi][qt][sx];
        __syncthreads();
        const int an = attn_unit_id(F, q + 1); const bool has_next = an >= 0;
        if (has_next) attn_load(F, an, kv, vv, qf);
        if (((a >> 1) & 15) == 0) attn_unit<true>(F, a, qc); else attn_unit<false>(F, a, qc);
        __syncthreads();
        if (!has_next) break;
        a = an; ++q;
    }
}
template <int H> __device__ __forceinline__ void gmlp_half(Frame& F, LAS unsigned char* tile, int tb, int w, int lane) {
    const int c = lane & 15, g = lane >> 4, qq = c >> 2, pp = c & 3;
    f32x4 acc[4][4];
#pragma unroll
    for (int dt = 0; dt < 4; ++dt)
#pragma unroll
        for (int q4 = 0; q4 < 4; ++q4) acc[dt][q4] = (f32x4){0.f, 0.f, 0.f, 0.f};
    const bf16* Wg = FWS(bf16, WS_WM) + (size_t)w * 128 * 128;
    v2u uw[4][4];
#pragma unroll
    for (int q4 = 0; q4 < 4; ++q4)
#pragma unroll
        for (int dt = 0; dt < 4; ++dt) uw[q4][dt] = *(const GAS v2u*)(FWS(bf16, WS_Z) + (size_t)(tb + 16 * (4 * H + q4) + c) * 1024 + 64 * w + 4 * g + 16 * dt);
#pragma unroll
    for (int ks = 0; ks < 2 + 2 * H; ++ks) {
        bf16x8 af[4];
        const int r1 = 32 * ks + 4 * g + qq, r2 = r1 + 16;
#pragma unroll
        for (int dt = 0; dt < 4; ++dt) { const s16x4 lo = vtr(tile + r1 * 128 + ((dt ^ ((r1 >> 1) & 3)) * 32) + pp * 8), hi = vtr(tile + r2 * 128 + ((dt ^ ((r2 >> 1) & 3)) * 32) + pp * 8);
            af[dt] = (bf16x8){lo[0], lo[1], lo[2], lo[3], hi[0], hi[1], hi[2], hi[3]}; }
#pragma unroll
        for (int q4 = 0; q4 < 4; ++q4) { const int qt = 4 * H + q4;
            if (2 * ks <= qt) {
                const v2u b0 = *(const GAS v2u*)(Wg + (size_t)(16 * qt + c) * 128 + 32 * ks + 4 * g), b1 = *(const GAS v2u*)(Wg + (size_t)(16 * qt + c) * 128 + 32 * ks + 16 + 4 * g);
                const v4u bw = {b0.x, b0.y, b1.x, b1.y}; const bf16x8 bf = __builtin_bit_cast(bf16x8, bw);
#pragma unroll
                for (int dt = 0; dt < 4; ++dt) acc[dt][q4] = mfma16(af[dt], bf, acc[dt][q4]);
            } }
    }
#pragma unroll
    for (int q4 = 0; q4 < 4; ++q4) { const int q = 16 * (4 * H + q4) + c; const float bias = FIN(7)[w * 128 + q];
        const size_t off = (size_t)(tb + q) * 1024 + 64 * w + 4 * g; bf16* go = FWS(bf16, WS_GO) + (size_t)(tb + q) * 512 + 64 * w + 4 * g;
#pragma unroll
        for (int dt = 0; dt < 4; ++dt) { const v2u uq = uw[q4][dt];
            const f32x4 mx = acc[dt][q4] + bias; v2u o; o.x = cvt_pk_bf16(bf_lo(uq.x) * mx[0], bf_hi(uq.x) * mx[1]); o.y = cvt_pk_bf16(bf_lo(uq.y) * mx[2], bf_hi(uq.y) * mx[3]);
            *(GAS v2u*)(go + 16 * dt) = o; } }
}
__device__ __forceinline__ void gmlp_load(Frame& F, int cu, v4u (&sl)[16]) {
    const int lane = F.lane, w = F.wave, c16 = lane & 7, ch0 = 64 * w + 8 * c16, p0 = lane >> 3;
    const GAS char* zb = (const GAS char*)(FWS(bf16, WS_Z) + (size_t)cu * 128 * 1024 + 512);
    const unsigned lo_s = (unsigned)(p0 * 2048 + ch0 * 2);
#pragma unroll
    for (int it = 0; it < 16; ++it) sl[it] = *(const GAS v4u*)(zb + it * 16384 + (size_t)lo_s);
}
__device__ __forceinline__ void gmlp_front(Frame& F, v4u (&sl)[16]) {
    const int lane = F.lane, w = F.wave, c16 = lane & 7, ch0 = 64 * w + 8 * c16, p0 = lane >> 3;
    LAS f32x2* stats = (LAS f32x2*)(F.lds + TAB_GATHER);
    LAS f32x2* part = stats + 128;
    LAS unsigned char* tile = F.lds + w * 16384;
    LAS f32x2* pw = part + w * 128 + p0;
#pragma unroll
    for (int it = 0; it < 16; ++it) { f32x4 a, bq; pg8::unpack8(sl[it], a, bq);
        float sm = ((a[0] + a[1]) + (a[2] + a[3])) + ((bq[0] + bq[1]) + (bq[2] + bq[3]));
        float sq = ((a[0] * a[0] + a[1] * a[1]) + (a[2] * a[2] + a[3] * a[3])) + ((bq[0] * bq[0] + bq[1] * bq[1]) + (bq[2] * bq[2] + bq[3] * bq[3]));
        sm += dpp_f<0xB1>(sm); sq += dpp_f<0xB1>(sq); sm += dpp_f<0x4E>(sm); sq += dpp_f<0x4E>(sq); sm += dpp_f<0x141>(sm); sq += dpp_f<0x141>(sq);
        if (c16 == 0) pw[8 * it] = (f32x2){sm, sq}; }
#pragma unroll
    for (int it = 0; it < 16; ++it) asm volatile("" : "+v"(sl[it]));
    __syncthreads();
    {   const int r = 16 * w + (lane >> 2), j = lane & 3;
        const f32x2 pa = part[j * 128 + r], pb = part[(j + 4) * 128 + r];
        float sm = pa.x + pb.x, sq = pa.y + pb.y;
        sm += dpp_f<0xB1>(sm); sq += dpp_f<0xB1>(sq); sm += dpp_f<0x4E>(sm); sq += dpp_f<0x4E>(sq);
        const float mean = sm * (1.f / 512.f), var = fmaxf(sq * (1.f / 512.f) - mean * mean, 0.f);
        if (j == 0) stats[r] = (f32x2){mean, rsqrtf(var + EPS_)}; }
    __syncthreads();
    const f32x4 lg0 = *(const f32x4*)(FIN(4) + ch0), lg1 = *(const f32x4*)(FIN(4) + ch0 + 4), lb0 = *(const f32x4*)(FIN(5) + ch0), lb1 = *(const f32x4*)(FIN(5) + ch0 + 4);
    const LAS f32x2* sp = stats + p0;
    LAS unsigned char* tp = tile + p0 * 128 + (((c16 >> 1) ^ ((p0 >> 1) & 3)) * 32) + (c16 & 1) * 16;
#pragma unroll
    for (int it = 0; it < 16; ++it) {
        f32x4 a, bq; pg8::unpack8(sl[it], a, bq); const f32x2 st = sp[8 * it];
        a = (a - st.x) * st.y * lg0 + lb0; bq = (bq - st.x) * st.y * lg1 + lb1;
        *(LAS v4u*)(tp + 1024 * it) = pg8::pack8(a, bq); }
    LDS_WAIT(); asm volatile("" ::: "memory");
}
__device__ __forceinline__ void gmlp_back(Frame& F, int cu) {
    LAS unsigned char* tile = F.lds + F.wave * 16384;
    gmlp_half<0>(F, tile, cu * 128, F.wave, F.lane);
    gmlp_half<1>(F, tile, cu * 128, F.wave, F.lane);
}
__device__ __forceinline__ void gmlp_pair(Frame& F, int cu) {
    v4u sa[16], sb[16];
    gmlp_load(F, cu, sa);
    gmlp_front(F, sa);
    gmlp_back(F, cu);
    __syncthreads();
    gmlp_load(F, cu + 1, sb);
    gmlp_front(F, sb);
    gmlp_back(F, cu + 1);
    __syncthreads();
}

__device__ __forceinline__ void router_phase(Frame& F) {
    const int tid = F.tid, lane = F.lane, w = F.wave;
    LAS unsigned char* wrl = F.lds;
    LAS float* g2l = (LAS float*)(F.lds + 99328);
    LAS float* lgw = (LAS float*)(F.lds + 103424) + w * 800;
    LAS unsigned* lcnt = (LAS unsigned*)(F.lds + 129024);
    LAS unsigned* lbase = (LAS unsigned*)(F.lds + 129024 + 128);
    for (int i = tid; i < 48 * 128; i += 512) { const int row = i >> 7, ch = i & 127;
        *(LAS v4u*)(wrl + row * 2064 + ch * 16) = *(const GAS v4u*)(FWS(bf16, WS_WR) + (size_t)row * 1024 + ch * 8); }
    for (int i = tid; i < 1024; i += 512) g2l[i] = FIN(11)[i];
    if (tid < 32) lcnt[tid] = 0u;
    __syncthreads();
    const int c = lane & 15, g = lane >> 4;
    for (int bq = w; bq < 16 * ((T_ / 256 - F.vcu + F.G - 1) / F.G); bq += 8) { const int bi = 16 * (F.vcu + (bq >> 4) * F.G) + (bq & 15);
        const int t0 = bi * 16;
        const GAS v4u* xrow = (const GAS v4u*)(FWS(bf16, WS_X1) + (size_t)(t0 + c) * 1024) + g;
        GAS v2u* hrow = (GAS v2u*)(FWS(unsigned char, WS_H2) + (size_t)(t0 + c) * 1024) + g;
        v4u xr[32]; float ss = 0.f;
#pragma unroll
        for (int s = 0; s < 32; ++s) xr[s] = xrow[4 * s];
#pragma unroll
        for (int s = 0; s < 32; ++s) { f32x4 a, bq; pg8::unpack8(xr[s], a, bq); ss += (a[0] * a[0] + a[1] * a[1]) + (a[2] * a[2] + a[3] * a[3]) + (bq[0] * bq[0] + bq[1] * bq[1]) + (bq[2] * bq[2] + bq[3] * bq[3]); }
#pragma unroll
        for (int s = 0; s < 32; ++s) asm volatile("" : "+v"(xr[s]));
        ss += __shfl_xor(ss, 16); ss += __shfl_xor(ss, 32);
        const float rstd = rsqrtf(ss * (1.f / D_) + EPS_);
        f32x4 acc[3] = {(f32x4){0.f, 0.f, 0.f, 0.f}, (f32x4){0.f, 0.f, 0.f, 0.f}, (f32x4){0.f, 0.f, 0.f, 0.f}};
        const LAS unsigned char* wl = wrl + c * 2064 + g * 16; const LAS unsigned char* wl2 = wl + 2 * 16 * 2064;
#pragma unroll
        for (int s = 0; s < 32; ++s) {
            f32x4 a, bq; pg8::unpack8(xr[s], a, bq);
            const f32x4 ga = *(const LAS f32x4*)(g2l + 32 * s + 8 * g), gb = *(const LAS f32x4*)(g2l + 32 * s + 8 * g + 4);
            const f32x4 ha = a * rstd * ga, hb = bq * rstd * gb;
            const v4u hw = pg8::pack8(ha, hb);
            { v2u h8; h8.x = pk4_fp8(ha[0], ha[1], ha[2], ha[3]); h8.y = pk4_fp8(hb[0], hb[1], hb[2], hb[3]); hrow[4 * s] = h8; }
            const bf16x8 af = __builtin_bit_cast(bf16x8, hw);
#pragma unroll
            for (int ot = 0; ot < 3; ++ot) { const bf16x8 bfr = *(const LAS bf16x8*)((ot == 2 ? wl2 : wl + ot * 16 * 2064) + 64 * s); acc[ot] = mfma16(af, bfr, acc[ot]); }
            if ((s & 1) == 1) asm volatile("" ::: "memory");
        }
#pragma unroll
        for (int ot = 0; ot < 3; ++ot)
#pragma unroll
            for (int i = 0; i < 4; ++i) lgw[(4 * g + i) * 49 + 16 * ot + c] = acc[ot][i];
        LDS_WAIT(); asm volatile("" ::: "memory");
        {
            const LAS float* lg = lgw + c * 49;
            float gl[4]; int gsel = 0; float gmax;
#pragma unroll
            for (int j = 0; j < 4; ++j) gl[j] = lg[j] + FIN(13)[j];
            gmax = gl[0];
#pragma unroll
            for (int j = 1; j < 4; ++j) if (gl[j] > gmax) { gmax = gl[j]; gsel = j; }
            float den = 0.f;
#pragma unroll
            for (int j = 0; j < 4; ++j) den += expf(gl[j] - gmax);
            const float gwt = 1.0f / den;
            float el[8];
#pragma unroll
            for (int j = 0; j < 8; ++j) el[j] = lg[4 + 8 * gsel + j] + FIN(15)[8 * gsel + j];
            int i1 = 0; float l1 = el[0];
#pragma unroll
            for (int j = 1; j < 8; ++j) if (el[j] > l1) { l1 = el[j]; i1 = j; }
            int i2 = -1; float l2 = -3.0e38f;
#pragma unroll
            for (int j = 0; j < 8; ++j) if (j != i1 && el[j] > l2) { l2 = el[j]; i2 = j; }
            const float e21 = expf(l2 - l1); const float w0 = gwt / (1.0f + e21), w1 = gwt * e21 / (1.0f + e21);
            if (lane < 16) {
                const int t = t0 + lane, e0 = 8 * gsel + i1, e1 = 8 * gsel + i2;
                const unsigned p0 = __hip_atomic_fetch_add(lcnt + e0, 1u, __ATOMIC_RELAXED, __HIP_MEMORY_SCOPE_WORKGROUP);
                const unsigned p1 = __hip_atomic_fetch_add(lcnt + e1, 1u, __ATOMIC_RELAXED, __HIP_MEMORY_SCOPE_WORKGROUP);
                FWS(int, WS_TOKE)[2 * t] = e0; FWS(int, WS_TOKE)[2 * t + 1] = e1; FWS(float, WS_TOKW)[2 * t] = w0; FWS(float, WS_TOKW)[2 * t + 1] = w1; FWS(int, WS_TOKP)[2 * t] = (int)p0; FWS(int, WS_TOKP)[2 * t + 1] = (int)p1;
            }
        }
        LDS_WAIT(); asm volatile("" ::: "memory");
    }
    __syncthreads();
    if (tid < 32) lbase[tid] = __hip_atomic_fetch_add(F.ctl + CW_CNT + tid, lcnt[tid], RLX_AGENT);
    __syncthreads();
    for (int bq = w; bq < 16 * ((T_ / 256 - F.vcu + F.G - 1) / F.G); bq += 8) { const int bi = 16 * (F.vcu + (bq >> 4) * F.G) + (bq & 15);
        if (lane < 16) { const int t = bi * 16 + lane;
#pragma unroll
            for (int k = 0; k < 2; ++k) { const int e = FWS(int, WS_TOKE)[2 * t + k]; const int pos = (int)lbase[e] + FWS(int, WS_TOKP)[2 * t + k]; FWS(int, WS_TOKP)[2 * t + k] = pos; FWS(int, WS_LIST)[(size_t)e * T_ + pos] = t; } }
    }
}

__device__ __forceinline__ int moe_tables(Frame& F, int gather, bool reuse = false) {
    LAS int* s_cnt = (LAS int*)(F.lds + TAB_CNT); LAS int* s_tpre = (LAS int*)(F.lds + TAB_TPRE); LAS int* s_ul = (LAS int*)(F.lds + TAB_ULIST); LAS unsigned* s_tab = (LAS unsigned*)(F.lds + TAB_GATHER);
    __syncthreads();
    if (!reuse) {
        if (F.tid < 32) s_cnt[F.tid] = (int)__hip_atomic_load(F.ctl + CW_CNT + F.tid, RLX_AGENT);
        __syncthreads();
        if (F.tid == 0) { int a = 0; for (int e = 0; e < 32; ++e) { s_tpre[e] = a; a += (s_cnt[e] + 255) >> 8; } s_tpre[32] = a; }
        __syncthreads();
    }
    const int NT = s_tpre[32];
    const int tot = 4 * NT, R = tot / F.G, rem = tot - R * F.G;
    int ex = -1, prodq = F.vcu >> 2;
    if (F.G == 256) { const int x = F.vcu >> 5, a = (F.vcu >> 2) & 7, as = (gather == 2) ? ((a + 4) & 7) : a, e4 = 4 * (8 * as + x) + (F.vcu & 3); if (e4 < rem) { ex = e4; prodq = 8 * x + as; } }
    else if (F.vcu < rem) ex = F.vcu;
    const int n_main = R < MAX_UNITS - 1 ? R : MAX_UNITS - 1, nu = n_main + (ex >= 0 ? 1 : 0);
    if (F.tid < nu) { const int L = (F.tid < n_main) ? ((gather == 2) ? n_main - 1 - F.tid : F.tid) * F.G + F.vcu : R * F.G + ex, ti = L >> 2, pn = L & 3;       int e = 0; for (int j = 1; j < 32; ++j) if (s_tpre[j] <= ti) e = j; s_ul[F.tid] = (e << 16) | (ti << 2) | pn; }
    __syncthreads();
    if (gather == 2) {
        for (int idx = F.tid; idx < nu * 256; idx += 512) { const int wd = s_ul[idx >> 8]; s_tab[idx] = (unsigned)(256 * ((wd >> 2) & 0x3fff) + (idx & 255)) * 512u; }
        __syncthreads();
    } else if (gather == 1) {
        for (int idx = F.tid; idx < nu * 256; idx += 512) { const int i = idx >> 8, r = idx & 255; const int wd = s_ul[i]; const int e = wd >> 16, ti = (wd >> 2) & 0x3fff;
            int rr = 256 * (ti - s_tpre[e]) + r; if (rr >= s_cnt[e]) rr = s_cnt[e] - 1;
            s_tab[idx] = (unsigned)FWS(int, WS_LIST)[(size_t)e * T_ + rr] * 1024u; }
        __syncthreads();
    }
    return nu | (n_main << 8) | (prodq << 16);
}

__device__ __forceinline__ void final_phase(Frame& F, bool fresh) {
    LAS int* s_tpre = (LAS int*)(F.lds + TAB_TPRE);
    if (fresh) (void)moe_tables(F, 0);
    const int gw = F.vcu * 8 + F.wave, NGW = F.G * 8, lane = F.lane;
    f32x4 gfv[4];
#pragma unroll
    for (int q = 0; q < 4; ++q) gfv[q] = *((const GAS f32x4*)FIN(19) + lane + 64 * q);
    constexpr int NR = 4;
    v2u evn[NR], pvn[NR]; f32x2 wvn[NR];
    { const int tb0 = NR * gw;
#pragma unroll
      for (int r = 0; r < NR; ++r) { evn[r] = *(const GAS v2u*)(FWS(int, WS_TOKE) + 2 * (tb0 + r)); pvn[r] = *(const GAS v2u*)(FWS(int, WS_TOKP) + 2 * (tb0 + r)); wvn[r] = *(const GAS f32x2*)(FWS(float, WS_TOKW) + 2 * (tb0 + r)); } }
    for (int tb = NR * gw; tb < T_; tb += NR * NGW) {
        v2u ev[NR], pv[NR]; f32x2 wv[NR];
#pragma unroll
        for (int r = 0; r < NR; ++r) { ev[r] = evn[r]; pv[r] = pvn[r]; wv[r] = wvn[r]; }
        v2u xr[NR][4]; unsigned ya[NR][4], yb[NR][4];
#pragma unroll
        for (int r = 0; r < NR; ++r) {
            const size_t r0 = (size_t)(256 * s_tpre[ev[r].x] + (int)pv[r].x), r1 = (size_t)(256 * s_tpre[ev[r].y] + (int)pv[r].y);
            const GAS v2u* xp = (const GAS v2u*)(FWS(bf16, WS_X1) + (size_t)(tb + r) * 1024) + lane; const GAS unsigned* y0 = (const GAS unsigned*)(FWS(unsigned char, WS_Y) + r0 * 1024) + lane; const GAS unsigned* y1 = (const GAS unsigned*)(FWS(unsigned char, WS_Y) + r1 * 1024) + lane;
#pragma unroll
            for (int q = 0; q < 4; ++q) { xr[r][q] = __builtin_nontemporal_load(xp + 64 * q); ya[r][q] = y0[64 * q]; yb[r][q] = y1[64 * q]; } }
        { const int tbn = tb + NR * NGW; if (tbn < T_) {
#pragma unroll
            for (int r = 0; r < NR; ++r) { evn[r] = *(const GAS v2u*)(FWS(int, WS_TOKE) + 2 * (tbn + r)); pvn[r] = *(const GAS v2u*)(FWS(int, WS_TOKP) + 2 * (tbn + r)); wvn[r] = *(const GAS f32x2*)(FWS(float, WS_TOKW) + 2 * (tbn + r)); } } }
#pragma unroll
        for (int r = 0; r < NR; ++r) {
            f32x4 v[4]; float ss = 0.f; const float w0 = wv[r].x * (1.0f / 16.0f), w1 = wv[r].y * (1.0f / 16.0f);
#pragma unroll
            for (int q = 0; q < 4; ++q) {
                const f32x4 xa = (f32x4){bf_lo(xr[r][q].x), bf_hi(xr[r][q].x), bf_lo(xr[r][q].y), bf_hi(xr[r][q].y)};
                const f32x2 a0 = __builtin_amdgcn_cvt_pk_f32_fp8((int)ya[r][q], false), a1 = __builtin_amdgcn_cvt_pk_f32_fp8((int)ya[r][q], true), b0 = __builtin_amdgcn_cvt_pk_f32_fp8((int)yb[r][q], false), b1 = __builtin_amdgcn_cvt_pk_f32_fp8((int)yb[r][q], true);
                v[q] = xa + w0 * (f32x4){a0.x, a0.y, a1.x, a1.y} + w1 * (f32x4){b0.x, b0.y, b1.x, b1.y};
                ss += (v[q][0] * v[q][0] + v[q][1] * v[q][1]) + (v[q][2] * v[q][2] + v[q][3] * v[q][3]); }
            const float rstd = rsqrtf(wave_sum(ss) * (1.f / D_) + EPS_);
            GAS f32x4* op = (GAS f32x4*)(F.out + (size_t)(tb + r) * 1024) + lane;
#pragma unroll
            for (int q = 0; q < 4; ++q) __builtin_nontemporal_store(v[q] * rstd * gfv[q], op + 64 * q);
        }
    }
}

struct ExpItem { const float* W; unsigned char* WT; int K, N, mode, item; float scale; };
__device__ __forceinline__ ExpItem exp_item(Frame& F, int it) {
    const int e = it / 768, q = it % 768;
    if (q < 256) return ExpItem{FIN(16) + (size_t)e * D_ * DEXP, FWS(unsigned char, WS_WGU) + (size_t)e * D_ * D_, D_, DEXP, 1, q, 32.0f};
    if (q < 512) return ExpItem{FIN(17) + (size_t)e * D_ * DEXP, FWS(unsigned char, WS_WGU) + (size_t)e * D_ * D_, D_, DEXP, 2, q - 256, 32.0f};
    return ExpItem{FIN(18) + (size_t)e * DEXP * D_, FWS(unsigned char, WS_WD) + (size_t)e * D_ * DEXP, DEXP, D_, 0, q - 512, 16.0f};
}
__device__ __forceinline__ void exp_item_load(const ExpItem& d, int lane, float (&tv)[32]) {
    const int nblk = d.N / 32, kb = d.item / nblk, nb = d.item % nblk;
    const float* wp = d.W + (size_t)(64 * kb) * d.N + 32 * nb + (size_t)(lane >> 5) * d.N + (lane & 31);
#pragma unroll
    for (int i = 0; i < 32; ++i) tv[i] = __builtin_nontemporal_load(wp + (size_t)(2 * i) * d.N);
}
__device__ __forceinline__ void exp_item_finish(const ExpItem& d, int lane, LAS float* scr, const float (&tv)[32]) {
    const int nblk = d.N / 32, kb = d.item / nblk, nb = d.item % nblk, k0 = 64 * kb, n0 = 32 * nb;
#pragma unroll
    for (int i = 0; i < 32; ++i) { const int kk = 2 * i + (lane >> 5); scr[kk * 33 + (lane & 31)] = tv[i] * d.scale; }
    LDS_WAIT(); asm volatile("" ::: "memory");
    const int c = lane & 3, rowbase = (d.mode == 0) ? n0 : ((n0 >> 7) * 256 + (n0 & 127) + (d.mode == 2 ? 128 : 0));
#pragma unroll
    for (int j = 0; j < 2; ++j) { const int n = (lane >> 2) + 16 * j; const LAS float* sp = scr + (16 * c) * 33 + n;
        v4u o; o.x = pk4_fp8(sp[0 * 33], sp[1 * 33], sp[2 * 33], sp[3 * 33]); o.y = pk4_fp8(sp[4 * 33], sp[5 * 33], sp[6 * 33], sp[7 * 33]);
        o.z = pk4_fp8(sp[8 * 33], sp[9 * 33], sp[10 * 33], sp[11 * 33]); o.w = pk4_fp8(sp[12 * 33], sp[13 * 33], sp[14 * 33], sp[15 * 33]);
        *(GAS v4u*)(d.WT + (size_t)(rowbase + n) * d.K + k0 + 16 * c) = o; }
    LDS_WAIT(); asm volatile("" ::: "memory");
}
__device__ __forceinline__ void conv_expert_items(Frame& F, int j0, int cnt) {
    LAS float* scr = (LAS float*)(F.lds + RING_OFF + F.wave * 16384);
    const int gw = F.vcu * 8 + F.wave, NGW = F.G * 8, NIT = NEXP * 768;
    __syncthreads();
    int j = j0; const int jend = j0 + cnt;
    if (j < jend && gw + j * NGW < NIT) {
        ExpItem cur = exp_item(F, gw + j * NGW); float tv[32]; exp_item_load(cur, F.lane, tv);
        for (;;) {
            const int jn = j + 1; const bool hn = (jn < jend) && (gw + jn * NGW < NIT); ExpItem nd = cur; float tn[32];
            if (hn) { nd = exp_item(F, gw + jn * NGW); exp_item_load(nd, F.lane, tn); }
            exp_item_finish(cur, F.lane, scr, tv);
            if (!hn) break;
            cur = nd; j = jn;
#pragma unroll
            for (int i = 0; i < 32; ++i) tv[i] = tn[i];
        }
    }
    __syncthreads();
}
constexpr int N_PHASES = 9;

struct Args { const float* in[20]; float* out; unsigned char* ws; int ph_lo, ph_hi, li, pad; };
__global__ void __launch_bounds__(512, 2) mk_fwd(Args args) {
    extern __shared__ __attribute__((aligned(16))) unsigned char lds[];
    Frame F;
    F.lds = (LAS unsigned char*)lds;
    F.tid = threadIdx.x; F.lane = F.tid & 63; F.wave = __builtin_amdgcn_readfirstlane(F.tid >> 6);
    F.G = gridDim.x; { const int bx = blockIdx.x; F.vcu = (F.G % 8 == 0) ? (bx % 8) * (F.G / 8) + bx / 8 : bx; }
    unsigned char* ws = args.ws;
    F.ctl = (unsigned*)(ws + WS_CTL);
    F.wsp = ws; F.in = args.in; F.out = args.out;
    for (int u = F.tid; u < 128; u += 512) ((LAS unsigned*)(F.lds + LDSCTL_OFF))[u] = 0u;
    __syncthreads();
    volatile LAS unsigned* MISC = (volatile LAS unsigned*)(F.lds + MISC_OFF);
    XcdBarrier bar; bar.bar = F.ctl + CW_BAR; bar.x = 0; bar.st = nullptr;
    if (MK_N_LAUNCHES == 1) bar = xcd_barrier_post(F.ctl + CW_BAR, MISC + 8);
    unsigned* const qw = F.ctl + CW_QUAD + 32 * (F.vcu >> 2);
    if (MK_N_LAUNCHES == 1 && F.tid == 0) (void)__hip_atomic_fetch_or(qw + 16, 1u << xb_xcc_id(), __ATOMIC_RELAXED, __HIP_MEMORY_SCOPE_AGENT);
    bool q_same = false, x_same = false;
    unsigned* const xw = F.ctl + CW_XLOC + 32 * (F.vcu >> 5);
    const bool xloc = (MK_N_LAUNCHES == 1) && (F.G == 256);
    if (xloc && F.tid == 0) (void)__hip_atomic_fetch_or(xw + 16, 1u << xb_xcc_id(), __ATOMIC_RELAXED, __HIP_MEMORY_SCOPE_AGENT);
#define QUAD_BAR(n) do { if (MK_N_LAUNCHES == 1) quad_barrier(qw, 4u * (n), q_same, F.ctl + CW_BAR); } while (0)
#define GRID_BAR() do { if (MK_N_LAUNCHES == 1) xcd_barrier(bar); } while (0)
    const int lo = args.ph_lo, hi = args.ph_hi;
#ifndef PH_MASK
#define PH_MASK 0x1ff
#endif
#define IN(k) (((PH_MASK >> (k)) & 1) && lo <= (k) && (k) < hi)
#define BOTH(k) (IN(k) && IN((k) + 1))
#define LOCAL_SEAM() do { asm volatile("s_waitcnt vmcnt(0)" ::: "memory"); __syncthreads(); } while (0)
    LAS unsigned char* ring = F.lds + RING_OFF; const LAS unsigned char* gtab = F.lds + TAB_GATHER;

    if (IN(0)) { p0_prologue(F); if (BOTH(0)) GRID_BAR(); }

    if (IN(1)) {
        { pg8::DenseOrder S; S.init(FWS(bf16, WS_XN), FWS(bf16, WS_WIN), T_, 1024, D_, F.G, (int)blockIdx.x);
          pg8::EpiInProj E{FWS(bf16, WS_Q), FWS(bf16, WS_K), FWS(bf16, WS_V), FWS(bf16, WS_Z), FWS(float, WS_ROPE), 3};
          pg8::gemm_phase<pg8::EpiInProj, pg8::DenseOrder, true, false>(ring, D_, S, E, gtab); }
        { pg8::DenseOrder S; S.init(FWS(unsigned char, WS_XN8), FWS(unsigned char, WS_WIN8Q), T_, 768 + 2048, D_ / 2, F.G, (int)blockIdx.x, true);
          { LAS unsigned* tab = (LAS unsigned*)(F.lds + TAB_GATHER);
            for (int idx = F.tid; idx < MAX_UNITS * 256; idx += 512) { pg8::Unit u; if (S.next(idx >> 8, u)) tab[idx] = (unsigned)(u.pm * 256 + (idx & 255)) * 1024u; }
            __syncthreads(); }
          pg8::EpiInProj8 E{pg8::EpiInProj{FWS(bf16, WS_Q), FWS(bf16, WS_K), FWS(bf16, WS_V), FWS(bf16, WS_Z), FWS(float, WS_ROPE), 0}, pg8::EpiGates{FWS(bf16, WS_SGA), FWS(bf16, WS_SGG)}};
          pg8::gemm_phase<pg8::EpiInProj8, pg8::DenseOrder, true, true, 122, 127>(ring, D_ / 2, S, E, gtab); }
        if (BOTH(1)) {
            if (xloc) { if (F.tid == 0) MISC[13] = (__builtin_popcount(xb_ld(xw + 16)) == 1) ? 1u : 0u; __syncthreads(); x_same = MISC[13] != 0u; quad_barrier(xw, 32u, x_same, F.ctl + CW_BAR); }
            else GRID_BAR();
        }
    }
    if (IN(2)) {
        if (MK_N_LAUNCHES == 1) { if (F.tid == 0) MISC[12] = (__builtin_popcount(xb_ld(qw + 16)) == 1) ? 1u : 0u; __syncthreads(); q_same = MISC[12] != 0u; }
#ifndef P2_SKIP_ATTN
        attn_phase(F);
#endif
#ifndef P2_SKIP_GMLP
        for (int pm = F.vcu; pm < T_ / 256; pm += F.G) gmlp_pair(F, 2 * pm);
#endif
        if (BOTH(2)) QUAD_BAR(1);
    }
    if (IN(3)) {
        pg8::DualOrder S; S.init(FWS(bf16, WS_AO), FWS(bf16, WS_WA), FWS(bf16, WS_GO), FWS(bf16, WS_WG), T_, D_, 512, F.G, F.vcu);
        pg8::EpiMixFused E{FWS(bf16, WS_MIX), FWS(bf16, WS_SGA), FWS(bf16, WS_SGG)};
        pg8::gemm_phase<pg8::EpiMixFused, pg8::DualOrder, true, false>(ring, 512, S, E, gtab);
        if (BOTH(3)) QUAD_BAR(2);
    }
    if (IN(4)) {
        pg8::DenseOrder S; S.init(FWS(bf16, WS_MIX), FWS(bf16, WS_WOUT), T_, D_, D_, F.G, F.vcu, false, true); pg8::EpiResid E{FIN(0), FWS(bf16, WS_X1)};
        pg8::gemm_phase<pg8::EpiResid, pg8::DenseOrder, true, false>(ring, D_, S, E, gtab);
        if (BOTH(4)) QUAD_BAR(3);
    }
    if (IN(5)) { router_phase(F); conv_expert_items(F, 0, (NEXP * 768 + F.G * 8 - 1) / (F.G * 8));       if (BOTH(5)) GRID_BAR(); }
    if (IN(6)) {
        const int nu = moe_tables(F, 1) & 255;
        pg8::MoeOrder S{(const LAS int*)(F.lds + TAB_ULIST), nu, (const char*)FWS(unsigned char, WS_H2), 0, (const char*)FWS(unsigned char, WS_WGU), (size_t)D_ * D_, (size_t)256 * D_, 0};
        pg8::EpiGateUp E{FWS(unsigned char, WS_HID)};
        pg8::gemm_phase<pg8::EpiGateUp, pg8::MoeOrder, true, true, 122, 127>(ring, D_ / 2, S, E, gtab);
        if (BOTH(6)) { if (MK_N_LAUNCHES == 1) quad_barrier(qw, 16u, x_same, F.ctl + CW_BAR); }
    }
    if (IN(7)) {
        const int pk = moe_tables(F, 2, MK_N_LAUNCHES == 1 && lo <= 6), nu = pk & 255, n_main = (pk >> 8) & 255, prodq = pk >> 16;
        pg8::EpiDown E{FWS(unsigned char, WS_Y)};
#pragma unroll 1
        for (int pass = 0; pass < 2; ++pass) {
            const int u0 = pass ? n_main : 0, n = pass ? nu - n_main : n_main;
            if (pass && n > 0 && MK_N_LAUNCHES == 1) {
                if (F.tid == 0) { unsigned* pc = F.ctl + CW_QUAD + 32 * prodq; XB_SPIN(xb_ld(pc) < 16u, F.ctl + CW_BAR); __builtin_amdgcn_fence(__ATOMIC_ACQUIRE, "agent"); asm volatile("s_waitcnt vmcnt(0)" ::: "memory"); }
                __syncthreads(); }
            pg8::MoeOrder S{(const LAS int*)(F.lds + TAB_ULIST) + u0, n, (const char*)FWS(unsigned char, WS_HID), 0, (const char*)FWS(unsigned char, WS_WD), (size_t)D_ * DEXP, (size_t)256 * DEXP, u0};
            pg8::gemm_phase<pg8::EpiDown, pg8::MoeOrder, true, true, 123, 124>(ring, DEXP / 2 + (F.G >> 20), S, E, gtab);
        }
        if (BOTH(7)) GRID_BAR();
    }
    if (IN(8)) final_phase(F, !(MK_N_LAUNCHES == 1 && lo <= 6));
#undef IN
#undef BOTH
}

extern "C" void kernel_launch(void* const* d_in, const int* in_sizes, int n_in, void* d_out, int out_size, void* d_ws, size_t ws_size, hipStream_t stream) {
    static int grid = 0;
    if (grid == 0) {
        if (n_in != 20 || in_sizes[0] != T_ * D_ || out_size != T_ * D_ || ws_size < WS_END) { fprintf(stderr, "kernel_launch: unexpected shapes (n_in %d, in0 %d, out %d, ws %zu)\n", n_in, n_in > 0 ? in_sizes[0] : -1, out_size, ws_size); grid = -1; return; }
        int dev = 0, cus = 0, per_cu = 0;
        if (hipGetDevice(&dev) != hipSuccess || hipDeviceGetAttribute(&cus, hipDeviceAttributeMultiprocessorCount, dev) != hipSuccess) { grid = -1; return; }
        if (hipFuncSetAttribute((const void*)mk_fwd, hipFuncAttributeMaxDynamicSharedMemorySize, LDS_BYTES) != hipSuccess) { fprintf(stderr, "kernel_launch: hipFuncSetAttribute failed\n"); grid = -1; return; }
        if (hipOccupancyMaxActiveBlocksPerMultiprocessor(&per_cu, (const void*)mk_fwd, 512, LDS_BYTES) != hipSuccess || per_cu < 1) fprintf(stderr, "kernel_launch: occupancy query reports %d\n", per_cu);
        (void)hipGetLastError();
        grid = cus - cus % 4;
    }
    if (grid < 0) return;
    if (hipMemsetAsync((char*)d_ws + WS_CTL, 0, CTL_ZERO_BYTES, stream) != hipSuccess) return;
    Args a{};
    for (int i = 0; i < 20; ++i) a.in[i] = (const float*)d_in[i];
    a.out = (float*)d_out; a.ws = (unsigned char*)d_ws;
    if (MK_N_LAUNCHES == 1) { a.ph_lo = 0; a.ph_hi = N_PHASES; a.li = 0; hipLaunchKernelGGL(mk_fwd, dim3(grid), dim3(512), LDS_BYTES, stream, a); }
    else for (int li = 0; li < N_PHASES; ++li) { a.ph_lo = li; a.ph_hi = li + 1; a.li = li; hipLaunchKernelGGL(mk_fwd, dim3(grid), dim3(512), LDS_BYTES, stream, a); }
}
```

```cpp
#include <hip/hip_runtime.h>
#include <cstdio>
#include <cstdint>

#ifndef MK_N_LAUNCHES
#define MK_N_LAUNCHES 1
#endif

#define GAS __attribute__((address_space(1)))
#define LAS __attribute__((address_space(3)))
typedef unsigned short bf16;
typedef unsigned v4u __attribute__((ext_vector_type(4)));
typedef unsigned v2u __attribute__((ext_vector_type(2)));
typedef float f32x4 __attribute__((ext_vector_type(4)));
typedef float f32x2 __attribute__((ext_vector_type(2)));
typedef short bf16x8 __attribute__((ext_vector_type(8)));
typedef short s16x4 __attribute__((ext_vector_type(4)));
typedef int v8i __attribute__((ext_vector_type(8)));
typedef int v4i __attribute__((ext_vector_type(4)));

constexpr int T_ = 65536, D_ = 1024, SEQ_ = 2048, INC_ = 3840;
constexpr int NEXP = 32, DEXP = 512;
constexpr float EPS_ = 1e-5f;
constexpr float LOG2E = 1.4426950408889634f;
constexpr float QSCALE = 0.125f * LOG2E;

constexpr size_t MiB = 1u << 20;
constexpr size_t WS_CTL = 0, CTL_ZERO_BYTES = 1 * MiB;
constexpr size_t WS_WIN = 2 * MiB;
constexpr size_t WS_WIN8Q = 6 * MiB;
constexpr size_t WS_WIN8Z = 6 * MiB + 768 * 1024;
constexpr size_t WS_WIN8 = 6 * MiB + 1280 * 1024;
constexpr size_t WS_WA = 10 * MiB, WS_WG = 11 * MiB, WS_WOUT = 12 * MiB;
constexpr size_t WS_WR = 14 * MiB;
constexpr size_t WS_WM = 14 * MiB + 256 * 1024;
constexpr size_t WS_ROPE = 14 * MiB + 512 * 1024;
constexpr size_t WS_WGU = 16 * MiB;
constexpr size_t WS_WD = 80 * MiB;
constexpr size_t WS_LIST = 112 * MiB;
constexpr size_t WS_TOKE = 120 * MiB, WS_TOKW = 121 * MiB, WS_TOKP = 122 * MiB;
constexpr size_t WS_XN = 128 * MiB;
constexpr size_t WS_Q = 256 * MiB, WS_K = 320 * MiB, WS_V = 336 * MiB, WS_AO = 352 * MiB, WS_GO = 416 * MiB;
constexpr size_t WS_Z = 480 * MiB, WS_SGA = 608 * MiB, WS_SGG = 736 * MiB, WS_MIX = 864 * MiB;
constexpr size_t WS_XN8 = 352 * MiB;
constexpr size_t WS_X1 = 128 * MiB;
constexpr size_t WS_H2 = 352 * MiB;
constexpr size_t WS_HID = 480 * MiB;
constexpr size_t WS_Y = 616 * MiB;
constexpr size_t WS_END = 992 * MiB;
constexpr int CW_BAR = 4096;
constexpr int CW_CNT = 16384;
constexpr int CW_QUAD = 32768;
constexpr int CW_XLOC = 40960;

constexpr int RING_OFF = 0, RING_BYTES = 131072;
constexpr int LDSCTL_OFF = RING_BYTES, MISC_OFF = LDSCTL_OFF + 320;
constexpr int TAB_OFF = RING_BYTES + 512;
constexpr int TAB_CNT = TAB_OFF, TAB_TPRE = TAB_OFF + 128, TAB_ULIST = TAB_OFF + 384, TAB_GATHER = TAB_OFF + 512;
constexpr int MAX_UNITS = 13;
constexpr int LDS_BYTES = 163840;
static_assert(TAB_GATHER + MAX_UNITS * 1024 <= LDS_BYTES, "LDS map");

#define RLX_AGENT __ATOMIC_RELAXED, __HIP_MEMORY_SCOPE_AGENT
#define LDS_WAIT() asm volatile("s_waitcnt lgkmcnt(0)" ::: "memory")
#define VM_WAIT() asm volatile("s_waitcnt vmcnt(0)" ::: "memory")
__device__ __forceinline__ unsigned cvt_pk_bf16(float lo, float hi) { unsigned r; asm volatile("v_cvt_pk_bf16_f32 %0, %1, %2" : "=v"(r) : "v"(lo), "v"(hi)); return r; }
__device__ __forceinline__ float bf_lo(unsigned w) { return __uint_as_float(w << 16); }
__device__ __forceinline__ float bf_hi(unsigned w) { return __uint_as_float(w & 0xffff0000u); }
__device__ __forceinline__ float fast_exp2(float x) { return __builtin_amdgcn_exp2f(x); }
__device__ __forceinline__ float fast_rcp(float x) { return __builtin_amdgcn_rcpf(x); }
__device__ __forceinline__ float gelu_tanh(float x) { const float u = x + 0.044715f * x * x * x; return x * fast_rcp(1.0f + fast_exp2(-2.302208198f * u)); }
__device__ __forceinline__ float sigmoidf_(float x) { return fast_rcp(1.0f + fast_exp2(-LOG2E * x)); }
__device__ __forceinline__ float sat448(float v) { return __builtin_amdgcn_fmed3f(v, -448.0f, 448.0f); }
__device__ __forceinline__ unsigned pk4_fp8(float a, float b, float c, float d) { int w = 0; w = __builtin_amdgcn_cvt_pk_fp8_f32(a, b, w, false); w = __builtin_amdgcn_cvt_pk_fp8_f32(c, d, w, true); return (unsigned)w; }
__device__ __forceinline__ void unpack8_fp8(const v2u w, f32x4& v0, f32x4& v1) {
    const f32x2 a = __builtin_amdgcn_cvt_pk_f32_fp8((int)w.x, false), b = __builtin_amdgcn_cvt_pk_f32_fp8((int)w.x, true), c = __builtin_amdgcn_cvt_pk_f32_fp8((int)w.y, false), d = __builtin_amdgcn_cvt_pk_f32_fp8((int)w.y, true);
    v0 = (f32x4){a.x, a.y, b.x, b.y}; v1 = (f32x4){c.x, c.y, d.x, d.y};
}
template <int CTRL> __device__ __forceinline__ float dpp_f(float v) { return __builtin_bit_cast(float, __builtin_amdgcn_update_dpp(0, __builtin_bit_cast(int, v), CTRL, 0xF, 0xF, true)); }
__device__ __forceinline__ float wave_sum(float v) {
    v += dpp_f<0xB1>(v); v += dpp_f<0x4E>(v); v += dpp_f<0x141>(v); v += dpp_f<0x140>(v);
    { const auto rr = __builtin_amdgcn_permlane16_swap(__float_as_uint(v), __float_as_uint(v), false, false); v = __uint_as_float(rr[0]) + __uint_as_float(rr[1]); }
    { const auto rr = __builtin_amdgcn_permlane32_swap(__float_as_uint(v), __float_as_uint(v), false, false); v = __uint_as_float(rr[0]) + __uint_as_float(rr[1]); }
    return v;
}
__device__ __forceinline__ f32x4 mfma16(bf16x8 a, bf16x8 b, f32x4 c) { return __builtin_amdgcn_mfma_f32_16x16x32_bf16(a, b, c, 0, 0, 0); }
typedef short v4i16_t __attribute__((ext_vector_type(4)));
__device__ __forceinline__ s16x4 vtr(LAS const unsigned char* p) { return __builtin_bit_cast(s16x4, __builtin_amdgcn_ds_read_tr16_b64_v4i16((LAS v4i16_t*)p)); }

namespace pg8 {
#define PG8_LAS __attribute__((address_space(3)))
typedef unsigned short bf16_t;
typedef unsigned u32x4 __attribute__((ext_vector_type(4)));
constexpr int BM = 256, BK = 64, HALF = 128, HTB = HALF * BK * 2, STAGE_BYTES = 8 * HTB, NXCD = 8, WGM = 8;
__host__ __device__ __forceinline__ int lds_byte(int r, int c) { const int st = (r >> 4) * 2 + (c >> 5), rr = r & 15, cc = c & 31, ob = rr * 64 + cc * 2; return st * 1024 + (ob ^ (((ob >> 9) & 1) << 5)); }
__host__ __device__ __forceinline__ void stage_rc(int b, int& R, int& C) { const int st = b / 1024, sb = b % 1024, swz = sb ^ (((sb >> 9) & 1) << 5); R = (st >> 1) * 16 + swz / 64; C = (st & 1) * 32 + (swz % 64) / 2; }
__host__ __device__ __forceinline__ int perm32(int rho) { const int n = rho >> 4, i = rho & 15; return 8 * (i >> 2) + 4 * n + (i & 3); }

template <int OFF> __device__ __forceinline__ void glds16s(const char* sbase, unsigned voff, unsigned lds_base) {
    unsigned keep;
    asm volatile("s_mov_b32 %0, m0\n\ts_add_u32 m0, %3, %4\n\ts_nop 2\n\tglobal_load_lds_dwordx4 %2, %1\n\ts_mov_b32 m0, %0" : "=&s"(keep) : "s"(sbase), "v"(voff), "s"(lds_base), "n"(OFF) : "memory", "scc");
}
struct Unit { int pm, pn; const char* a; const char* b; int aux; };

struct DenseOrder {
    const char* A; const char* Bt; int K, nM, nN, nwg, G, c; bool idg, panel;
    __device__ void init(const void* A_, const void* Bt_, int M, int N, int K_, int G_, int c_, bool idg_ = false, bool panel_ = false) { A = (const char*)A_; Bt = (const char*)Bt_; K = K_; nM = M / BM; nN = N / BM; nwg = nM * nN; G = G_; c = c_; idg = idg_; panel = panel_; }
    __device__ bool next(int i, Unit& u) const {
        if (panel) { u.pn = c & 3; u.pm = (c & ~3) + (i & 3) + (i >> 2) * G; if (u.pm >= nM) return false; }
        else {
        const long L = (long)i * G + c; if (L >= nwg) return false;
        int wgid = (int)L; { const int q = nwg / NXCD, r = nwg % NXCD, xcd = wgid % NXCD, off = wgid / NXCD; wgid = (xcd < r ? xcd * (q + 1) : r * (q + 1) + (xcd - r) * q) + off; }
        const int nig = WGM * nN, gid = wgid / nig, fm = gid * WGM, gsz = (nM - fm) < WGM ? (nM - fm) : WGM;
        u.pm = fm + ((wgid % nig) % gsz); u.pn = (wgid % nig) / gsz; }
        u.a = idg ? A : A + (size_t)u.pm * BM * K * 2; u.b = Bt + (size_t)u.pn * BM * K * 2; u.aux = idg ? i : 0; return true;
    }
};
struct DualOrder {
    const char* A[2]; const char* Bt[2]; int K, nM, nN, nwg, G, c;
    __device__ void init(const void* A0, const void* B0, const void* A1, const void* B1, int M, int N, int K_, int G_, int c_) { A[0] = (const char*)A0; Bt[0] = (const char*)B0; A[1] = (const char*)A1; Bt[1] = (const char*)B1; K = K_; nM = M / BM; nN = N / BM; nwg = nM * nN; G = G_; c = c_; }
    __device__ bool next(int i, Unit& u) const {
        const int seg = i & 1, t = i >> 1; u.pn = c & 3; u.pm = (c & ~3) + (t & 3) + (t >> 2) * G; if (u.pm >= nM) return false;
        u.a = (seg ? A[1] : A[0]) + (size_t)u.pm * BM * K * 2; u.b = (seg ? Bt[1] : Bt[0]) + (size_t)u.pn * BM * K * 2; u.aux = seg; return true;
    }
};
struct MoeOrder {
    const PG8_LAS int* ulist; int nu; const char* Abase; size_t a_tile; const char* Bbase; size_t b_exp, b_pn; int aux0;
    __device__ bool next(int i, Unit& u) const {
        if (i >= nu) return false;
        const int w = __builtin_amdgcn_readfirstlane(ulist[i]); const int e = w >> 16, ti = (w >> 2) & 0x3fff, pn = w & 3;
        u.pm = ti; u.pn = pn; u.a = Abase + (size_t)ti * a_tile; u.b = Bbase + (size_t)e * b_exp + (size_t)pn * b_pn; u.aux = i + aux0; return true;
    }
};

template <class Epi, class Sched, bool ALIGN_EPI, bool GATHER, int SA8 = 0, int SB8 = 0>
__device__ __forceinline__ void gemm_phase(PG8_LAS unsigned char* lds, const int K, const Sched& S, const Epi& E, const PG8_LAS unsigned char* gtab) {
    const int tid = threadIdx.x, wid = __builtin_amdgcn_readfirstlane(tid >> 6), lane = tid & 63, wr = wid >> 2, wc = wid & 3, fr = lane & 15, fq = lane >> 4;
    const int nt = K / BK;
    unsigned voffA[2], voffB[2]; int gRow[2]; unsigned gCol[2];
#pragma unroll
    for (int i = 0; i < 2; ++i) { int R, C; stage_rc(tid * 16 + i * 8192, R, C); const int Rb = (R & ~31) + perm32(R & 31);
        voffA[i] = (unsigned)(R * K + C) * 2u; voffB[i] = (unsigned)(Rb * K + C) * 2u; gRow[i] = R; gCol[i] = (unsigned)C * 2u; }
    const size_t kstep = (size_t)(BK * 2);
    const size_t hstep = (size_t)HALF * K * 2;
    const unsigned ldsw = (unsigned)wid * 1024u;
    const unsigned ldsb = (unsigned)(size_t)lds + ldsw;
    const int aoff = lds_byte(wr * 64 + fr, fq * 8), boff = lds_byte(wc * 32 + fr, fq * 8);
    unsigned gC[2][2], gN[2][2];
#define PG8_SA(b, h) (((b) * 2 + (h)) * HTB)
#define PG8_SB(b, h) ((4 + (b) * 2 + (h)) * HTB)
#define PG8_STAGE(bufoff, gbase, voff) do { glds16s<(bufoff)>((const char*)(gbase), (voff)[0], ldsb); glds16s<(bufoff) + 8192>((const char*)(gbase), (voff)[1], ldsb); } while (0)
#define PG8_STAGE_A(bufoff, kptr, h) PG8_STAGE(bufoff, kptr, gC[h])
#define PG8_GLOAD(dst, unit) do { _Pragma("unroll") for (int _h = 0; _h < 2; ++_h) _Pragma("unroll") for (int _i = 0; _i < 2; ++_i) \
        dst[_h][_i] = *(const PG8_LAS unsigned*)(gtab + (unit) * 1024 + (gRow[_i] + _h * HALF) * 4) + gCol[_i]; } while (0)
#define PG8_LDA(dst, b, h) do { _Pragma("unroll") for (int m = 0; m < 4; ++m) _Pragma("unroll") for (int k = 0; k < 2; ++k) dst[m][k] = *(const PG8_LAS bf16x8*)(lds + PG8_SA(b, h) + aoff + m * 2048 + k * 1024); } while (0)
#define PG8_LDB(dst, b, h) do { _Pragma("unroll") for (int n = 0; n < 2; ++n) _Pragma("unroll") for (int k = 0; k < 2; ++k) dst[n][k] = *(const PG8_LAS bf16x8*)(lds + PG8_SB(b, h) + boff + n * 2048 + k * 1024); } while (0)
#define PG8_CAT8(x0, x1) __builtin_shufflevector(__builtin_bit_cast(v4i, x0), __builtin_bit_cast(v4i, x1), 0, 1, 2, 3, 4, 5, 6, 7)
#define PG8_MMA(ai, bj, At, Bt) do { __builtin_amdgcn_s_setprio(1); _Pragma("unroll") for (int m = 0; m < 4; ++m) _Pragma("unroll") for (int n = 0; n < 2; ++n) { \
        if constexpr (SA8 != 0) { acc[ai][bj][m][n] = __builtin_amdgcn_mfma_scale_f32_16x16x128_f8f6f4(PG8_CAT8(Bt[n][0], Bt[n][1]), PG8_CAT8(At[m][0], At[m][1]), acc[ai][bj][m][n], 0, 0, 0, SA8 * 0x01010101, 0, SB8 * 0x01010101); } \
        else { _Pragma("unroll") for (int k = 0; k < 2; ++k) acc[ai][bj][m][n] = __builtin_amdgcn_mfma_f32_16x16x32_bf16(Bt[n][k], At[m][k], acc[ai][bj][m][n], 0, 0, 0); } } \
        __builtin_amdgcn_s_setprio(0); } while (0)
#define PG8_WAIT_V(n) asm volatile("s_waitcnt vmcnt(" #n ")" ::: "memory")
#define PG8_WAIT_L(n) asm volatile("s_waitcnt lgkmcnt(" #n ")" ::: "memory")
#define PG8_BAR __builtin_amdgcn_s_barrier()
#define PG8_SCHED __builtin_amdgcn_sched_barrier(0)
    Unit cur, nxt; int ui = 0;
    if (!S.next(0, cur)) return;
    f32x4 acc[2][2][4][2];
#pragma unroll
    for (int a = 0; a < 2; ++a)
#pragma unroll
        for (int b = 0; b < 2; ++b)
#pragma unroll
            for (int m = 0; m < 4; ++m)
#pragma unroll
                for (int n = 0; n < 2; ++n) acc[a][b][m][n] = (f32x4){0.f, 0.f, 0.f, 0.f};
    bf16x8 At[4][2], B0[2][2], B1[2][2];
    const char* cA = cur.a; const char* cB = cur.b;
    if constexpr (GATHER) { PG8_GLOAD(gC, cur.aux); PG8_WAIT_L(0); }
    else {
#pragma unroll
        for (int h = 0; h < 2; ++h)
#pragma unroll
            for (int i = 0; i < 2; ++i) gC[h][i] = voffA[i] + (unsigned)h * (unsigned)hstep; }
    PG8_STAGE(PG8_SB(0, 0), cB, voffB); PG8_STAGE(PG8_SB(0, 1), cB + hstep, voffB); PG8_STAGE_A(PG8_SA(0, 0), cA, 0); PG8_STAGE_A(PG8_SA(0, 1), cA, 1);
    if (wr == 1) PG8_BAR;
    PG8_WAIT_V(2); PG8_BAR;
    PG8_STAGE(PG8_SB(1, 0), cB + kstep, voffB); PG8_STAGE_A(PG8_SA(1, 0), cA + kstep, 0); PG8_STAGE(PG8_SB(1, 1), cB + hstep + kstep, voffB);
    PG8_WAIT_V(6); PG8_BAR;
    for (;;) {
        const bool has_next = S.next(ui + 1, nxt);
        const char* nA = has_next ? nxt.a : cA; const char* nB = has_next ? nxt.b : cB;
        if constexpr (GATHER) { if (has_next) { PG8_GLOAD(gN, nxt.aux); } else {
#pragma unroll
            for (int h = 0; h < 2; ++h)
#pragma unroll
                for (int i = 0; i < 2; ++i) gN[h][i] = gC[h][i]; } }
#pragma unroll 1
        for (int t = 0; t < nt; t += 2) {
            const bool last = (t == nt - 2);
            const char* a1 = cA + (size_t)(t + 1) * kstep;
            const char* a2 = last ? nA : cA + (size_t)(t + 2) * kstep; const char* b2 = last ? nB : cB + (size_t)(t + 2) * kstep;
            const char* a3 = a2 + kstep; const char* b3 = b2 + kstep;
            PG8_LDB(B0, 0, 0); PG8_LDB(B1, 0, 1); PG8_SCHED; PG8_LDA(At, 0, 0); PG8_STAGE_A(PG8_SA(1, 1), a1, 1);
            if constexpr (GATHER) { if (last) {
#pragma unroll
                for (int h = 0; h < 2; ++h)
#pragma unroll
                    for (int i = 0; i < 2; ++i) gC[h][i] = gN[h][i]; } }
            PG8_WAIT_V(8); PG8_WAIT_L(0); PG8_BAR; PG8_MMA(0, 0, At, B0); PG8_MMA(0, 1, At, B1); PG8_BAR; PG8_SCHED;
            PG8_LDA(At, 0, 1); PG8_STAGE(PG8_SB(0, 0), b2, voffB); PG8_STAGE(PG8_SB(0, 1), b2 + hstep, voffB); PG8_STAGE_A(PG8_SA(0, 0), a2, 0);
            PG8_WAIT_V(8); PG8_WAIT_L(0); PG8_BAR; PG8_MMA(1, 0, At, B0); PG8_MMA(1, 1, At, B1); PG8_BAR; PG8_SCHED;
            PG8_LDB(B0, 1, 0); PG8_LDB(B1, 1, 1); PG8_SCHED; PG8_LDA(At, 1, 0); PG8_STAGE_A(PG8_SA(0, 1), a2, 1);
            PG8_WAIT_V(8); PG8_WAIT_L(0); PG8_BAR; PG8_MMA(0, 0, At, B0); PG8_MMA(0, 1, At, B1); PG8_BAR; PG8_SCHED;
            PG8_LDA(At, 1, 1); PG8_STAGE(PG8_SB(1, 0), b3, voffB); PG8_STAGE(PG8_SB(1, 1), b3 + hstep, voffB); PG8_STAGE_A(PG8_SA(1, 0), a3, 0);
            PG8_WAIT_V(8); PG8_WAIT_L(0); PG8_BAR; PG8_MMA(1, 0, At, B0); PG8_MMA(1, 1, At, B1); PG8_BAR; PG8_SCHED;
        }
        if constexpr (ALIGN_EPI) { if (wr == 0) PG8_BAR; }
        E(acc, cur, wr, wc, fr, fq);
        if (!has_next) break;
        if (!(Epi::SEG && cur.aux == 0))
#pragma unroll
        for (int a = 0; a < 2; ++a)
#pragma unroll
            for (int b = 0; b < 2; ++b)
#pragma unroll
                for (int m = 0; m < 4; ++m)
#pragma unroll
                    for (int n = 0; n < 2; ++n) acc[a][b][m][n] = (f32x4){0.f, 0.f, 0.f, 0.f};
        cur = nxt; cA = nA; cB = nB; ++ui;
        if constexpr (ALIGN_EPI) { if (wr == 1) PG8_BAR; }
    }
    PG8_WAIT_V(0);
    if constexpr (!ALIGN_EPI) { if (wr == 0) PG8_BAR; }
    PG8_BAR;
#undef PG8_SA
#undef PG8_SB
#undef PG8_STAGE
#undef PG8_STAGE_A
#undef PG8_GLOAD
#undef PG8_LDA
#undef PG8_LDB
#undef PG8_MMA
#undef PG8_CAT8
#undef PG8_WAIT_V
#undef PG8_WAIT_L
#undef PG8_BAR
#undef PG8_SCHED
}

__device__ __forceinline__ u32x4 pack8(const f32x4 v0, const f32x4 v1) { u32x4 w; w.x = cvt_pk_bf16(v0[0], v0[1]); w.y = cvt_pk_bf16(v0[2], v0[3]); w.z = cvt_pk_bf16(v1[0], v1[1]); w.w = cvt_pk_bf16(v1[2], v1[3]); return w; }
__device__ __forceinline__ void unpack8(const u32x4 w, f32x4& v0, f32x4& v1) { v0 = (f32x4){bf_lo(w.x), bf_hi(w.x), bf_lo(w.y), bf_hi(w.y)}; v1 = (f32x4){bf_lo(w.z), bf_hi(w.z), bf_lo(w.w), bf_hi(w.w)}; }

struct EpiInProj {
    static constexpr bool SEG = false;
    bf16_t *Q, *Kb, *Vb, *Z; const float* rope; int pn0;
    __device__ __forceinline__ void operator()(const f32x4 (&acc)[2][2][4][2], const Unit& u, int wr, int wc, int fr, int fq) const {
        const int row0 = u.pm * BM + wr * 64 + fr, c8 = wc * 32 + 8 * fq, pn = u.pn + pn0;
        if (pn <= 2) {
            const bool rot_lane = ((wc & 1) == 0) && (fq < 2);
            const float sgn = (fq == 0) ? -1.f : 1.f;
#pragma unroll
            for (int ai = 0; ai < 2; ++ai)
#pragma unroll
                for (int m = 0; m < 4; ++m) {
                    const int row = row0 + ai * HALF + m * 16, pos = row & (SEQ_ - 1);
                    const f32x4 cs0 = *(const f32x4*)(rope + pos * 16), cs1 = *(const f32x4*)(rope + pos * 16 + 4), sn0 = *(const f32x4*)(rope + pos * 16 + 8), sn1 = *(const f32x4*)(rope + pos * 16 + 12);
#pragma unroll
                    for (int bj = 0; bj < 2; ++bj) {
                        f32x4 v0 = acc[ai][bj][m][0], v1 = acc[ai][bj][m][1];
                        const bool isv = (pn == 2) && (bj == 1);
                        if (!isv) {
                            f32x4 o0, o1;
#pragma unroll
                            for (int j = 0; j < 4; ++j) { o0[j] = __shfl_xor(v0[j], 16); o1[j] = __shfl_xor(v1[j], 16); }
                            if (rot_lane) { v0 = v0 * cs0 + sgn * (o0 * sn0); v1 = v1 * cs1 + sgn * (o1 * sn1); }
                        }
                        bf16_t* dst;
                        if (pn < 2) { v0 = v0 * QSCALE; v1 = v1 * QSCALE; dst = Q + (size_t)row * 512 + pn * 256 + bj * HALF + c8; }
                        else dst = (bj == 0 ? Kb : Vb) + (size_t)row * 128 + c8;
                        *(u32x4*)dst = pack8(v0, v1);
                    }
                }
        } else if (pn <= 6) {
#pragma unroll
            for (int ai = 0; ai < 2; ++ai)
#pragma unroll
                for (int m = 0; m < 4; ++m) {
                    bf16_t* rowp = Z + (size_t)(row0 + ai * HALF + m * 16) * 1024 + (pn - 3) * 256 + c8;
#pragma unroll
                    for (int bj = 0; bj < 2; ++bj) { f32x4 v0 = acc[ai][bj][m][0], v1 = acc[ai][bj][m][1];
#pragma unroll
                        for (int j = 0; j < 4; ++j) { v0[j] = gelu_tanh(v0[j]); v1[j] = gelu_tanh(v1[j]); }
                        *(u32x4*)(rowp + bj * HALF) = pack8(v0, v1); }
                }
        }
    }
};
struct EpiGates {
    static constexpr bool SEG = false;
    bf16_t *R, *S;
    __device__ __forceinline__ void operator()(const f32x4 (&acc)[2][2][4][2], const Unit& u, int wr, int wc, int fr, int fq) const {
        const int row0 = u.pm * BM + wr * 64 + fr, col0 = u.pn * HALF + wc * 32 + 8 * fq;
#pragma unroll
        for (int ai = 0; ai < 2; ++ai)
#pragma unroll
            for (int m = 0; m < 4; ++m) { f32x4 r0, r1, s0, s1;
#pragma unroll
                for (int j = 0; j < 4; ++j) { const float ea0 = fast_exp2(-LOG2E * acc[ai][0][m][0][j]), ea1 = fast_exp2(-LOG2E * acc[ai][0][m][1][j]), eg0 = fast_exp2(-LOG2E * acc[ai][1][m][0][j]), eg1 = fast_exp2(-LOG2E * acc[ai][1][m][1][j]);
                    r0[j] = (1.0f + eg0) * fast_rcp(1.0f + ea0); r1[j] = (1.0f + eg1) * fast_rcp(1.0f + ea1); s0[j] = fast_rcp(1.0f + eg0); s1[j] = fast_rcp(1.0f + eg1); }
                const size_t off = (size_t)(row0 + ai * HALF + m * 16) * 1024 + col0;
                *(u32x4*)(R + off) = pack8(r0, r1); *(u32x4*)(S + off) = pack8(s0, s1); }
    }
};
struct EpiInProj8 {
    static constexpr bool SEG = false;
    EpiInProj qkv; EpiGates gates;
    __device__ __forceinline__ void operator()(const f32x4 (&acc)[2][2][4][2], const Unit& u, int wr, int wc, int fr, int fq) const {
        if (u.pn < 3) qkv(acc, u, wr, wc, fr, fq);
        else if (u.pn < 5) { Unit v = u; v.pn = u.pn + 2; qkv(acc, v, wr, wc, fr, fq); }
        else { Unit v = u; v.pn = u.pn - 5; gates(acc, v, wr, wc, fr, fq); }
    }
};
struct EpiMixFused {
    static constexpr bool SEG = true;
    bf16_t* MIX; const bf16_t *SGA, *SGG;
    __device__ __forceinline__ void operator()(f32x4 (&acc)[2][2][4][2], const Unit& u, int wr, int wc, int fr, int fq) const {
        const int row0 = u.pm * BM + wr * 64 + fr, col0 = u.pn * BM + wc * 32 + 8 * fq;
        if (u.aux == 0) {
#pragma unroll
            for (int ai = 0; ai < 2; ++ai)
#pragma unroll
                for (int m = 0; m < 4; ++m) { const size_t off = (size_t)(row0 + ai * HALF + m * 16) * 1024 + col0;
#pragma unroll
                    for (int bj = 0; bj < 2; ++bj) { f32x4 a0, a1; unpack8(__builtin_nontemporal_load((const u32x4*)(SGA + off + bj * HALF)), a0, a1);
                        acc[ai][bj][m][0] = acc[ai][bj][m][0] * a0; acc[ai][bj][m][1] = acc[ai][bj][m][1] * a1; } }
        } else {
#pragma unroll
            for (int ai = 0; ai < 2; ++ai)
#pragma unroll
                for (int m = 0; m < 4; ++m) { const size_t off = (size_t)(row0 + ai * HALF + m * 16) * 1024 + col0;
#pragma unroll
                    for (int bj = 0; bj < 2; ++bj) { f32x4 g0, g1; unpack8(__builtin_nontemporal_load((const u32x4*)(SGG + off + bj * HALF)), g0, g1);
                        *(u32x4*)(MIX + off + bj * HALF) = pack8(acc[ai][bj][m][0] * g0, acc[ai][bj][m][1] * g1); } }
        }
    }
};
struct EpiResid {
    static constexpr bool SEG = false;
    const float* X; bf16_t* X1;
    __device__ __forceinline__ void operator()(const f32x4 (&acc)[2][2][4][2], const Unit& u, int wr, int wc, int fr, int fq) const {
        const int row0 = u.pm * BM + wr * 64 + fr, col0 = u.pn * BM + wc * 32 + 8 * fq;
#pragma unroll
        for (int ai = 0; ai < 2; ++ai)
#pragma unroll
            for (int m = 0; m < 4; ++m) { const size_t off = (size_t)(row0 + ai * HALF + m * 16) * 1024 + col0;
#pragma unroll
                for (int bj = 0; bj < 2; ++bj) { const f32x4 x0 = __builtin_nontemporal_load((const f32x4*)(X + off + bj * HALF)), x1 = __builtin_nontemporal_load((const f32x4*)(X + off + bj * HALF + 4));
                    *(u32x4*)(X1 + off + bj * HALF) = pack8(acc[ai][bj][m][0] + x0, acc[ai][bj][m][1] + x1); } }
    }
};
struct EpiGateUp {
    static constexpr bool SEG = false;
    unsigned char* HID;
    __device__ __forceinline__ void operator()(const f32x4 (&acc)[2][2][4][2], const Unit& u, int wr, int wc, int fr, int fq) const {
        const int row0 = u.pm * BM + wr * 64 + fr, col0 = u.pn * HALF + wc * 32 + 8 * fq;
#pragma unroll
        for (int ai = 0; ai < 2; ++ai)
#pragma unroll
            for (int m = 0; m < 4; ++m) { f32x4 v0, v1;
#pragma unroll
                for (int j = 0; j < 4; ++j) { const float g0 = acc[ai][0][m][0][j], g1 = acc[ai][0][m][1][j];
                    v0[j] = 8.0f * g0 * sigmoidf_(g0) * acc[ai][1][m][0][j]; v1[j] = 8.0f * g1 * sigmoidf_(g1) * acc[ai][1][m][1][j]; }
                v2u o; o.x = pk4_fp8(sat448(v0[0]), sat448(v0[1]), sat448(v0[2]), sat448(v0[3])); o.y = pk4_fp8(sat448(v1[0]), sat448(v1[1]), sat448(v1[2]), sat448(v1[3]));
                *(v2u*)(HID + (size_t)(row0 + ai * HALF + m * 16) * DEXP + col0) = o; }
    }
};
struct EpiDown {
    static constexpr bool SEG = false;
    unsigned char* Y;
    __device__ __forceinline__ void operator()(const f32x4 (&acc)[2][2][4][2], const Unit& u, int wr, int wc, int fr, int fq) const {
        const int row0 = u.pm * BM + wr * 64 + fr, col0 = u.pn * BM + wc * 32 + 8 * fq;
#pragma unroll
        for (int ai = 0; ai < 2; ++ai)
#pragma unroll
            for (int m = 0; m < 4; ++m) { unsigned char* rowp = Y + (size_t)(row0 + ai * HALF + m * 16) * 1024 + col0;
#pragma unroll
                for (int bj = 0; bj < 2; ++bj) { const f32x4 v0 = acc[ai][bj][m][0] * 16.0f, v1 = acc[ai][bj][m][1] * 16.0f;
                    v2u o; o.x = pk4_fp8(sat448(v0[0]), sat448(v0[1]), sat448(v0[2]), sat448(v0[3])); o.y = pk4_fp8(sat448(v1[0]), sat448(v1[1]), sat448(v1[2]), sat448(v1[3])); *(v2u*)(rowp + bj * HALF) = o; } }
    }
};
}

#define XB_TMO      128
#define XB_XCNT(j)  (256  + 64 * (j))
#define XB_XSUB(j)  (1280 + 64 * (j))
#define XB_XGEN(j)  (2304 + 64 * (j))
#define XB_TOP      3328
#define XB_TOPGEN   3392
#define XCD_BAR_WORDS 3456
#define XB_SPIN_CAP (1u << 18)
__device__ __forceinline__ unsigned xb_ld(unsigned* p)              { return __hip_atomic_load(p, __ATOMIC_RELAXED, __HIP_MEMORY_SCOPE_AGENT); }
__device__ __forceinline__ unsigned xb_add(unsigned* p, unsigned v) { return __hip_atomic_fetch_add(p, v, __ATOMIC_RELAXED, __HIP_MEMORY_SCOPE_AGENT); }
__device__ __forceinline__ unsigned xb_xcc_id() { return (unsigned)__builtin_amdgcn_s_getreg((3 << 11) | 20) & 0xFu; }
#define XB_SPIN(cond, bar) do { unsigned _sp = 0; while (cond) { __builtin_amdgcn_s_sleep(1); \
    if ((++_sp & 255u) == 0u) { if (xb_ld(&(bar)[XB_TMO])) break; if (_sp > XB_SPIN_CAP) { atomicAdd(&(bar)[XB_TMO], 1u); break; } } } } while (0)
struct XcdBarrier { unsigned* bar; unsigned x; volatile LAS unsigned* st; };
__device__ __forceinline__ XcdBarrier xcd_barrier_post(unsigned* bar, volatile LAS unsigned* st) {
    XcdBarrier b; b.bar = bar; b.x = xb_xcc_id(); b.st = st;
    if (threadIdx.x == 0) (void)xb_add(&bar[XB_XCNT(b.x)], 1u);
    return b;
}
__device__ __forceinline__ void xcd_barrier_complete(unsigned* bar, unsigned x, unsigned& nloc, unsigned& nx) {
    const unsigned G = gridDim.x * gridDim.y * gridDim.z;
    unsigned sum, cnt, mine, sp = 0u;
    for (;;) {
        sum = 0u; cnt = 0u; mine = 0u;
#pragma unroll
        for (unsigned j = 0; j < 16; ++j) { const unsigned c = xb_ld(&bar[XB_XCNT(j)]); sum += c; cnt += (c > 0u) ? 1u : 0u; mine = (j == x) ? c : mine; }
        if (sum == G) break;
        __builtin_amdgcn_s_sleep(1);
        if ((++sp & 255u) == 0u) { if (xb_ld(&bar[XB_TMO])) break; if (sp > XB_SPIN_CAP) { atomicAdd(&bar[XB_TMO], 1u); break; } }
    }
    nloc = mine > 0u ? mine : 1u; nx = cnt > 0u ? cnt : 1u;
}
__device__ __forceinline__ void xcd_barrier(const XcdBarrier& b) {
    asm volatile("s_waitcnt vmcnt(0)" ::: "memory");
    __syncthreads();
    if (threadIdx.x == 0) {
        unsigned* bar = b.bar;
        __builtin_amdgcn_s_waitcnt(0);
        unsigned nloc = b.st[0], nx = b.st[1];
        if (nloc == 0u) { xcd_barrier_complete(bar, b.x, nloc, nx); b.st[0] = nloc; b.st[1] = nx; }
        const unsigned old = xb_add(&bar[XB_XSUB(b.x)], 1u);
        const unsigned gen = old / nloc;
        if (old + 1u == (gen + 1u) * nloc) {
            __builtin_amdgcn_fence(__ATOMIC_RELEASE, "agent");
            asm volatile("s_waitcnt vmcnt(0)" ::: "memory");
            const unsigned og = xb_add(&bar[XB_TOP], 1u);
            const unsigned tg = og / nx;
            if (og + 1u == (tg + 1u) * nx) xb_add(&bar[XB_TOPGEN], 1u);
            else XB_SPIN(xb_ld(&bar[XB_TOPGEN]) == tg, bar);
            __builtin_amdgcn_fence(__ATOMIC_ACQUIRE, "agent");
            xb_add(&bar[XB_XGEN(b.x)], 1u);
            asm volatile("s_waitcnt vmcnt(0)" ::: "memory");
        } else {
            XB_SPIN(xb_ld(&bar[XB_XGEN(b.x)]) == gen, bar);
            __builtin_amdgcn_fence(__ATOMIC_ACQUIRE, "agent");
            asm volatile("s_waitcnt vmcnt(0)" ::: "memory");
        }
    }
    __syncthreads();
}

__device__ __forceinline__ void quad_barrier(unsigned* cnt, unsigned target, bool same_xcd, unsigned* bar) {
    asm volatile("s_waitcnt vmcnt(0)" ::: "memory");
    __syncthreads();
    if (threadIdx.x == 0) {
        if (!same_xcd) { __builtin_amdgcn_fence(__ATOMIC_RELEASE, "agent"); asm volatile("s_waitcnt vmcnt(0)" ::: "memory"); }
        (void)xb_add(cnt, 1u);
        XB_SPIN(xb_ld(cnt) < target, bar);
        __builtin_amdgcn_fence(__ATOMIC_ACQUIRE, "agent");
        asm volatile("s_waitcnt vmcnt(0)" ::: "memory");
    }
    __syncthreads();
}

struct Frame {
    LAS unsigned char* lds;
    unsigned* ctl;
    int tid, lane, wave, vcu, G;
    unsigned char* wsp; const float* const* in; float* out;
};
#define FIN(k) (F.in[k])
#define FWS(T, off) ((T*)(F.wsp + (off)))

__device__ __forceinline__ void p0_transpose_item(const float* W, int K, int N, int ldw, bf16* WT, int mode, LAS float* scr, int item, int lane) {
    const int nblk = N / 32, kb = item / nblk, nb = item % nblk, k0 = 64 * kb, n0 = 32 * nb;
    float tv[32];
#pragma unroll
    for (int i = 0; i < 32; ++i) { const int kk = 2 * i + (lane >> 5); tv[i] = __builtin_nontemporal_load(W + (size_t)(k0 + kk) * ldw + n0 + (lane & 31)); }
#pragma unroll
    for (int i = 0; i < 32; ++i) { const int kk = 2 * i + (lane >> 5); scr[kk * 33 + (lane & 31)] = tv[i]; }
    LDS_WAIT(); asm volatile("" ::: "memory");
    const int c = lane & 7;
    const int rowbase = (mode == 0) ? n0 : ((n0 >> 7) * 256 + (n0 & 127) + (mode == 2 ? 128 : 0));
#pragma unroll
    for (int j = 0; j < 4; ++j) { const int n = (lane >> 3) + 8 * j; const LAS float* s = scr + (8 * c) * 33 + n;
        v4u o; o.x = cvt_pk_bf16(s[0 * 33], s[1 * 33]); o.y = cvt_pk_bf16(s[2 * 33], s[3 * 33]); o.z = cvt_pk_bf16(s[4 * 33], s[5 * 33]); o.w = cvt_pk_bf16(s[6 * 33], s[7 * 33]);
        *(GAS v4u*)(WT + (size_t)(rowbase + n) * K + k0 + 8 * c) = o; }
    LDS_WAIT(); asm volatile("" ::: "memory");
}
__device__ __forceinline__ void p0_transpose_item8(const float* W, int K, int N, int ldw, unsigned char* WT, int mode, float scale, LAS float* scr, int item, int lane) {
    const int nblk = N / 32, kb = item / nblk, nb = item % nblk, k0 = 64 * kb, n0 = 32 * nb;
    float tv[32];
#pragma unroll
    for (int i = 0; i < 32; ++i) { const int kk = 2 * i + (lane >> 5); tv[i] = __builtin_nontemporal_load(W + (size_t)(k0 + kk) * ldw + n0 + (lane & 31)); }
#pragma unroll
    for (int i = 0; i < 32; ++i) { const int kk = 2 * i + (lane >> 5); scr[kk * 33 + (lane & 31)] = tv[i] * scale; }
    LDS_WAIT(); asm volatile("" ::: "memory");
    const int c = lane & 3;
    const int rowbase = (mode == 0) ? n0 : ((n0 >> 7) * 256 + (n0 & 127) + (mode == 2 ? 128 : 0));
#pragma unroll
    for (int j = 0; j < 2; ++j) { const int n = (lane >> 2) + 16 * j; const LAS float* sp = scr + (16 * c) * 33 + n;
        v4u o; o.x = pk4_fp8(sp[0 * 33], sp[1 * 33], sp[2 * 33], sp[3 * 33]); o.y = pk4_fp8(sp[4 * 33], sp[5 * 33], sp[6 * 33], sp[7 * 33]);
        o.z = pk4_fp8(sp[8 * 33], sp[9 * 33], sp[10 * 33], sp[11 * 33]); o.w = pk4_fp8(sp[12 * 33], sp[13 * 33], sp[14 * 33], sp[15 * 33]);
        *(GAS v4u*)(WT + (size_t)(rowbase + n) * K + k0 + 16 * c) = o; }
    LDS_WAIT(); asm volatile("" ::: "memory");
}
template <int NR> __device__ __forceinline__ void rms_rows_to_bf16(int lane, const float* xrow0, size_t rstride, const float* gain, bf16* orow0, unsigned char* o8row0) {
    f32x4 v[NR][4]; float rstd[NR];
#pragma unroll
    for (int r = 0; r < NR; ++r) { const GAS f32x4* xr = (const GAS f32x4*)(xrow0 + r * rstride) + lane;
#pragma unroll
        for (int j = 0; j < 4; ++j) v[r][j] = __builtin_nontemporal_load(xr + 64 * j); }
    const GAS f32x4* gr = (const GAS f32x4*)gain + lane; f32x4 g[4];
#pragma unroll
    for (int j = 0; j < 4; ++j) g[j] = gr[64 * j];
#pragma unroll
    for (int r = 0; r < NR; ++r) { float s = 0.f;
#pragma unroll
        for (int j = 0; j < 4; ++j) s += (v[r][j].x * v[r][j].x + v[r][j].y * v[r][j].y) + (v[r][j].z * v[r][j].z + v[r][j].w * v[r][j].w);
        rstd[r] = rsqrtf(wave_sum(s) * (1.f / D_) + EPS_); }
#pragma unroll
    for (int r = 0; r < NR; ++r) { GAS v2u* o8 = (GAS v2u*)(orow0 + r * rstride) + lane;
#pragma unroll
        for (int j = 0; j < 4; ++j) { const f32x4 h = v[r][j] * rstd[r] * g[j]; v2u o; o.x = cvt_pk_bf16(h.x, h.y); o.y = cvt_pk_bf16(h.z, h.w); o8[64 * j] = o;
            ((GAS unsigned*)(o8row0 + r * rstride))[lane + 64 * j] = pk4_fp8(h.x, h.y, h.z, h.w); } }
}
__device__ __forceinline__ void p0_prologue(Frame& F) {
    LAS float* scr = (LAS float*)(F.lds + RING_OFF + F.wave * 16384);
    const int gw = F.vcu * 8 + F.wave, NGW = F.G * 8;
    constexpr int I_IN = 16 * 16, I_QKV = 16 * 24, I_ZV = 16 * 16, I_GA = 16 * 32, I_A = 8 * 32, I_O = 16 * 32, I_DENSE = I_IN + I_QKV + I_ZV + 2 * I_GA + 2 * I_A + I_O;
    for (int it = gw; it < I_DENSE; it += NGW) {
        int r = it;
        if (r < I_IN) { p0_transpose_item(FIN(2) + 768, D_, 512, INC_, FWS(bf16, WS_WIN), 0, scr, r, F.lane); continue; } r -= I_IN;
        if (r < I_QKV) { p0_transpose_item8(FIN(2), D_, 768, INC_, FWS(unsigned char, WS_WIN8Q), 0, 32.0f, scr, r, F.lane); continue; } r -= I_QKV;
        if (r < I_ZV) { p0_transpose_item8(FIN(2) + 1280, D_, 512, INC_, FWS(unsigned char, WS_WIN8Z), 0, 32.0f, scr, r, F.lane); continue; } r -= I_ZV;
        if (r < I_GA) { p0_transpose_item8(FIN(2) + 1792, D_, 1024, INC_, FWS(unsigned char, WS_WIN8), 1, 32.0f, scr, r, F.lane); continue; } r -= I_GA;
        if (r < I_GA) { p0_transpose_item8(FIN(2) + 2816, D_, 1024, INC_, FWS(unsigned char, WS_WIN8), 2, 32.0f, scr, r, F.lane); continue; } r -= I_GA;
        if (r < I_A) { p0_transpose_item(FIN(8), 512, D_, D_, FWS(bf16, WS_WA), 0, scr, r, F.lane); continue; } r -= I_A;
        if (r < I_A) { p0_transpose_item(FIN(9), 512, D_, D_, FWS(bf16, WS_WG), 0, scr, r, F.lane); continue; } r -= I_A;
        p0_transpose_item(FIN(10), D_, D_, D_, FWS(bf16, WS_WOUT), 0, scr, r, F.lane);
    }
    const int gt = F.vcu * 512 + F.tid, NGT = F.G * 512;
    for (int i = gt; i < 48 * 1024; i += NGT) { const int o = i >> 10, k = i & 1023; float v = 0.f; if (o < 4) v = FIN(12)[k * 4 + o]; else if (o < 36) v = FIN(14)[k * 32 + (o - 4)];
        FWS(bf16, WS_WR)[i] = (bf16)(cvt_pk_bf16(v, 0.f) & 0xffffu); }
    for (int i = gt; i < 8 * 128 * 128; i += NGT) { const int p = i & 127, q = (i >> 7) & 127; const float v = (p <= q) ? FIN(6)[i] : 0.f; FWS(bf16, WS_WM)[i] = (bf16)(cvt_pk_bf16(v, 0.f) & 0xffffu); }
    for (int i = gt; i < SEQ_ * 8; i += NGT) { const int pos = i >> 3, j = i & 7; const float inv = powf(500000.0f, -(float)(2 * j) / 16.0f); const float ang = (float)pos * inv;
        FWS(float, WS_ROPE)[pos * 16 + j] = cosf(ang); FWS(float, WS_ROPE)[pos * 16 + 8 + j] = sinf(ang); }
    for (int m = 4 * gw; m < T_; m += 4 * NGW) rms_rows_to_bf16<4>(F.lane, FIN(0) + (size_t)m * D_, (size_t)D_, FIN(1), FWS(bf16, WS_XN) + (size_t)m * D_, FWS(unsigned char, WS_XN8) + (size_t)m * D_);
}

__device__ __forceinline__ void attn_load(Frame& F, int au, v4u (&kv)[4], v4u (&vv)[4], bf16x8 (&qf)[2][2][2]) {
    const int tid = F.tid, lane = F.lane, w = F.wave;
    const int hk = au & 1, n = (au >> 1) & 15, b = au >> 5;
#pragma unroll
    for (int it = 0; it < 4; ++it) { const int q = it * 512 + tid, kr = q >> 3, c16 = q & 7;
        int rel = 128 * (n - 1) + kr; if (rel < 0) rel = 0;
        const size_t trow = (size_t)(b * SEQ_ + rel);
        kv[it] = *(const GAS v4u*)(FWS(bf16, WS_K) + trow * 128 + hk * 64 + c16 * 8);
        vv[it] = *(const GAS v4u*)(FWS(bf16, WS_V) + trow * 128 + hk * 64 + c16 * 8); }
    const int hq = 4 * hk + (w >> 1), qh = w & 1, c = lane & 15, g = lane >> 4, tok0 = b * SEQ_ + 128 * n;
#pragma unroll
    for (int gi = 0; gi < 2; ++gi)
#pragma unroll
        for (int qt = 0; qt < 2; ++qt)
#pragma unroll
            for (int sx = 0; sx < 2; ++sx) qf[gi][qt][sx] = *(const GAS bf16x8*)(FWS(bf16, WS_Q) + (size_t)(tok0 + 64 * qh + 32 * gi + 16 * qt + c) * 512 + hq * 64 + 32 * sx + 8 * g);
}
template <bool FIRST>
__device__ __forceinline__ void attn_unit(Frame& F, int au, const bf16x8 (&qc)[2][2][2]) {
    const int lane = F.lane, w = F.wave;
    const int hk = au & 1, n = (au >> 1) & 15, b = au >> 5;
    const int tok0 = b * SEQ_ + 128 * n;
    LAS unsigned char* Kl = F.lds;
    LAS unsigned char* Vl = F.lds + 36864;
    const int hq = 4 * hk + (w >> 1), qh = w & 1, c = lane & 15, g = lane >> 4, qq = c >> 2, pp = c & 3;
    const float sink2 = FIN(3)[hq] * LOG2E;
#pragma unroll 1
    for (int gi = 0; gi < 2; ++gi) {
        const int q0 = 64 * qh + 32 * gi;
        bf16x8 qf[2][2];
#pragma unroll
        for (int qt = 0; qt < 2; ++qt)
#pragma unroll
            for (int s = 0; s < 2; ++s) qf[qt][s] = gi ? qc[1][qt][s] : qc[0][qt][s];
        f32x4 S[10][2];
#pragma unroll
        for (int kt = 0; kt < 10; ++kt) { S[kt][0] = (f32x4){0.f, 0.f, 0.f, 0.f}; S[kt][1] = (f32x4){0.f, 0.f, 0.f, 0.f}; }
#pragma unroll
        for (int kt = 0; kt < 10; ++kt)
#pragma unroll
            for (int s = 0; s < 2; ++s) { const bf16x8 kf = *(const LAS bf16x8*)(Kl + (q0 + 16 * kt + c) * 144 + 64 * s + 16 * g);
                S[kt][0] = mfma16(kf, qf[0][s], S[kt][0]); S[kt][1] = mfma16(kf, qf[1][s], S[kt][1]); }
        float inv[2];
#pragma unroll
        for (int qt = 0; qt < 2; ++qt) {
            float m = sink2;
#pragma unroll
            for (int kt = 0; kt < 10; ++kt) {
                const int d = kt - qt;
                if (d < 0 || d > 8) continue;
#pragma unroll
                for (int i = 0; i < 4; ++i) { bool valid = true;
                    if (d == 0 || d == 8) { const int relp = 16 * d + 4 * g + i - c; valid = (relp >= 1) && (relp <= 128); }
                    if (FIRST) valid = valid && (q0 + 16 * kt + 4 * g + i >= 128);
                    const float s = valid ? S[kt][qt][i] : -1e30f; S[kt][qt][i] = s; m = fmaxf(m, s); } }
            m = fmaxf(m, __shfl_xor(m, 16)); m = fmaxf(m, __shfl_xor(m, 32));
            float sum = 0.f;
#pragma unroll
            for (int kt = 0; kt < 10; ++kt) { const int d = kt - qt;
#pragma unroll
                for (int i = 0; i < 4; ++i) { const float p = (d < 0 || d > 8) ? 0.f : fast_exp2(S[kt][qt][i] - m); S[kt][qt][i] = p; sum += p; } }
            sum += __shfl_xor(sum, 16); sum += __shfl_xor(sum, 32);
            inv[qt] = 1.0f / (sum + fast_exp2(sink2 - m));
        }
        f32x4 O[4][2];
#pragma unroll
        for (int dt = 0; dt < 4; ++dt) { O[dt][0] = (f32x4){0.f, 0.f, 0.f, 0.f}; O[dt][1] = (f32x4){0.f, 0.f, 0.f, 0.f}; }
#pragma unroll
        for (int ks = 0; ks < 5; ++ks) {
            bf16x8 pf[2];
#pragma unroll
            for (int qt = 0; qt < 2; ++qt) { const v4u pw = {cvt_pk_bf16(S[2 * ks][qt][0], S[2 * ks][qt][1]), cvt_pk_bf16(S[2 * ks][qt][2], S[2 * ks][qt][3]),
                                                              cvt_pk_bf16(S[2 * ks + 1][qt][0], S[2 * ks + 1][qt][1]), cvt_pk_bf16(S[2 * ks + 1][qt][2], S[2 * ks + 1][qt][3])};
                pf[qt] = __builtin_bit_cast(bf16x8, pw); }
            const int r1 = q0 + 32 * ks + 4 * g + qq, r2 = r1 + 16;
#pragma unroll
            for (int dt = 0; dt < 4; ++dt) {
                const s16x4 lo = vtr(Vl + r1 * 128 + ((dt ^ ((r1 >> 1) & 3)) * 32) + pp * 8);
                const s16x4 hi = vtr(Vl + r2 * 128 + ((dt ^ ((r2 >> 1) & 3)) * 32) + pp * 8);
                const bf16x8 af = (bf16x8){lo[0], lo[1], lo[2], lo[3], hi[0], hi[1], hi[2], hi[3]};
                O[dt][0] = mfma16(af, pf[0], O[dt][0]); O[dt][1] = mfma16(af, pf[1], O[dt][1]); }
        }
#pragma unroll
        for (int qt = 0; qt < 2; ++qt) { bf16* orow = FWS(bf16, WS_AO) + (size_t)(tok0 + q0 + 16 * qt + c) * 512 + hq * 64 + 4 * g;
#pragma unroll
            for (int dt = 0; dt < 4; ++dt) { const f32x4 o = O[dt][qt] * inv[qt]; v2u wv; wv.x = cvt_pk_bf16(o[0], o[1]); wv.y = cvt_pk_bf16(o[2], o[3]); *(GAS v2u*)(orow + 16 * dt) = wv; } }
    }
}
__device__ __forceinline__ int attn_unit_id(const Frame& F, int q) {
    const int pm = F.vcu + (q >> 2) * F.G, j = q & 3; if (pm >= T_ / 256) return -1;
    return ((pm >> 3) << 5) | ((2 * (pm & 7) + (j >> 1)) << 1) | (j & 1);
}
__device__ __forceinline__ void attn_phase(Frame& F) {
    int q = 0, a = attn_unit_id(F, 0); if (a < 0) return;
    LAS unsigned char* Kl = F.lds; LAS unsigned char* Vl = F.lds + 36864;
    v4u kv[4], vv[4]; bf16x8 qf[2][2][2];
    attn_load(F, a, kv, vv, qf);
    for (;;) {
#pragma unroll
        for (int it = 0; it < 4; ++it) { const int qi = it * 512 + F.tid, kr = qi >> 3, c16 = qi & 7;
            *(LAS v4u*)(Kl + kr * 144 + c16 * 16) = kv[it];
            *(LAS v4u*)(Vl + kr * 128 + (((c16 >> 1) ^ ((kr >> 1) & 3)) * 32) + (c16 & 1) * 16) = vv[it]; }
        bf16x8 qc[2][2][2];
#pragma unroll
        for (int gi = 0; gi < 2; ++gi)
#pragma unroll
            for (int qt = 0; qt < 2; ++qt)
#pragma unroll
                for (int sx = 0; sx < 2; ++sx) qc[gi][qt][sx] = qf[gi][qt][sx];
        __syncthreads();
        const int an = attn_unit_id(F, q + 1); const bool has_next = an >= 0;
        if (has_next) attn_load(F, an, kv, vv, qf);
        if (((a >> 1) & 15) == 0) attn_unit<true>(F, a, qc); else attn_unit<false>(F, a, qc);
        __syncthreads();
        if (!has_next) break;
        a = an; ++q;
    }
}
template <int H> __device__ __forceinline__ void gmlp_half(Frame& F, LAS unsigned char* tile, int tb, int w, int lane) {
    const int c = lane & 15, g = lane >> 4, qq = c >> 2, pp = c & 3;
    f32x4 acc[4][4];
#pragma unroll
    for (int dt = 0; dt < 4; ++dt)
#pragma unroll
        for (int q4 = 0; q4 < 4; ++q4) acc[dt][q4] = (f32x4){0.f, 0.f, 0.f, 0.f};
    const bf16* Wg = FWS(bf16, WS_WM) + (size_t)w * 128 * 128;
    v2u uw[4][4];
#pragma unroll
    for (int q4 = 0; q4 < 4; ++q4)
#pragma unroll
        for (int dt = 0; dt < 4; ++dt) uw[q4][dt] = *(const GAS v2u*)(FWS(bf16, WS_Z) + (size_t)(tb + 16 * (4 * H + q4) + c) * 1024 + 64 * w + 4 * g + 16 * dt);
#pragma unroll
    for (int ks = 0; ks < 2 + 2 * H; ++ks) {
        bf16x8 af[4];
        const int r1 = 32 * ks + 4 * g + qq, r2 = r1 + 16;
#pragma unroll
        for (int dt = 0; dt < 4; ++dt) { const s16x4 lo = vtr(tile + r1 * 128 + ((dt ^ ((r1 >> 1) & 3)) * 32) + pp * 8), hi = vtr(tile + r2 * 128 + ((dt ^ ((r2 >> 1) & 3)) * 32) + pp * 8);
            af[dt] = (bf16x8){lo[0], lo[1], lo[2], lo[3], hi[0], hi[1], hi[2], hi[3]}; }
#pragma unroll
        for (int q4 = 0; q4 < 4; ++q4) { const int qt = 4 * H + q4;
            if (2 * ks <= qt) {
                const v2u b0 = *(const GAS v2u*)(Wg + (size_t)(16 * qt + c) * 128 + 32 * ks + 4 * g), b1 = *(const GAS v2u*)(Wg + (size_t)(16 * qt + c) * 128 + 32 * ks + 16 + 4 * g);
                const v4u bw = {b0.x, b0.y, b1.x, b1.y}; const bf16x8 bf = __builtin_bit_cast(bf16x8, bw);
#pragma unroll
                for (int dt = 0; dt < 4; ++dt) acc[dt][q4] = mfma16(af[dt], bf, acc[dt][q4]);
            } }
    }
#pragma unroll
    for (int q4 = 0; q4 < 4; ++q4) { const int q = 16 * (4 * H + q4) + c; const float bias = FIN(7)[w * 128 + q];
        const size_t off = (size_t)(tb + q) * 1024 + 64 * w + 4 * g; bf16* go = FWS(bf16, WS_GO) + (size_t)(tb + q) * 512 + 64 * w + 4 * g;
#pragma unroll
        for (int dt = 0; dt < 4; ++dt) { const v2u uq = uw[q4][dt];
            const f32x4 mx = acc[dt][q4] + bias; v2u o; o.x = cvt_pk_bf16(bf_lo(uq.x) * mx[0], bf_hi(uq.x) * mx[1]); o.y = cvt_pk_bf16(bf_lo(uq.y) * mx[2], bf_hi(uq.y) * mx[3]);
            *(GAS v2u*)(go + 16 * dt) = o; } }
}
__device__ __forceinline__ void gmlp_load(Frame& F, int cu, v4u (&sl)[16]) {
    const int lane = F.lane, w = F.wave, c16 = lane & 7, ch0 = 64 * w + 8 * c16, p0 = lane >> 3;
    const GAS char* zb = (const GAS char*)(FWS(bf16, WS_Z) + (size_t)cu * 128 * 1024 + 512);
    const unsigned lo_s = (unsigned)(p0 * 2048 + ch0 * 2);
#pragma unroll
    for (int it = 0; it < 16; ++it) sl[it] = *(const GAS v4u*)(zb + it * 16384 + (size_t)lo_s);
}
__device__ __forceinline__ void gmlp_front(Frame& F, v4u (&sl)[16]) {
    const int lane = F.lane, w = F.wave, c16 = lane & 7, ch0 = 64 * w + 8 * c16, p0 = lane >> 3;
    LAS f32x2* stats = (LAS f32x2*)(F.lds + TAB_GATHER);
    LAS f32x2* part = stats + 128;
    LAS unsigned char* tile = F.lds + w * 16384;
    LAS f32x2* pw = part + w * 128 + p0;
#pragma unroll
    for (int it = 0; it < 16; ++it) { f32x4 a, bq; pg8::unpack8(sl[it], a, bq);
        float sm = ((a[0] + a[1]) + (a[2] + a[3])) + ((bq[0] + bq[1]) + (bq[2] + bq[3]));
        float sq = ((a[0] * a[0] + a[1] * a[1]) + (a[2] * a[2] + a[3] * a[3])) + ((bq[0] * bq[0] + bq[1] * bq[1]) + (bq[2] * bq[2] + bq[3] * bq[3]));
        sm += dpp_f<0xB1>(sm); sq += dpp_f<0xB1>(sq); sm += dpp_f<0x4E>(sm); sq += dpp_f<0x4E>(sq); sm += dpp_f<0x141>(sm); sq += dpp_f<0x141>(sq);
        if (c16 == 0) pw[8 * it] = (f32x2){sm, sq}; }
#pragma unroll
    for (int it = 0; it < 16; ++it) asm volatile("" : "+v"(sl[it]));
    __syncthreads();
    {   const int r = 16 * w + (lane >> 2), j = lane & 3;
        const f32x2 pa = part[j * 128 + r], pb = part[(j + 4) * 128 + r];
        float sm = pa.x + pb.x, sq = pa.y + pb.y;
        sm += dpp_f<0xB1>(sm); sq += dpp_f<0xB1>(sq); sm += dpp_f<0x4E>(sm); sq += dpp_f<0x4E>(sq);
        const float mean = sm * (1.f / 512.f), var = fmaxf(sq * (1.f / 512.f) - mean * mean, 0.f);
        if (j == 0) stats[r] = (f32x2){mean, rsqrtf(var + EPS_)}; }
    __syncthreads();
    const f32x4 lg0 = *(const f32x4*)(FIN(4) + ch0), lg1 = *(const f32x4*)(FIN(4) + ch0 + 4), lb0 = *(const f32x4*)(FIN(5) + ch0), lb1 = *(const f32x4*)(FIN(5) + ch0 + 4);
    const LAS f32x2* sp = stats + p0;
    LAS unsigned char* tp = tile + p0 * 128 + (((c16 >> 1) ^ ((p0 >> 1) & 3)) * 32) + (c16 & 1) * 16;
#pragma unroll
    for (int it = 0; it < 16; ++it) {
        f32x4 a, bq; pg8::unpack8(sl[it], a, bq); const f32x2 st = sp[8 * it];
        a = (a - st.x) * st.y * lg0 + lb0; bq = (bq - st.x) * st.y * lg1 + lb1;
        *(LAS v4u*)(tp + 1024 * it) = pg8::pack8(a, bq); }
    LDS_WAIT(); asm volatile("" ::: "memory");
}
__device__ __forceinline__ void gmlp_back(Frame& F, int cu) {
    LAS unsigned char* tile = F.lds + F.wave * 16384;
    gmlp_half<0>(F, tile, cu * 128, F.wave, F.lane);
    gmlp_half<1>(F, tile, cu * 128, F.wave, F.lane);
}
__device__ __forceinline__ void gmlp_pair(Frame& F, int cu) {
    v4u sa[16], sb[16];
    gmlp_load(F, cu, sa);
    gmlp_front(F, sa);
    gmlp_back(F, cu);
    __syncthreads();
    gmlp_load(F, cu + 1, sb);
    gmlp_front(F, sb);
    gmlp_back(F, cu + 1);
    __syncthreads();
}

__device__ __forceinline__ void router_phase(Frame& F) {
    const int tid = F.tid, lane = F.lane, w = F.wave;
    LAS unsigned char* wrl = F.lds;
    LAS float* g2l = (LAS float*)(F.lds + 99328);
    LAS float* lgw = (LAS float*)(F.lds + 103424) + w * 800;
    LAS unsigned* lcnt = (LAS unsigned*)(F.lds + 129024);
    LAS unsigned* lbase = (LAS unsigned*)(F.lds + 129024 + 128);
    for (int i = tid; i < 48 * 128; i += 512) { const int row = i >> 7, ch = i & 127;
        *(LAS v4u*)(wrl + row * 2064 + ch * 16) = *(const GAS v4u*)(FWS(bf16, WS_WR) + (size_t)row * 1024 + ch * 8); }
    for (int i = tid; i < 1024; i += 512) g2l[i] = FIN(11)[i];
    if (tid < 32) lcnt[tid] = 0u;
    __syncthreads();
    const int c = lane & 15, g = lane >> 4;
    for (int bq = w; bq < 16 * ((T_ / 256 - F.vcu + F.G - 1) / F.G); bq += 8) { const int bi = 16 * (F.vcu + (bq >> 4) * F.G) + (bq & 15);
        const int t0 = bi * 16;
        const GAS v4u* xrow = (const GAS v4u*)(FWS(bf16, WS_X1) + (size_t)(t0 + c) * 1024) + g;
        GAS v2u* hrow = (GAS v2u*)(FWS(unsigned char, WS_H2) + (size_t)(t0 + c) * 1024) + g;
        v4u xr[32]; float ss = 0.f;
#pragma unroll
        for (int s = 0; s < 32; ++s) xr[s] = xrow[4 * s];
#pragma unroll
        for (int s = 0; s < 32; ++s) { f32x4 a, bq; pg8::unpack8(xr[s], a, bq); ss += (a[0] * a[0] + a[1] * a[1]) + (a[2] * a[2] + a[3] * a[3]) + (bq[0] * bq[0] + bq[1] * bq[1]) + (bq[2] * bq[2] + bq[3] * bq[3]); }
#pragma unroll
        for (int s = 0; s < 32; ++s) asm volatile("" : "+v"(xr[s]));
        ss += __shfl_xor(ss, 16); ss += __shfl_xor(ss, 32);
        const float rstd = rsqrtf(ss * (1.f / D_) + EPS_);
        f32x4 acc[3] = {(f32x4){0.f, 0.f, 0.f, 0.f}, (f32x4){0.f, 0.f, 0.f, 0.f}, (f32x4){0.f, 0.f, 0.f, 0.f}};
        const LAS unsigned char* wl = wrl + c * 2064 + g * 16; const LAS unsigned char* wl2 = wl + 2 * 16 * 2064;
#pragma unroll
        for (int s = 0; s < 32; ++s) {
            f32x4 a, bq; pg8::unpack8(xr[s], a, bq);
            const f32x4 ga = *(const LAS f32x4*)(g2l + 32 * s + 8 * g), gb = *(const LAS f32x4*)(g2l + 32 * s + 8 * g + 4);
            const f32x4 ha = a * rstd * ga, hb = bq * rstd * gb;
            const v4u hw = pg8::pack8(ha, hb);
            { v2u h8; h8.x = pk4_fp8(ha[0], ha[1], ha[2], ha[3]); h8.y = pk4_fp8(hb[0], hb[1], hb[2], hb[3]); hrow[4 * s] = h8; }
            const bf16x8 af = __builtin_bit_cast(bf16x8, hw);
#pragma unroll
            for (int ot = 0; ot < 3; ++ot) { const bf16x8 bfr = *(const LAS bf16x8*)((ot == 2 ? wl2 : wl + ot * 16 * 2064) + 64 * s); acc[ot] = mfma16(af, bfr, acc[ot]); }
            if ((s & 1) == 1) asm volatile("" ::: "memory");
        }
#pragma unroll
        for (int ot = 0; ot < 3; ++ot)
#pragma unroll
            for (int i = 0; i < 4; ++i) lgw[(4 * g + i) * 49 + 16 * ot + c] = acc[ot][i];
        LDS_WAIT(); asm volatile("" ::: "memory");
        {
            const LAS float* lg = lgw + c * 49;
            float gl[4]; int gsel = 0; float gmax;
#pragma unroll
            for (int j = 0; j < 4; ++j) gl[j] = lg[j] + FIN(13)[j];
            gmax = gl[0];
#pragma unroll
            for (int j = 1; j < 4; ++j) if (gl[j] > gmax) { gmax = gl[j]; gsel = j; }
            float den = 0.f;
#pragma unroll
            for (int j = 0; j < 4; ++j) den += expf(gl[j] - gmax);
            const float gwt = 1.0f / den;
            float el[8];
#pragma unroll
            for (int j = 0; j < 8; ++j) el[j] = lg[4 + 8 * gsel + j] + FIN(15)[8 * gsel + j];
            int i1 = 0; float l1 = el[0];
#pragma unroll
            for (int j = 1; j < 8; ++j) if (el[j] > l1) { l1 = el[j]; i1 = j; }
            int i2 = -1; float l2 = -3.0e38f;
#pragma unroll
            for (int j = 0; j < 8; ++j) if (j != i1 && el[j] > l2) { l2 = el[j]; i2 = j; }
            const float e21 = expf(l2 - l1); const float w0 = gwt / (1.0f + e21), w1 = gwt * e21 / (1.0f + e21);
            if (lane < 16) {
                const int t = t0 + lane, e0 = 8 * gsel + i1, e1 = 8 * gsel + i2;
                const unsigned p0 = __hip_atomic_fetch_add(lcnt + e0, 1u, __ATOMIC_RELAXED, __HIP_MEMORY_SCOPE_WORKGROUP);
                const unsigned p1 = __hip_atomic_fetch_add(lcnt + e1, 1u, __ATOMIC_RELAXED, __HIP_MEMORY_SCOPE_WORKGROUP);
                FWS(int, WS_TOKE)[2 * t] = e0; FWS(int, WS_TOKE)[2 * t + 1] = e1; FWS(float, WS_TOKW)[2 * t] = w0; FWS(float, WS_TOKW)[2 * t + 1] = w1; FWS(int, WS_TOKP)[2 * t] = (int)p0; FWS(int, WS_TOKP)[2 * t + 1] = (int)p1;
            }
        }
        LDS_WAIT(); asm volatile("" ::: "memory");
    }
    __syncthreads();
    if (tid < 32) lbase[tid] = __hip_atomic_fetch_add(F.ctl + CW_CNT + tid, lcnt[tid], RLX_AGENT);
    __syncthreads();
    for (int bq = w; bq < 16 * ((T_ / 256 - F.vcu + F.G - 1) / F.G); bq += 8) { const int bi = 16 * (F.vcu + (bq >> 4) * F.G) + (bq & 15);
        if (lane < 16) { const int t = bi * 16 + lane;
#pragma unroll
            for (int k = 0; k < 2; ++k) { const int e = FWS(int, WS_TOKE)[2 * t + k]; const int pos = (int)lbase[e] + FWS(int, WS_TOKP)[2 * t + k]; FWS(int, WS_TOKP)[2 * t + k] = pos; FWS(int, WS_LIST)[(size_t)e * T_ + pos] = t; } }
    }
}

__device__ __forceinline__ int moe_tables(Frame& F, int gather, bool reuse = false) {
    LAS int* s_cnt = (LAS int*)(F.lds + TAB_CNT); LAS int* s_tpre = (LAS int*)(F.lds + TAB_TPRE); LAS int* s_ul = (LAS int*)(F.lds + TAB_ULIST); LAS unsigned* s_tab = (LAS unsigned*)(F.lds + TAB_GATHER);
    __syncthreads();
    if (!reuse) {
        if (F.tid < 32) s_cnt[F.tid] = (int)__hip_atomic_load(F.ctl + CW_CNT + F.tid, RLX_AGENT);
        __syncthreads();
        if (F.tid == 0) { int a = 0; for (int e = 0; e < 32; ++e) { s_tpre[e] = a; a += (s_cnt[e] + 255) >> 8; } s_tpre[32] = a; }
        __syncthreads();
    }
    const int NT = s_tpre[32];
    const int tot = 4 * NT, R = tot / F.G, rem = tot - R * F.G;
    int ex = -1, prodq = F.vcu >> 2;
    if (F.G == 256) { const int x = F.vcu >> 5, a = (F.vcu >> 2) & 7, as = (gather == 2) ? ((a + 4) & 7) : a, e4 = 4 * (8 * as + x) + (F.vcu & 3); if (e4 < rem) { ex = e4; prodq = 8 * x + as; } }
    else if (F.vcu < rem) ex = F.vcu;
    const int n_main = R < MAX_UNITS - 1 ? R : MAX_UNITS - 1, nu = n_main + (ex >= 0 ? 1 : 0);
    if (F.tid < nu) { const int L = (F.tid < n_main) ? ((gather == 2) ? n_main - 1 - F.tid : F.tid) * F.G + F.vcu : R * F.G + ex, ti = L >> 2, pn = L & 3;       int e = 0; for (int j = 1; j < 32; ++j) if (s_tpre[j] <= ti) e = j; s_ul[F.tid] = (e << 16) | (ti << 2) | pn; }
    __syncthreads();
    if (gather == 2) {
        for (int idx = F.tid; idx < nu * 256; idx += 512) { const int wd = s_ul[idx >> 8]; s_tab[idx] = (unsigned)(256 * ((wd >> 2) & 0x3fff) + (idx & 255)) * 512u; }
        __syncthreads();
    } else if (gather == 1) {
        for (int idx = F.tid; idx < nu * 256; idx += 512) { const int i = idx >> 8, r = idx & 255; const int wd = s_ul[i]; const int e = wd >> 16, ti = (wd >> 2) & 0x3fff;
            int rr = 256 * (ti - s_tpre[e]) + r; if (rr >= s_cnt[e]) rr = s_cnt[e] - 1;
            s_tab[idx] = (unsigned)FWS(int, WS_LIST)[(size_t)e * T_ + rr] * 1024u; }
        __syncthreads();
    }
    return nu | (n_main << 8) | (prodq << 16);
}

__device__ __forceinline__ void final_phase(Frame& F, bool fresh) {
    LAS int* s_tpre = (LAS int*)(F.lds + TAB_TPRE);
    if (fresh) (void)moe_tables(F, 0);
    const int gw = F.vcu * 8 + F.wave, NGW = F.G * 8, lane = F.lane;
    f32x4 gfv[4];
#pragma unroll
    for (int q = 0; q < 4; ++q) gfv[q] = *((const GAS f32x4*)FIN(19) + lane + 64 * q);
    constexpr int NR = 4;
    v2u evn[NR], pvn[NR]; f32x2 wvn[NR];
    { const int tb0 = NR * gw;
#pragma unroll
      for (int r = 0; r < NR; ++r) { evn[r] = *(const GAS v2u*)(FWS(int, WS_TOKE) + 2 * (tb0 + r)); pvn[r] = *(const GAS v2u*)(FWS(int, WS_TOKP) + 2 * (tb0 + r)); wvn[r] = *(const GAS f32x2*)(FWS(float, WS_TOKW) + 2 * (tb0 + r)); } }
    for (int tb = NR * gw; tb < T_; tb += NR * NGW) {
        v2u ev[NR], pv[NR]; f32x2 wv[NR];
#pragma unroll
        for (int r = 0; r < NR; ++r) { ev[r] = evn[r]; pv[r] = pvn[r]; wv[r] = wvn[r]; }
        v2u xr[NR][4]; unsigned ya[NR][4], yb[NR][4];
#pragma unroll
        for (int r = 0; r < NR; ++r) {
            const size_t r0 = (size_t)(256 * s_tpre[ev[r].x] + (int)pv[r].x), r1 = (size_t)(256 * s_tpre[ev[r].y] + (int)pv[r].y);
            const GAS v2u* xp = (const GAS v2u*)(FWS(bf16, WS_X1) + (size_t)(tb + r) * 1024) + lane; const GAS unsigned* y0 = (const GAS unsigned*)(FWS(unsigned char, WS_Y) + r0 * 1024) + lane; const GAS unsigned* y1 = (const GAS unsigned*)(FWS(unsigned char, WS_Y) + r1 * 1024) + lane;
#pragma unroll
            for (int q = 0; q < 4; ++q) { xr[r][q] = __builtin_nontemporal_load(xp + 64 * q); ya[r][q] = y0[64 * q]; yb[r][q] = y1[64 * q]; } }
        { const int tbn = tb + NR * NGW; if (tbn < T_) {
#pragma unroll
            for (int r = 0; r < NR; ++r) { evn[r] = *(const GAS v2u*)(FWS(int, WS_TOKE) + 2 * (tbn + r)); pvn[r] = *(const GAS v2u*)(FWS(int, WS_TOKP) + 2 * (tbn + r)); wvn[r] = *(const GAS f32x2*)(FWS(float, WS_TOKW) + 2 * (tbn + r)); } } }
#pragma unroll
        for (int r = 0; r < NR; ++r) {
            f32x4 v[4]; float ss = 0.f; const float w0 = wv[r].x * (1.0f / 16.0f), w1 = wv[r].y * (1.0f / 16.0f);
#pragma unroll
            for (int q = 0; q < 4; ++q) {
                const f32x4 xa = (f32x4){bf_lo(xr[r][q].x), bf_hi(xr[r][q].x), bf_lo(xr[r][q].y), bf_hi(xr[r][q].y)};
                const f32x2 a0 = __builtin_amdgcn_cvt_pk_f32_fp8((int)ya[r][q], false), a1 = __builtin_amdgcn_cvt_pk_f32_fp8((int)ya[r][q], true), b0 = __builtin_amdgcn_cvt_pk_f32_fp8((int)yb[r][q], false), b1 = __builtin_amdgcn_cvt_pk_f32_fp8((int)yb[r][q], true);
                v[q] = xa + w0 * (f32x4){a0.x, a0.y, a1.x, a1.y} + w1 * (f32x4){b0.x, b0.y, b1.x, b1.y};
                ss += (v[q][0] * v[q][0] + v[q][1] * v[q][1]) + (v[q][2] * v[q][2] + v[q][3] * v[q][3]); }
            const float rstd = rsqrtf(wave_sum(ss) * (1.f / D_) + EPS_);
            GAS f32x4* op = (GAS f32x4*)(F.out + (size_t)(tb + r) * 1024) + lane;
#pragma unroll
            for (int q = 0; q < 4; ++q) __builtin_nontemporal_store(v[q] * rstd * gfv[q], op + 64 * q);
        }
    }
}

struct ExpItem { const float* W; unsigned char* WT; int K, N, mode, item; float scale; };
__device__ __forceinline__ ExpItem exp_item(Frame& F, int it) {
    const int e = it / 768, q = it % 768;
    if (q < 256) return ExpItem{FIN(16) + (size_t)e * D_ * DEXP, FWS(unsigned char, WS_WGU) + (size_t)e * D_ * D_, D_, DEXP, 1, q, 32.0f};
    if (q < 512) return ExpItem{FIN(17) + (size_t)e * D_ * DEXP, FWS(unsigned char, WS_WGU) + (size_t)e * D_ * D_, D_, DEXP, 2, q - 256, 32.0f};
    return ExpItem{FIN(18) + (size_t)e * DEXP * D_, FWS(unsigned char, WS_WD) + (size_t)e * D_ * DEXP, DEXP, D_, 0, q - 512, 16.0f};
}
__device__ __forceinline__ void exp_item_load(const ExpItem& d, int lane, float (&tv)[32]) {
    const int nblk = d.N / 32, kb = d.item / nblk, nb = d.item % nblk;
    const float* wp = d.W + (size_t)(64 * kb) * d.N + 32 * nb + (size_t)(lane >> 5) * d.N + (lane & 31);
#pragma unroll
    for (int i = 0; i < 32; ++i) tv[i] = __builtin_nontemporal_load(wp + (size_t)(2 * i) * d.N);
}
__device__ __forceinline__ void exp_item_finish(const ExpItem& d, int lane, LAS float* scr, const float (&tv)[32]) {
    const int nblk = d.N / 32, kb = d.item / nblk, nb = d.item % nblk, k0 = 64 * kb, n0 = 32 * nb;
#pragma unroll
    for (int i = 0; i < 32; ++i) { const int kk = 2 * i + (lane >> 5); scr[kk * 33 + (lane & 31)] = tv[i] * d.scale; }
    LDS_WAIT(); asm volatile("" ::: "memory");
    const int c = lane & 3, rowbase = (d.mode == 0) ? n0 : ((n0 >> 7) * 256 + (n0 & 127) + (d.mode == 2 ? 128 : 0));
#pragma unroll
    for (int j = 0; j < 2; ++j) { const int n = (lane >> 2) + 16 * j; const LAS float* sp = scr + (16 * c) * 33 + n;
        v4u o; o.x = pk4_fp8(sp[0 * 33], sp[1 * 33], sp[2 * 33], sp[3 * 33]); o.y = pk4_fp8(sp[4 * 33], sp[5 * 33], sp[6 * 33], sp[7 * 33]);
        o.z = pk4_fp8(sp[8 * 33], sp[9 * 33], sp[10 * 33], sp[11 * 33]); o.w = pk4_fp8(sp[12 * 33], sp[13 * 33], sp[14 * 33], sp[15 * 33]);
        *(GAS v4u*)(d.WT + (size_t)(rowbase + n) * d.K + k0 + 16 * c) = o; }
    LDS_WAIT(); asm volatile("" ::: "memory");
}
__device__ __forceinline__ void conv_expert_items(Frame& F, int j0, int cnt) {
    LAS float* scr = (LAS float*)(F.lds + RING_OFF + F.wave * 16384);
    const int gw = F.vcu * 8 + F.wave, NGW = F.G * 8, NIT = NEXP * 768;
    __syncthreads();
    int j = j0; const int jend = j0 + cnt;
    if (j < jend && gw + j * NGW < NIT) {
        ExpItem cur = exp_item(F, gw + j * NGW); float tv[32]; exp_item_load(cur, F.lane, tv);
        for (;;) {
            const int jn = j + 1; const bool hn = (jn < jend) && (gw + jn * NGW < NIT); ExpItem nd = cur; float tn[32];
            if (hn) { nd = exp_item(F, gw + jn * NGW); exp_item_load(nd, F.lane, tn); }
            exp_item_finish(cur, F.lane, scr, tv);
            if (!hn) break;
            cur = nd; j = jn;
#pragma unroll
            for (int i = 0; i < 32; ++i) tv[i] = tn[i];
        }
    }
    __syncthreads();
}
constexpr int N_PHASES = 9;

struct Args { const float* in[20]; float* out; unsigned char* ws; int ph_lo, ph_hi, li, pad; };
__global__ void __launch_bounds__(512, 2) mk_fwd(Args args) {
    extern __shared__ __attribute__((aligned(16))) unsigned char lds[];
    Frame F;
    F.lds = (LAS unsigned char*)lds;
    F.tid = threadIdx.x; F.lane = F.tid & 63; F.wave = __builtin_amdgcn_readfirstlane(F.tid >> 6);
    F.G = gridDim.x; { const int bx = blockIdx.x; F.vcu = (F.G % 8 == 0) ? (bx % 8) * (F.G / 8) + bx / 8 : bx; }
    unsigned char* ws = args.ws;
    F.ctl = (unsigned*)(ws + WS_CTL);
    F.wsp = ws; F.in = args.in; F.out = args.out;
    for (int u = F.tid; u < 128; u += 512) ((LAS unsigned*)(F.lds + LDSCTL_OFF))[u] = 0u;
    __syncthreads();
    volatile LAS unsigned* MISC = (volatile LAS unsigned*)(F.lds + MISC_OFF);
    XcdBarrier bar; bar.bar = F.ctl + CW_BAR; bar.x = 0; bar.st = nullptr;
    if (MK_N_LAUNCHES == 1) bar = xcd_barrier_post(F.ctl + CW_BAR, MISC + 8);
    unsigned* const qw = F.ctl + CW_QUAD + 32 * (F.vcu >> 2);
    if (MK_N_LAUNCHES == 1 && F.tid == 0) (void)__hip_atomic_fetch_or(qw + 16, 1u << xb_xcc_id(), __ATOMIC_RELAXED, __HIP_MEMORY_SCOPE_AGENT);
    bool q_same = false, x_same = false;
    unsigned* const xw = F.ctl + CW_XLOC + 32 * (F.vcu >> 5);
    const bool xloc = (MK_N_LAUNCHES == 1) && (F.G == 256);
    if (xloc && F.tid == 0) (void)__hip_atomic_fetch_or(xw + 16, 1u << xb_xcc_id(), __ATOMIC_RELAXED, __HIP_MEMORY_SCOPE_AGENT);
#define QUAD_BAR(n) do { if (MK_N_LAUNCHES == 1) quad_barrier(qw, 4u * (n), q_same, F.ctl + CW_BAR); } while (0)
#define GRID_BAR() do { if (MK_N_LAUNCHES == 1) xcd_barrier(bar); } while (0)
    const int lo = args.ph_lo, hi = args.ph_hi;
#ifndef PH_MASK
#define PH_MASK 0x1ff
#endif
#define IN(k) (((PH_MASK >> (k)) & 1) && lo <= (k) && (k) < hi)
#define BOTH(k) (IN(k) && IN((k) + 1))
#define LOCAL_SEAM() do { asm volatile("s_waitcnt vmcnt(0)" ::: "memory"); __syncthreads(); } while (0)
    LAS unsigned char* ring = F.lds + RING_OFF; const LAS unsigned char* gtab = F.lds + TAB_GATHER;

    if (IN(0)) { p0_prologue(F); if (BOTH(0)) GRID_BAR(); }

    if (IN(1)) {
        { pg8::DenseOrder S; S.init(FWS(bf16, WS_XN), FWS(bf16, WS_WIN), T_, 512, D_, F.G, (int)blockIdx.x);
          pg8::EpiInProj E{FWS(bf16, WS_Q), FWS(bf16, WS_K), FWS(bf16, WS_V), FWS(bf16, WS_Z), FWS(float, WS_ROPE), 3};
          pg8::gemm_phase<pg8::EpiInProj, pg8::DenseOrder, true, false>(ring, D_, S, E, gtab); }
        { pg8::DenseOrder S; S.init(FWS(unsigned char, WS_XN8), FWS(unsigned char, WS_WIN8Q), T_, 768 + 512 + 2048, D_ / 2, F.G, (int)blockIdx.x, true);
          { LAS unsigned* tab = (LAS unsigned*)(F.lds + TAB_GATHER);
            for (int idx = F.tid; idx < MAX_UNITS * 256; idx += 512) { pg8::Unit u; if (S.next(idx >> 8, u)) tab[idx] = (unsigned)(u.pm * 256 + (idx & 255)) * 1024u; }
            __syncthreads(); }
          pg8::EpiInProj8 E{pg8::EpiInProj{FWS(bf16, WS_Q), FWS(bf16, WS_K), FWS(bf16, WS_V), FWS(bf16, WS_Z), FWS(float, WS_ROPE), 0}, pg8::EpiGates{FWS(bf16, WS_SGA), FWS(bf16, WS_SGG)}};
          pg8::gemm_phase<pg8::EpiInProj8, pg8::DenseOrder, true, true, 122, 127>(ring, D_ / 2, S, E, gtab); }
        if (BOTH(1)) {
            if (xloc) { if (F.tid == 0) MISC[13] = (__builtin_popcount(xb_ld(xw + 16)) == 1) ? 1u : 0u; __syncthreads(); x_same = MISC[13] != 0u; quad_barrier(xw, 32u, x_same, F.ctl + CW_BAR); }
            else GRID_BAR();
        }
    }
    if (IN(2)) {
        if (MK_N_LAUNCHES == 1) { if (F.tid == 0) MISC[12] = (__builtin_popcount(xb_ld(qw + 16)) == 1) ? 1u : 0u; __syncthreads(); q_same = MISC[12] != 0u; }
#ifndef P2_SKIP_ATTN
        attn_phase(F);
#endif
#ifndef P2_SKIP_GMLP
        for (int pm = F.vcu; pm < T_ / 256; pm += F.G) gmlp_pair(F, 2 * pm);
#endif
        if (BOTH(2)) QUAD_BAR(1);
    }
    if (IN(3)) {
        pg8::DualOrder S; S.init(FWS(bf16, WS_AO), FWS(bf16, WS_WA), FWS(bf16, WS_GO), FWS(bf16, WS_WG), T_, D_, 512, F.G, F.vcu);
        pg8::EpiMixFused E{FWS(bf16, WS_MIX), FWS(bf16, WS_SGA), FWS(bf16, WS_SGG)};
        pg8::gemm_phase<pg8::EpiMixFused, pg8::DualOrder, true, false>(ring, 512, S, E, gtab);
        if (BOTH(3)) QUAD_BAR(2);
    }
    if (IN(4)) {
        pg8::DenseOrder S; S.init(FWS(bf16, WS_MIX), FWS(bf16, WS_WOUT), T_, D_, D_, F.G, F.vcu, false, true); pg8::EpiResid E{FIN(0), FWS(bf16, WS_X1)};
        pg8::gemm_phase<pg8::EpiResid, pg8::DenseOrder, true, false>(ring, D_, S, E, gtab);
        if (BOTH(4)) QUAD_BAR(3);
    }
    if (IN(5)) { router_phase(F); conv_expert_items(F, 0, (NEXP * 768 + F.G * 8 - 1) / (F.G * 8));       if (BOTH(5)) GRID_BAR(); }
    if (IN(6)) {
        const int nu = moe_tables(F, 1) & 255;
        pg8::MoeOrder S{(const LAS int*)(F.lds + TAB_ULIST), nu, (const char*)FWS(unsigned char, WS_H2), 0, (const char*)FWS(unsigned char, WS_WGU), (size_t)D_ * D_, (size_t)256 * D_, 0};
        pg8::EpiGateUp E{FWS(unsigned char, WS_HID)};
        pg8::gemm_phase<pg8::EpiGateUp, pg8::MoeOrder, true, true, 122, 127>(ring, D_ / 2, S, E, gtab);
        if (BOTH(6)) { if (MK_N_LAUNCHES == 1) quad_barrier(qw, 16u, x_same, F.ctl + CW_BAR); }
    }
    if (IN(7)) {
        const int pk = moe_tables(F, 2, MK_N_LAUNCHES == 1 && lo <= 6), nu = pk & 255, n_main = (pk >> 8) & 255, prodq = pk >> 16;
        pg8::EpiDown E{FWS(unsigned char, WS_Y)};
#pragma unroll 1
        for (int pass = 0; pass < 2; ++pass) {
            const int u0 = pass ? n_main : 0, n = pass ? nu - n_main : n_main;
            if (pass && n > 0 && MK_N_LAUNCHES == 1) {
                if (F.tid == 0) { unsigned* pc = F.ctl + CW_QUAD + 32 * prodq; XB_SPIN(xb_ld(pc) < 16u, F.ctl + CW_BAR); __builtin_amdgcn_fence(__ATOMIC_ACQUIRE, "agent"); asm volatile("s_waitcnt vmcnt(0)" ::: "memory"); }
                __syncthreads(); }
            pg8::MoeOrder S{(const LAS int*)(F.lds + TAB_ULIST) + u0, n, (const char*)FWS(unsigned char, WS_HID), 0, (const char*)FWS(unsigned char, WS_WD), (size_t)D_ * DEXP, (size_t)256 * DEXP, u0};
            pg8::gemm_phase<pg8::EpiDown, pg8::MoeOrder, true, true, 123, 124>(ring, DEXP / 2 + (F.G >> 20), S, E, gtab);
        }
        if (BOTH(7)) GRID_BAR();
    }
    if (IN(8)) final_phase(F, !(MK_N_LAUNCHES == 1 && lo <= 6));
#undef IN
#undef BOTH
}

extern "C" void kernel_launch(void* const* d_in, const int* in_sizes, int n_in, void* d_out, int out_size, void* d_ws, size_t ws_size, hipStream_t stream) {
    static int grid = 0;
    if (grid == 0) {
        if (n_in != 20 || in_sizes[0] != T_ * D_ || out_size != T_ * D_ || ws_size < WS_END) { fprintf(stderr, "kernel_launch: unexpected shapes (n_in %d, in0 %d, out %d, ws %zu)\n", n_in, n_in > 0 ? in_sizes[0] : -1, out_size, ws_size); grid = -1; return; }
        int dev = 0, cus = 0, per_cu = 0;
        if (hipGetDevice(&dev) != hipSuccess || hipDeviceGetAttribute(&cus, hipDeviceAttributeMultiprocessorCount, dev) != hipSuccess) { grid = -1; return; }
        if (hipFuncSetAttribute((const void*)mk_fwd, hipFuncAttributeMaxDynamicSharedMemorySize, LDS_BYTES) != hipSuccess) { fprintf(stderr, "kernel_launch: hipFuncSetAttribute failed\n"); grid = -1; return; }
        if (hipOccupancyMaxActiveBlocksPerMultiprocessor(&per_cu, (const void*)mk_fwd, 512, LDS_BYTES) != hipSuccess || per_cu < 1) fprintf(stderr, "kernel_launch: occupancy query reports %d\n", per_cu);
        (void)hipGetLastError();
        grid = cus - cus % 4;
    }
    if (grid < 0) return;
    if (hipMemsetAsync((char*)d_ws + WS_CTL, 0, CTL_ZERO_BYTES, stream) != hipSuccess) return;
    Args a{};
    for (int i = 0; i < 20; ++i) a.in[i] = (const float*)d_in[i];
    a.out = (float*)d_out; a.ws = (unsigned char*)d_ws;
    if (MK_N_LAUNCHES == 1) { a.ph_lo = 0; a.ph_hi = N_PHASES; a.li = 0; hipLaunchKernelGGL(mk_fwd, dim3(grid), dim3(512), LDS_BYTES, stream, a); }
    else for (int li = 0; li < N_PHASES; ++li) { a.ph_lo = li; a.ph_hi = li + 1; a.li = li; hipLaunchKernelGGL(mk_fwd, dim3(grid), dim3(512), LDS_BYTES, stream, a); }
}
```
